# Optimizing an MI355X kernel written in HIP

```python
import math
import jax, jax.numpy as jnp
from jax import lax
import numpy as np

D_MODEL = 1024
BATCH = 4
SEQ = 8192
DEPTH = 1

HEAD_DIM = 64
A_HEADS = 8
A_KV_HEADS = 2
A_REP = A_HEADS // A_KV_HEADS
B_HEADS = 4
B_VDIM = 2 * HEAD_DIM
A_WIDTH = A_HEADS * HEAD_DIM
B_WIDTH = B_HEADS * B_VDIM
MIX_WIDTH = A_WIDTH + B_WIDTH
A_Q = A_HEADS * HEAD_DIM
A_KV = A_KV_HEADS * HEAD_DIM
B_QK = B_HEADS * 2 * HEAD_DIM
IN_WIDTH = A_Q + 2 * A_KV + 2 * B_QK + B_WIDTH
Q_BLOCK = 128
ATTN_SCALE = HEAD_DIM ** -0.5
GRID_W = 64
ROPE_THETA = 10000.0
NUM_BUCKETS = 32
MAX_DISTANCE = 128
N_EXPERTS = 16
EC_CAPACITY_FACTOR = 2
D_EXPERT = 2 * D_MODEL
PLE_DIM = 256
LN_EPS = 1e-5
QK_EPS = 1e-6
DEEPNORM_ALPHA = (2 * DEPTH) ** 0.25
DEEPNORM_BETA = (8 * DEPTH) ** -0.25

kernel_name = "hybrid_gqa_diffattn_ec_moe_encoder"


def layer_norm(x, g, b):
    xf = x.astype(jnp.float32)
    mu = jnp.mean(xf, axis=-1, keepdims=True)
    xc = xf - mu
    var = jnp.mean(xc * xc, axis=-1, keepdims=True)
    return (xc * lax.rsqrt(var + LN_EPS) * g.astype(jnp.float32) + b.astype(jnp.float32)).astype(x.dtype)


def rms_norm(x, g, eps):
    xf = x.astype(jnp.float32)
    ms = jnp.mean(xf * xf, axis=-1, keepdims=True)
    return (xf * lax.rsqrt(ms + eps) * g.astype(jnp.float32)).astype(x.dtype)


def rope_1d(x, pos):
    d = x.shape[-1]
    inv = ROPE_THETA ** (-jnp.arange(0, d, 2, dtype=jnp.float32) / d)
    ang = pos.astype(jnp.float32)[:, None] * inv[None, :]
    cos = jnp.cos(ang)[:, None, :]
    sin = jnp.sin(ang)[:, None, :]
    xf = x.astype(jnp.float32)
    x1, x2 = xf[..., : d // 2], xf[..., d // 2:]
    return jnp.concatenate([x1 * cos - x2 * sin, x2 * cos + x1 * sin], axis=-1).astype(x.dtype)


def axial_rope(x, row, col):
    half = x.shape[-1] // 2
    return jnp.concatenate([rope_1d(x[..., :half], row), rope_1d(x[..., half:], col)], axis=-1)


def t5_bucket(rel):
    half = NUM_BUCKETS // 2
    max_exact = half // 2
    ret = (rel > 0).astype(jnp.int32) * half
    n = jnp.abs(rel)
    nf = jnp.maximum(n, 1).astype(jnp.float32)
    large = max_exact + (jnp.log(nf / max_exact) / math.log(MAX_DISTANCE / max_exact)
                         * (half - max_exact)).astype(jnp.int32)
    large = jnp.minimum(large, half - 1)
    return ret + jnp.where(n < max_exact, n, large)


def mixer_gqa_axial(q, k, v, q_norm, k_norm, row, col):
    b_, s_ = q.shape[0], q.shape[1]
    q = axial_rope(rms_norm(q, q_norm, QK_EPS), row, col)
    k = axial_rope(rms_norm(k, k_norm, QK_EPS), row, col)
    nb = s_ // Q_BLOCK
    qb = jnp.moveaxis(q.reshape(b_, nb, Q_BLOCK, A_KV_HEADS, A_REP, HEAD_DIM), 1, 0)

    def block(qblk):
        s = jnp.einsum('bqgrd,bkgd->bgrqk', qblk, k).astype(jnp.float32) * ATTN_SCALE
        w = jax.nn.softmax(s, axis=-1).astype(v.dtype)
        return jnp.einsum('bgrqk,bkgd->bqgrd', w, v)

    o = lax.map(block, qb)
    return jnp.moveaxis(o, 0, 1).reshape(b_, s_, A_WIDTH)


def mixer_diff_attn(q, k, v, lq1, lk1, lq2, lk2, subln, rel_bias, lam_init):
    b_, s_ = q.shape[0], q.shape[1]
    f32 = jnp.float32
    lam = (jnp.exp(jnp.sum(lq1.astype(f32) * lk1.astype(f32)))
           - jnp.exp(jnp.sum(lq2.astype(f32) * lk2.astype(f32))) + lam_init)
    pos = jnp.arange(s_, dtype=jnp.int32)
    nb = s_ // Q_BLOCK
    qb = jnp.moveaxis(q.reshape(b_, nb, Q_BLOCK, B_HEADS, 2, HEAD_DIM), 1, 0)
    pb = pos.reshape(nb, Q_BLOCK)

    def block(args):
        qblk, qpos = args
        bucket = t5_bucket(pos[None, :] - qpos[:, None])
        bias = jnp.moveaxis(rel_bias[bucket], -1, 0).astype(f32)
        s = jnp.einsum('bqhmd,bkhmd->bhmqk', qblk, k).astype(f32) * ATTN_SCALE
        w = jax.nn.softmax(s + bias[None, :, None], axis=-1)
        a = (w[:, :, 0] - lam * w[:, :, 1]).astype(v.dtype)
        return jnp.einsum('bhqk,bkhe->bqhe', a, v)

    o = lax.map(block, (qb, pb))
    o = jnp.moveaxis(o, 0, 1).reshape(b_, s_, B_HEADS, B_VDIM)
    o = rms_norm(o, subln, LN_EPS) * (1.0 - lam_init)
    return o.reshape(b_, s_, B_WIDTH)


def expert_choice_moe(h, w_router, w_gate, w_up, w_down):
    b_, s_, _ = h.shape
    cap = EC_CAPACITY_FACTOR * s_ // N_EXPERTS
    logits = jnp.einsum('bsd,de->bse', h, w_router).astype(jnp.float32)
    aff = jax.nn.softmax(logits, axis=-1)
    gates, idx = lax.top_k(jnp.swapaxes(aff, 1, 2), cap)
    bidx = jnp.arange(b_)[:, None, None]
    xe = h[bidx, idx]
    hg = jnp.einsum('becd,edf->becf', xe, w_gate)
    hu = jnp.einsum('becd,edf->becf', xe, w_up)
    ye = jnp.einsum('becf,efd->becd', jax.nn.silu(hg) * hu, w_down)
    ye = ye * gates[..., None].astype(ye.dtype)
    return jnp.zeros_like(h).at[bidx, idx].add(ye)


def setup_inputs(seed: int = 0) -> dict:
    key = jax.random.key(seed)
    ks = jax.random.split(key, 24)
    f32 = jnp.float32
    nrm = lambda k, shape, s: jax.random.normal(k, shape, f32) * s
    beta = DEEPNORM_BETA
    col_scale = jnp.concatenate([
        jnp.ones((A_Q + A_KV,), f32), jnp.full((A_KV,), beta, f32),
        jnp.ones((2 * B_QK,), f32), jnp.full((B_WIDTH,), beta, f32)])
    return {
        "x": nrm(ks[0], (BATCH, SEQ, D_MODEL), 1.0),
        "p": nrm(ks[1], (DEPTH, BATCH, SEQ, PLE_DIM), 1.0),
        "w_in": nrm(ks[2], (DEPTH, D_MODEL, IN_WIDTH), D_MODEL ** -0.5) * col_scale,
        "w_out": nrm(ks[3], (DEPTH, MIX_WIDTH, D_MODEL), MIX_WIDTH ** -0.5 * beta),
        "a_q_norm": 1.0 + nrm(ks[4], (DEPTH, HEAD_DIM), 0.05),
        "a_k_norm": 1.0 + nrm(ks[5], (DEPTH, HEAD_DIM), 0.05),
        "b_lambda_q1": nrm(ks[6], (DEPTH, HEAD_DIM), 0.1),
        "b_lambda_k1": nrm(ks[7], (DEPTH, HEAD_DIM), 0.1),
        "b_lambda_q2": nrm(ks[8], (DEPTH, HEAD_DIM), 0.1),
        "b_lambda_k2": nrm(ks[9], (DEPTH, HEAD_DIM), 0.1),
        "b_subln": 1.0 + nrm(ks[10], (DEPTH, B_VDIM), 0.05),
        "rel_bias": nrm(ks[11], (NUM_BUCKETS, B_HEADS), 0.5),
        "ln1_g": 1.0 + nrm(ks[12], (DEPTH, D_MODEL), 0.05),
        "ln1_b": nrm(ks[13], (DEPTH, D_MODEL), 0.01),
        "w_router": nrm(ks[14], (DEPTH, D_MODEL, N_EXPERTS), D_MODEL ** -0.5),
        "w_gate": nrm(ks[15], (DEPTH, N_EXPERTS, D_MODEL, D_EXPERT), D_MODEL ** -0.5),
        "w_up": nrm(ks[16], (DEPTH, N_EXPERTS, D_MODEL, D_EXPERT), D_MODEL ** -0.5 * beta),
        "w_down": nrm(ks[17], (DEPTH, N_EXPERTS, D_EXPERT, D_MODEL), D_EXPERT ** -0.5 * beta),
        "ln2_g": 1.0 + nrm(ks[18], (DEPTH, D_MODEL), 0.05),
        "ln2_b": nrm(ks[19], (DEPTH, D_MODEL), 0.01),
        "w_ple_gate": nrm(ks[20], (DEPTH, D_MODEL, D_MODEL), D_MODEL ** -0.5),
        "w_ple_proj": nrm(ks[21], (DEPTH, PLE_DIM, D_MODEL), PLE_DIM ** -0.5 * beta),
        "ln3_g": 1.0 + nrm(ks[22], (DEPTH, D_MODEL), 0.05),
        "ln3_b": nrm(ks[23], (DEPTH, D_MODEL), 0.01),
    }


def reference(x, p, w_in, w_out, a_q_norm, a_k_norm, b_lambda_q1, b_lambda_k1,
              b_lambda_q2, b_lambda_k2, b_subln, rel_bias, ln1_g, ln1_b, w_router,
              w_gate, w_up, w_down, ln2_g, ln2_b, w_ple_gate, w_ple_proj, ln3_g, ln3_b):
    b_, s_, _ = x.shape
    rows = s_ // GRID_W
    row = jnp.repeat(jnp.arange(rows, dtype=jnp.int32), GRID_W)
    col = jnp.tile(jnp.arange(GRID_W, dtype=jnp.int32), rows)
    splits = [A_Q, A_Q + A_KV, A_Q + 2 * A_KV, A_Q + 2 * A_KV + B_QK, A_Q + 2 * A_KV + 2 * B_QK]
    for i in range(DEPTH):
        lam_init = 0.8 - 0.6 * math.exp(-0.3 * i)
        cols = jnp.einsum('bsd,dn->bsn', x, w_in[i])
        qa, ka, va, qb, kb, vb = jnp.split(cols, splits, axis=-1)
        oa = mixer_gqa_axial(qa.reshape(b_, s_, A_HEADS, HEAD_DIM),
                             ka.reshape(b_, s_, A_KV_HEADS, HEAD_DIM),
                             va.reshape(b_, s_, A_KV_HEADS, HEAD_DIM),
                             a_q_norm[i], a_k_norm[i], row, col)
        ob = mixer_diff_attn(qb.reshape(b_, s_, B_HEADS, 2, HEAD_DIM),
                             kb.reshape(b_, s_, B_HEADS, 2, HEAD_DIM),
                             vb.reshape(b_, s_, B_HEADS, B_VDIM),
                             b_lambda_q1[i], b_lambda_k1[i], b_lambda_q2[i], b_lambda_k2[i],
                             b_subln[i], rel_bias, lam_init)
        mix = jnp.einsum('bsm,md->bsd', jnp.concatenate([oa, ob], axis=-1), w_out[i])
        x = layer_norm(DEEPNORM_ALPHA * x + mix, ln1_g[i], ln1_b[i])
        moe = expert_choice_moe(x, w_router[i], w_gate[i], w_up[i], w_down[i])
        x = layer_norm(DEEPNORM_ALPHA * x + moe, ln2_g[i], ln2_b[i])
        gate = jax.nn.sigmoid(jnp.einsum('bsd,de->bse', x, w_ple_gate[i]))
        ple = jnp.einsum('bsk,kd->bsd', p[i], w_ple_proj[i]) * gate
        x = layer_norm(DEEPNORM_ALPHA * x + ple, ln3_g[i], ln3_b[i])
    return x
```

```cpp
#include <hip/hip_runtime.h>
#include <hip/hip_cooperative_groups.h>
#include <hip/hip_bf16.h>
#include <cstdio>
#include <cstdint>
#include <cmath>
namespace cg = cooperative_groups;

#define LAS __attribute__((address_space(3)))
typedef unsigned short bf16_t;
typedef short bf16x8 __attribute__((ext_vector_type(8)));
typedef float f32x4 __attribute__((ext_vector_type(4)));
typedef float f32x2 __attribute__((ext_vector_type(2)));
typedef unsigned u32x4 __attribute__((ext_vector_type(4)));
typedef unsigned u32x2 __attribute__((ext_vector_type(2)));
typedef __bf16 bf16x2_t __attribute__((ext_vector_type(2)));
typedef int v8i32 __attribute__((ext_vector_type(8)));

constexpr int BATCH = 4, SEQ = 8192, DMODEL = 1024, MROWS = BATCH * SEQ;
constexpr int INW = 2304, NEXP = 16, CAP = 1024, DEXP = 2048, PLE = 256;
constexpr int VROWS = BATCH * NEXP * CAP;
constexpr float ALPHA = 1.189207115002721f, LN_EPS = 1e-5f, QK_EPS = 1e-6f;
constexpr float LOG2E = 1.4426950408889634f, C2 = 0.125f * LOG2E;
constexpr float LAM_INIT = 0.2f;
constexpr int COL_QA = 0, COL_KA = 512, COL_VA = 640, COL_QB = 768, COL_KB = 1280, COL_VB = 1792;

constexpr size_t MiB = 1u << 20;
constexpr size_t WS_AFF = 1 * MiB, WS_SLOT = 3 * MiB, WS_TOK = 5 * MiB, WS_GATE = 5 * MiB + 512 * 1024;
constexpr size_t WS_WIN = 8 * MiB, WS_WO = 13 * MiB, WS_WPG = 15 * MiB, WS_WPP = 17 * MiB;
constexpr size_t WS_WGU = 18 * MiB;
constexpr size_t WS_WD = 146 * MiB;
constexpr size_t WS_RH = 210 * MiB;
constexpr size_t WS_R3 = 466 * MiB;
constexpr size_t WS_PB = 530 * MiB;
constexpr size_t WS_END = 546 * MiB;

constexpr size_t OUT_Q8 = 0, OUT_K8 = 16 * MiB, OUT_VT8 = 20 * MiB;
constexpr int LDS_BYTES = 147456;
constexpr int NWAVES = 8;

struct Params {
    const float *x, *p, *w_in, *w_out, *a_q_norm, *a_k_norm, *lq1, *lk1, *lq2, *lk2, *subln, *rel_bias, *ln1_g, *ln1_b, *w_router,
                *w_gate, *w_up, *w_down, *ln2_g, *ln2_b, *w_pg, *w_pp, *ln3_g, *ln3_b;
    float* out; unsigned char* ws;
};

__device__ __forceinline__ unsigned cvtpk(float lo, float hi) { f32x2 v = {lo, hi}; bf16x2_t b = __builtin_convertvector(v, bf16x2_t); return __builtin_bit_cast(unsigned, b); }
__device__ __forceinline__ float bf_lo(unsigned w) { return __uint_as_float(w << 16); }
__device__ __forceinline__ float bf_hi(unsigned w) { return __uint_as_float(w & 0xffff0000u); }
template <int O> __device__ __forceinline__ float swz_xor(float v) { return __int_as_float(__builtin_amdgcn_ds_swizzle(__float_as_int(v), (O << 10) | 0x1f)); }
template <int O> __device__ __forceinline__ unsigned swz_xor_u(unsigned v) { return (unsigned)__builtin_amdgcn_ds_swizzle((int)v, (O << 10) | 0x1f); }
__device__ __forceinline__ float wave_sum(float v) {
    v += swz_xor<1>(v); v += swz_xor<2>(v); v += swz_xor<4>(v); v += swz_xor<8>(v); v += swz_xor<16>(v);
    auto rr = __builtin_amdgcn_permlane32_swap(__float_as_uint(v), __float_as_uint(v), false, false);
    return __uint_as_float(rr[0]) + __uint_as_float(rr[1]);
}
__device__ __forceinline__ float wave_max(float v) {
    v = fmaxf(v, swz_xor<1>(v)); v = fmaxf(v, swz_xor<2>(v)); v = fmaxf(v, swz_xor<4>(v)); v = fmaxf(v, swz_xor<8>(v)); v = fmaxf(v, swz_xor<16>(v));
    auto rr = __builtin_amdgcn_permlane32_swap(__float_as_uint(v), __float_as_uint(v), false, false);
    return fmaxf(__uint_as_float(rr[0]), __uint_as_float(rr[1]));
}
__device__ __forceinline__ unsigned wave_sum_u(unsigned v) {
    v += swz_xor_u<1>(v); v += swz_xor_u<2>(v); v += swz_xor_u<4>(v); v += swz_xor_u<8>(v); v += swz_xor_u<16>(v);
    auto rr = __builtin_amdgcn_permlane32_swap(v, v, false, false);
    return rr[0] + rr[1];
}
__device__ __forceinline__ unsigned pk_fp8x4(float a, float b, float c, float d) { int p = __builtin_amdgcn_cvt_pk_fp8_f32(a, b, 0, false); p = __builtin_amdgcn_cvt_pk_fp8_f32(c, d, p, true); return (unsigned)p; }
#define LDS_WAIT() asm volatile("s_waitcnt lgkmcnt(0)" ::: "memory")
__device__ __forceinline__ int ltid(int wv) { int l; asm volatile("v_mbcnt_lo_u32_b32 %0, -1, 0\n\tv_mbcnt_hi_u32_b32 %0, -1, %0" : "=v"(l)); return (wv << 6) | l; }

namespace pg8 {
constexpr int BM = 256, BK = 64, HALF = 128, HTB = HALF * BK * 2, STAGE_BYTES = 8 * HTB, NXCD = 8, WGM = 8;
__host__ __device__ __forceinline__ int lds_byte(int r, int c) { const int st = (r >> 4) * 2 + (c >> 5), rr = r & 15, cc = c & 31, ob = rr * 64 + cc * 2; return st * 1024 + (ob ^ (((ob >> 9) & 1) << 5)); }
__host__ __device__ __forceinline__ void stage_rc(int b, int& R, int& C) { const int st = b / 1024, sb = b % 1024, swz = sb ^ (((sb >> 9) & 1) << 5); R = (st >> 1) * 16 + swz / 64; C = (st & 1) * 32 + (swz % 64) / 2; }
__host__ __device__ __forceinline__ int perm32(int rho) { const int n = rho >> 4, i = rho & 15; return 8 * (i >> 2) + 4 * n + (i & 3); }
struct Unit { int pm, pn; };
struct Order {
    int nM, nN, nwg, G, c, pn0;
    __device__ __forceinline__ void init(int nM_, int nN_, int G_, int c_, int pn0_ = 0) { nM = nM_; nN = nN_; nwg = nM * nN; G = G_; c = c_; pn0 = pn0_; }
    __device__ __forceinline__ bool next(int i, Unit& u) const {
        const long L = (long)i * G + c; if (L >= nwg) return false;
        int wgid = (int)L; { const int q = nwg / NXCD, r = nwg % NXCD, xcd = wgid % NXCD, off = wgid / NXCD; wgid = (xcd < r ? xcd * (q + 1) : r * (q + 1) + (xcd - r) * q) + off; }
        const int nig = WGM * nN, gid = wgid / nig, fm = gid * WGM, gsz = (nM - fm) < WGM ? (nM - fm) : WGM;
        u.pm = fm + ((wgid % nig) % gsz); u.pn = pn0 + (wgid % nig) / gsz; return true;
    }
};
template <class Prob, class Epi, bool ALIGN_EPI>
__device__ __forceinline__ void gemm_phase(LAS unsigned char* lds, const Prob& S, const Epi& E, int wv) {
    int tid_ = ltid(wv);
    const int tid = tid_, wid = __builtin_amdgcn_readfirstlane(tid >> 6), lane = tid & 63, wr = wid >> 2, wc = wid & 3, fr = lane & 15, fq = lane >> 4;
    const int K = S.K, nt = K / BK;
    int Rr[2], Cc[2]; unsigned voffB[2];
#pragma unroll
    for (int i = 0; i < 2; ++i) { int R, C; stage_rc(tid * 16 + i * 8192, R, C); Rr[i] = R; Cc[i] = C; const int Rb = Epi::PERM ? ((R & ~31) + perm32(R & 31)) : R; voffB[i] = (unsigned)(Rb * K + C) * 2u; }
    const size_t kstep = (size_t)(BK * 2);
    const size_t hstepB = (size_t)HALF * K * 2;
    const unsigned ldsw = (unsigned)wid * 1024u;
    const int aoff = lds_byte(wr * 64 + fr, fq * 8), boff = lds_byte(wc * 32 + fr, fq * 8);
#define PG8_SA(b, h) (((b) * 2 + (h)) * HTB)
#define PG8_SB(b, h) ((4 + (b) * 2 + (h)) * HTB)
#define PG8_STAGEB(bufoff, gbase, voff) do { _Pragma("unroll") for (int _i = 0; _i < 2; ++_i) \
        __builtin_amdgcn_global_load_lds((const unsigned*)((const char*)(gbase) + (voff)[_i]), (LAS unsigned*)(lds + (bufoff) + ldsw + _i * 8192), 16, 0, 0); } while (0)
#define PG8_STAGEA(bufoff, kb, OFFh) do { _Pragma("unroll") for (int _i = 0; _i < 2; ++_i) \
        __builtin_amdgcn_global_load_lds((const unsigned*)(Ab + (kb) + (OFFh)[_i]), (LAS unsigned*)(lds + (bufoff) + ldsw + _i * 8192), 16, 0, 0); } while (0)
#define PG8_LDA(dst, b, h) do { _Pragma("unroll") for (int m = 0; m < 4; ++m) _Pragma("unroll") for (int k = 0; k < 2; ++k) dst[m][k] = *(const LAS bf16x8*)(lds + PG8_SA(b, h) + aoff + m * 2048 + k * 1024); } while (0)
#define PG8_LDB(dst, b, h) do { _Pragma("unroll") for (int n = 0; n < 2; ++n) _Pragma("unroll") for (int k = 0; k < 2; ++k) dst[n][k] = *(const LAS bf16x8*)(lds + PG8_SB(b, h) + boff + n * 2048 + k * 1024); } while (0)
#define PG8_MMA(ai, bj, At, Bt) do { __builtin_amdgcn_s_setprio(1); _Pragma("unroll") for (int m = 0; m < 4; ++m) _Pragma("unroll") for (int n = 0; n < 2; ++n) _Pragma("unroll") for (int k = 0; k < 2; ++k) \
        acc[ai][bj][m][n] = __builtin_amdgcn_mfma_f32_16x16x32_bf16(Bt[n][k], At[m][k], acc[ai][bj][m][n], 0, 0, 0); __builtin_amdgcn_s_setprio(0); } while (0)
#define PG8_WAIT_V(n) asm volatile("s_waitcnt vmcnt(" #n ")" ::: "memory")
#define PG8_WAIT_L(n) asm volatile("s_waitcnt lgkmcnt(" #n ")" ::: "memory")
#define PG8_BAR __builtin_amdgcn_s_barrier()
#define PG8_SCHED __builtin_amdgcn_sched_barrier(0)
    Unit cur, nxt; int ui = 0;
    if (!S.ord.next(0, cur)) return;
    f32x4 acc[2][2][4][2];
#pragma unroll
    for (int a = 0; a < 2; ++a)
#pragma unroll
        for (int b = 0; b < 2; ++b)
#pragma unroll
            for (int m = 0; m < 4; ++m)
#pragma unroll
                for (int n = 0; n < 2; ++n) acc[a][b][m][n] = (f32x4){0.f, 0.f, 0.f, 0.f};
    bf16x8 At[4][2], B0[2][2], B1[2][2];
    unsigned curA[2][2], nxtA[2][2];
    S.a_off(cur, Rr, Cc, curA);
    const char* Ab = S.A;
    const char* cB = S.b_base(cur);
    PG8_STAGEB(PG8_SB(0, 0), cB, voffB); PG8_STAGEB(PG8_SB(0, 1), cB + hstepB, voffB); PG8_STAGEA(PG8_SA(0, 0), 0, curA[0]); PG8_STAGEA(PG8_SA(0, 1), 0, curA[1]);
    if (wr == 1) PG8_BAR;
    PG8_WAIT_V(2); PG8_BAR;
    PG8_STAGEB(PG8_SB(1, 0), cB + kstep, voffB); PG8_STAGEA(PG8_SA(1, 0), kstep, curA[0]); PG8_STAGEB(PG8_SB(1, 1), cB + hstepB + kstep, voffB);
    PG8_WAIT_V(6); PG8_BAR;
    for (;;) {
        const bool has_next = S.ord.next(ui + 1, nxt);
        if (has_next) S.a_off(nxt, Rr, Cc, nxtA);
        else {
#pragma unroll
            for (int h = 0; h < 2; ++h)
#pragma unroll
                for (int i = 0; i < 2; ++i) nxtA[h][i] = curA[h][i];
        }
        const char* nB = has_next ? S.b_base(nxt) : cB;
        for (int t = 0; t < nt; t += 2) {
            const bool last = (t == nt - 2);
            const size_t k1 = (size_t)(t + 1) * kstep;
            const size_t k2 = last ? 0 : (size_t)(t + 2) * kstep; const char* b2 = last ? nB : cB + (size_t)(t + 2) * kstep;
            const size_t k3 = k2 + kstep; const char* b3 = b2 + kstep;
            unsigned a2o[2][2];
#pragma unroll
            for (int h = 0; h < 2; ++h)
#pragma unroll
                for (int i = 0; i < 2; ++i) a2o[h][i] = last ? nxtA[h][i] : curA[h][i];
            PG8_LDB(B0, 0, 0); PG8_LDB(B1, 0, 1); PG8_SCHED; PG8_LDA(At, 0, 0); PG8_STAGEA(PG8_SA(1, 1), k1, curA[1]);
            PG8_WAIT_V(8); PG8_WAIT_L(0); PG8_BAR; PG8_MMA(0, 0, At, B0); PG8_MMA(0, 1, At, B1); PG8_BAR; PG8_SCHED;
            PG8_LDA(At, 0, 1); PG8_STAGEB(PG8_SB(0, 0), b2, voffB); PG8_STAGEB(PG8_SB(0, 1), b2 + hstepB, voffB); PG8_STAGEA(PG8_SA(0, 0), k2, a2o[0]);
            PG8_WAIT_V(8); PG8_WAIT_L(0); PG8_BAR; PG8_MMA(1, 0, At, B0); PG8_MMA(1, 1, At, B1); PG8_BAR; PG8_SCHED;
            PG8_LDB(B0, 1, 0); PG8_LDB(B1, 1, 1); PG8_SCHED; PG8_LDA(At, 1, 0); PG8_STAGEA(PG8_SA(0, 1), k2, a2o[1]);
            PG8_WAIT_V(8); PG8_WAIT_L(0); PG8_BAR; PG8_MMA(0, 0, At, B0); PG8_MMA(0, 1, At, B1); PG8_BAR; PG8_SCHED;
            PG8_LDA(At, 1, 1); PG8_STAGEB(PG8_SB(1, 0), b3, voffB); PG8_STAGEB(PG8_SB(1, 1), b3 + hstepB, voffB); PG8_STAGEA(PG8_SA(1, 0), k3, a2o[0]);
            PG8_WAIT_V(8); PG8_WAIT_L(0); PG8_BAR; PG8_MMA(1, 0, At, B0); PG8_MMA(1, 1, At, B1); PG8_BAR; PG8_SCHED;
        }
        if constexpr (ALIGN_EPI) { if (wr == 0) PG8_BAR; }
        E(acc, cur, wr, wc, fr, fq);
        if (!has_next) break;
#pragma unroll
        for (int a = 0; a < 2; ++a)
#pragma unroll
            for (int b = 0; b < 2; ++b)
#pragma unroll
                for (int m = 0; m < 4; ++m)
#pragma unroll
                    for (int n = 0; n < 2; ++n) acc[a][b][m][n] = (f32x4){0.f, 0.f, 0.f, 0.f};
        cur = nxt; cB = nB; ++ui;
#pragma unroll
        for (int h = 0; h < 2; ++h)
#pragma unroll
            for (int i = 0; i < 2; ++i) curA[h][i] = nxtA[h][i];
        if constexpr (ALIGN_EPI) { if (wr == 1) PG8_BAR; }
    }
    PG8_WAIT_V(0);
    if constexpr (!ALIGN_EPI) { if (wr == 0) PG8_BAR; }
    PG8_BAR;
#undef PG8_SA
#undef PG8_SB
#undef PG8_STAGEA
#undef PG8_STAGEB
#undef PG8_LDA
#undef PG8_LDB
#undef PG8_MMA
#undef PG8_WAIT_V
#undef PG8_WAIT_L
#undef PG8_BAR
#undef PG8_SCHED
}
template <class Prob, class Epi, bool ALIGN_EPI>
__device__ __forceinline__ void gemm_phase_q(LAS unsigned char* lds, const Prob& S, const Epi& E, int wv) {
    int tid_ = ltid(wv);
    const int tid = tid_, wid = __builtin_amdgcn_readfirstlane(tid >> 6), lane = tid & 63, wr = wid >> 2, wc = wid & 3, fr = lane & 15, fq = lane >> 4;
    const int K = S.K, nt = K / BK;
    int Rr[2], Cc[2]; unsigned voffB[2];
#pragma unroll
    for (int i = 0; i < 2; ++i) { int R, C; stage_rc(tid * 16 + i * 8192, R, C); Rr[i] = R; Cc[i] = C; const int Rb = Epi::PERM ? ((R & ~31) + perm32(R & 31)) : R; voffB[i] = (unsigned)(Rb * K + C) * 2u; }
    const size_t kstep = (size_t)(BK * 2);
    const size_t hstepB = (size_t)HALF * K * 2;
    const unsigned ldsw = (unsigned)wid * 1024u;
    const int aq0 = lds_byte(wr * 64 + fr, fq * 8), aq1 = aq0 + 1024, bq0 = lds_byte(wc * 32 + fr, fq * 8), bq1 = bq0 + 1024;
    int sc_w = S.scale_b, sc_a = S.scale_a; asm volatile("" : "+v"(sc_w), "+v"(sc_a));
#define PG8_SA(b, h) (((b) * 2 + (h)) * HTB)
#define PG8_SB(b, h) ((4 + (b) * 2 + (h)) * HTB)
#define PG8_STAGEB(bufoff, gbase, voff) do { _Pragma("unroll") for (int _i = 0; _i < 2; ++_i) \
        __builtin_amdgcn_global_load_lds((const unsigned*)((const char*)(gbase) + (voff)[_i]), (LAS unsigned*)(lds + (bufoff) + ldsw + _i * 8192), 16, 0, 0); } while (0)
#define PG8_STAGEA(bufoff, kb, OFFh) do { _Pragma("unroll") for (int _i = 0; _i < 2; ++_i) \
        __builtin_amdgcn_global_load_lds((const unsigned*)(Ab + (kb) + (OFFh)[_i]), (LAS unsigned*)(lds + (bufoff) + ldsw + _i * 8192), 16, 0, 0); } while (0)
#define PG8_LDA(dst, b, h) do { _Pragma("unroll") for (int m = 0; m < 4; ++m) { const u32x4 l_ = *(const LAS u32x4*)(lds + PG8_SA(b, h) + aq0 + m * 2048), h_ = *(const LAS u32x4*)(lds + PG8_SA(b, h) + aq1 + m * 2048); \
        dst[m] = (v8i32){(int)l_.x, (int)l_.y, (int)l_.z, (int)l_.w, (int)h_.x, (int)h_.y, (int)h_.z, (int)h_.w}; } } while (0)
#define PG8_LDB(dst, b, h) do { _Pragma("unroll") for (int n = 0; n < 2; ++n) { const u32x4 l_ = *(const LAS u32x4*)(lds + PG8_SB(b, h) + bq0 + n * 2048), h_ = *(const LAS u32x4*)(lds + PG8_SB(b, h) + bq1 + n * 2048); \
        dst[n] = (v8i32){(int)l_.x, (int)l_.y, (int)l_.z, (int)l_.w, (int)h_.x, (int)h_.y, (int)h_.z, (int)h_.w}; } } while (0)
#define PG8_MMA(ai, bj, At, Bt) do { __builtin_amdgcn_s_setprio(1); _Pragma("unroll") for (int m = 0; m < 4; ++m) _Pragma("unroll") for (int n = 0; n < 2; ++n) \
        asm volatile("v_mfma_scale_f32_16x16x128_f8f6f4 %0, %1, %2, %0, %3, %4 op_sel_hi:[0,0,0]" : "+v"(acc[ai][bj][m][n]) : "v"(Bt[n]), "v"(At[m]), "v"(sc_w), "v"(sc_a)); __builtin_amdgcn_s_setprio(0); } while (0)
#define PG8_WAIT_V(n) asm volatile("s_waitcnt vmcnt(" #n ")" ::: "memory")
#define PG8_WAIT_L(n) asm volatile("s_waitcnt lgkmcnt(" #n ")" ::: "memory")
#define PG8_BAR __builtin_amdgcn_s_barrier()
#define PG8_SCHED __builtin_amdgcn_sched_barrier(0)
    Unit cur, nxt; int ui = 0;
    if (!S.ord.next(0, cur)) return;
    f32x4 acc[2][2][4][2];
#pragma unroll
    for (int a = 0; a < 2; ++a)
#pragma unroll
        for (int b = 0; b < 2; ++b)
#pragma unroll
            for (int m = 0; m < 4; ++m)
#pragma unroll
                for (int n = 0; n < 2; ++n) acc[a][b][m][n] = (f32x4){0.f, 0.f, 0.f, 0.f};
    v8i32 At[4], B0[2], B1[2];
    unsigned curA[2][2], nxtA[2][2];
    S.a_off(cur, Rr, Cc, curA);
    const char* Ab = S.A;
    const char* cB = S.b_base(cur);
    PG8_STAGEB(PG8_SB(0, 0), cB, voffB); PG8_STAGEB(PG8_SB(0, 1), cB + hstepB, voffB); PG8_STAGEA(PG8_SA(0, 0), 0, curA[0]); PG8_STAGEA(PG8_SA(0, 1), 0, curA[1]);
    if (wr == 1) PG8_BAR;
    PG8_WAIT_V(2); PG8_BAR;
    PG8_STAGEB(PG8_SB(1, 0), cB + kstep, voffB); PG8_STAGEA(PG8_SA(1, 0), kstep, curA[0]); PG8_STAGEB(PG8_SB(1, 1), cB + hstepB + kstep, voffB);
    PG8_WAIT_V(6); PG8_BAR;
    for (;;) {
        const bool has_next = S.ord.next(ui + 1, nxt);
        if (has_next) S.a_off(nxt, Rr, Cc, nxtA);
        else {
#pragma unroll
            for (int h = 0; h < 2; ++h)
#pragma unroll
                for (int i = 0; i < 2; ++i) nxtA[h][i] = curA[h][i];
        }
        const char* nB = has_next ? S.b_base(nxt) : cB;
        for (int t = 0; t < nt; t += 2) {
            const bool last = (t == nt - 2);
            const size_t k1 = (size_t)(t + 1) * kstep;
            const size_t k2 = last ? 0 : (size_t)(t + 2) * kstep; const char* b2 = last ? nB : cB + (size_t)(t + 2) * kstep;
            const size_t k3 = k2 + kstep; const char* b3 = b2 + kstep;
            unsigned a2o[2][2];
#pragma unroll
            for (int h = 0; h < 2; ++h)
#pragma unroll
                for (int i = 0; i < 2; ++i) a2o[h][i] = last ? nxtA[h][i] : curA[h][i];
            PG8_LDB(B0, 0, 0); PG8_LDB(B1, 0, 1); PG8_SCHED; PG8_LDA(At, 0, 0); PG8_STAGEA(PG8_SA(1, 1), k1, curA[1]);
            PG8_WAIT_V(8); PG8_WAIT_L(0); PG8_BAR; PG8_MMA(0, 0, At, B0); PG8_MMA(0, 1, At, B1); PG8_BAR; PG8_SCHED;
            PG8_LDA(At, 0, 1); PG8_STAGEB(PG8_SB(0, 0), b2, voffB); PG8_STAGEB(PG8_SB(0, 1), b2 + hstepB, voffB); PG8_STAGEA(PG8_SA(0, 0), k2, a2o[0]);
            PG8_WAIT_V(8); PG8_WAIT_L(0); PG8_BAR; PG8_MMA(1, 0, At, B0); PG8_MMA(1, 1, At, B1); PG8_BAR; PG8_SCHED;
            PG8_LDB(B0, 1, 0); PG8_LDB(B1, 1, 1); PG8_SCHED; PG8_LDA(At, 1, 0); PG8_STAGEA(PG8_SA(0, 1), k2, a2o[1]);
            PG8_WAIT_V(8); PG8_WAIT_L(0); PG8_BAR; PG8_MMA(0, 0, At, B0); PG8_MMA(0, 1, At, B1); PG8_BAR; PG8_SCHED;
            PG8_LDA(At, 1, 1); PG8_STAGEB(PG8_SB(1, 0), b3, voffB); PG8_STAGEB(PG8_SB(1, 1), b3 + hstepB, voffB); PG8_STAGEA(PG8_SA(1, 0), k3, a2o[0]);
            PG8_WAIT_V(8); PG8_WAIT_L(0); PG8_BAR; PG8_MMA(1, 0, At, B0); PG8_MMA(1, 1, At, B1); PG8_BAR; PG8_SCHED;
        }
        if constexpr (ALIGN_EPI) { if (wr == 0) PG8_BAR; }
#pragma unroll
        for (int a = 0; a < 2; ++a)
#pragma unroll
            for (int b = 0; b < 2; ++b) asm volatile("s_nop 15\n\ts_nop 15" : "+v"(acc[a][b][0][0]), "+v"(acc[a][b][0][1]), "+v"(acc[a][b][1][0]), "+v"(acc[a][b][1][1]), "+v"(acc[a][b][2][0]), "+v"(acc[a][b][2][1]), "+v"(acc[a][b][3][0]), "+v"(acc[a][b][3][1]));
        E(acc, cur, wr, wc, fr, fq);
        if (!has_next) break;
#pragma unroll
        for (int a = 0; a < 2; ++a)
#pragma unroll
            for (int b = 0; b < 2; ++b)
#pragma unroll
                for (int m = 0; m < 4; ++m)
#pragma unroll
                    for (int n = 0; n < 2; ++n) acc[a][b][m][n] = (f32x4){0.f, 0.f, 0.f, 0.f};
        cur = nxt; cB = nB; ++ui;
#pragma unroll
        for (int h = 0; h < 2; ++h)
#pragma unroll
            for (int i = 0; i < 2; ++i) curA[h][i] = nxtA[h][i];
        if constexpr (ALIGN_EPI) { if (wr == 1) PG8_BAR; }
    }
    PG8_WAIT_V(0);
    if constexpr (!ALIGN_EPI) { if (wr == 0) PG8_BAR; }
    PG8_BAR;
#undef PG8_SA
#undef PG8_SB
#undef PG8_STAGEA
#undef PG8_STAGEB
#undef PG8_LDA
#undef PG8_LDB
#undef PG8_MMA
#undef PG8_WAIT_V
#undef PG8_WAIT_L
#undef PG8_BAR
#undef PG8_SCHED
}
struct ProbPlain {
    int K; Order ord; const char* A; const char* Bt;
    __device__ __forceinline__ const char* b_base(const Unit& u) const { return Bt + (size_t)u.pn * 256 * K * 2; }
    __device__ __forceinline__ void a_off(const Unit& u, const int (&R)[2], const int (&C)[2], unsigned (&off)[2][2]) const {
#pragma unroll
        for (int h = 0; h < 2; ++h)
#pragma unroll
            for (int i = 0; i < 2; ++i) off[h][i] = (unsigned)((u.pm * 256 + h * 128 + R[i]) * K + C[i]) * 2u;
    }
};
struct ProbExpertGather {
    int K; Order ord; const char* A; const char* Bt; const int* tok;
    __device__ __forceinline__ const char* b_base(const Unit& u) const { return Bt + ((size_t)(u.pm >> 4) * 4096 + (size_t)u.pn * 256) * 1024 * 2; }
    __device__ __forceinline__ void a_off(const Unit& u, const int (&R)[2], const int (&C)[2], unsigned (&off)[2][2]) const {
#pragma unroll
        for (int h = 0; h < 2; ++h)
#pragma unroll
            for (int i = 0; i < 2; ++i) { const int row = tok[u.pm * 256 + h * 128 + R[i]]; off[h][i] = (unsigned)(row * 1024 + C[i]) * 2u; }
    }
};
struct ProbExpertDown {
    int K; Order ord; const char* A; const char* Bt;
    __device__ __forceinline__ const char* b_base(const Unit& u) const { return Bt + ((size_t)(u.pm >> 4) * 1024 + (size_t)u.pn * 256) * 2048 * 2; }
    __device__ __forceinline__ void a_off(const Unit& u, const int (&R)[2], const int (&C)[2], unsigned (&off)[2][2]) const {
#pragma unroll
        for (int h = 0; h < 2; ++h)
#pragma unroll
            for (int i = 0; i < 2; ++i) off[h][i] = (unsigned)((u.pm * 256 + h * 128 + R[i]) * 2048 + C[i]) * 2u;
    }
};
struct ProbExpertGatherQ {
    int K; int scale_a, scale_b; Order ord; const char* A; const char* Bt; const int* tok;
    __device__ __forceinline__ const char* b_base(const Unit& u) const { return Bt + ((size_t)(u.pm >> 4) * 4096 + (size_t)u.pn * 256) * 1024; }
    __device__ __forceinline__ void a_off(const Unit& u, const int (&R)[2], const int (&C)[2], unsigned (&off)[2][2]) const {
#pragma unroll
        for (int h = 0; h < 2; ++h)
#pragma unroll
            for (int i = 0; i < 2; ++i) { const int row = tok[u.pm * 256 + h * 128 + R[i]]; off[h][i] = (unsigned)(row * 512 + C[i]) * 2u; }
    }
};
struct ProbExpertDownQ {
    int K; int scale_a, scale_b; Order ord; const char* A; const char* Bt;
    __device__ __forceinline__ const char* b_base(const Unit& u) const { return Bt + ((size_t)(u.pm >> 4) * 1024 + (size_t)u.pn * 256) * 2048; }
    __device__ __forceinline__ void a_off(const Unit& u, const int (&R)[2], const int (&C)[2], unsigned (&off)[2][2]) const {
#pragma unroll
        for (int h = 0; h < 2; ++h)
#pragma unroll
            for (int i = 0; i < 2; ++i) off[h][i] = (unsigned)((u.pm * 256 + h * 128 + R[i]) * 1024 + C[i]) * 2u;
    }
};
struct EpiQKV {
    static constexpr bool PERM = true; bf16_t* O; unsigned* bnd;
    __device__ __forceinline__ void operator()(const f32x4 (&acc)[2][2][4][2], const Unit& u, int wr, int wc, int fr, int fq) const {
        const int row0 = u.pm * 256 + wr * 64 + fr, col0 = u.pn * 256 + wc * 32 + 8 * fq;
        const float sc = (u.pn == 3 || u.pn == 4) ? C2 : 1.f;
        const bool track = (u.pn >= 3 && u.pn <= 6);
        float mx = 0.f;
#pragma unroll
        for (int ai = 0; ai < 2; ++ai)
#pragma unroll
            for (int m = 0; m < 4; ++m) { bf16_t* rowp = O + (size_t)(row0 + ai * 128 + m * 16) * INW + col0;
#pragma unroll
                for (int bj = 0; bj < 2; ++bj) { const f32x4 v0 = acc[ai][bj][m][0] * sc, v1 = acc[ai][bj][m][1] * sc;
                    u32x4 w; w.x = cvtpk(v0[0], v0[1]); w.y = cvtpk(v0[2], v0[3]); w.z = cvtpk(v1[0], v1[1]); w.w = cvtpk(v1[2], v1[3]);
                    *(u32x4*)(rowp + bj * 128) = w;
                    if (track) { float ss = (v0[0] * v0[0] + v0[1] * v0[1]) + (v0[2] * v0[2] + v0[3] * v0[3]) + (v1[0] * v1[0] + v1[1] * v1[1]) + (v1[2] * v1[2] + v1[3] * v1[3]);
                        ss += swz_xor<16>(ss); { auto rr = __builtin_amdgcn_permlane32_swap(__float_as_uint(ss), __float_as_uint(ss), false, false); ss = __uint_as_float(rr[0]) + __uint_as_float(rr[1]); }
                        mx = fmaxf(mx, ss); } } }
        if (track) { mx = wave_max(mx) * 1.02f;
            if (fr == 0 && fq == 0) atomicMax(bnd + (u.pn >= 5 ? 64 : 0), __float_as_uint(mx)); }
    }
};
struct EpiBf16Plain {
    static constexpr bool PERM = true; bf16_t* O; int ldc;
    __device__ __forceinline__ void operator()(const f32x4 (&acc)[2][2][4][2], const Unit& u, int wr, int wc, int fr, int fq) const {
        const int row0 = u.pm * 256 + wr * 64 + fr, col0 = u.pn * 256 + wc * 32 + 8 * fq;
#pragma unroll
        for (int ai = 0; ai < 2; ++ai)
#pragma unroll
            for (int m = 0; m < 4; ++m) { bf16_t* rowp = O + (size_t)(row0 + ai * 128 + m * 16) * ldc + col0;
#pragma unroll
                for (int bj = 0; bj < 2; ++bj) { const f32x4 v0 = acc[ai][bj][m][0], v1 = acc[ai][bj][m][1];
                    u32x4 w; w.x = cvtpk(v0[0], v0[1]); w.y = cvtpk(v0[2], v0[3]); w.z = cvtpk(v1[0], v1[1]); w.w = cvtpk(v1[2], v1[3]);
                    *(u32x4*)(rowp + bj * 128) = w; } }
    }
};
struct EpiResF32 {
    static constexpr bool PERM = false; const bf16_t* xb; float* out;
    __device__ __forceinline__ void operator()(const f32x4 (&acc)[2][2][4][2], const Unit& u, int wr, int wc, int fr, int fq) const {
        const int col0 = u.pn * 256 + wc * 32 + 4 * fq;
#pragma unroll
        for (int ai = 0; ai < 2; ++ai)
#pragma unroll
            for (int m = 0; m < 4; ++m) { const size_t off = (size_t)(u.pm * 256 + ai * 128 + wr * 64 + m * 16 + fr) * DMODEL + col0;
#pragma unroll
                for (int bj = 0; bj < 2; ++bj)
#pragma unroll
                    for (int n = 0; n < 2; ++n) { const u32x2 w = *(const u32x2*)(xb + off + bj * 128 + n * 16); const f32x4 bs = {bf_lo(w.x), bf_hi(w.x), bf_lo(w.y), bf_hi(w.y)};
                        *(f32x4*)(out + off + bj * 128 + n * 16) = bs * ALPHA + acc[ai][bj][m][n]; } }
    }
};
__device__ __forceinline__ float silu_mul(float g, float u) { return g * __builtin_amdgcn_rcpf(1.f + __builtin_amdgcn_exp2f(-g * LOG2E)) * u; }
struct EpiSwiGLU {
    static constexpr bool PERM = true; unsigned char* H;
    __device__ __forceinline__ void operator()(const f32x4 (&acc)[2][2][4][2], const Unit& u, int wr, int wc, int fr, int fq) const {
        const int row0 = u.pm * 256 + wr * 64 + fr, col0 = u.pn * 128 + wc * 32 + 8 * fq;
#pragma unroll
        for (int ai = 0; ai < 2; ++ai)
#pragma unroll
            for (int m = 0; m < 4; ++m) { unsigned char* rowp = H + (size_t)(row0 + ai * 128 + m * 16) * DEXP + col0;
                const f32x4 g0 = acc[ai][0][m][0], g1 = acc[ai][0][m][1], u0 = acc[ai][1][m][0], u1 = acc[ai][1][m][1];
                u32x2 w; w.x = pk_fp8x4(silu_mul(g0[0], u0[0]) * 16.f, silu_mul(g0[1], u0[1]) * 16.f, silu_mul(g0[2], u0[2]) * 16.f, silu_mul(g0[3], u0[3]) * 16.f);
                w.y = pk_fp8x4(silu_mul(g1[0], u1[0]) * 16.f, silu_mul(g1[1], u1[1]) * 16.f, silu_mul(g1[2], u1[2]) * 16.f, silu_mul(g1[3], u1[3]) * 16.f);
                __builtin_nontemporal_store(w, (u32x2*)rowp); }
    }
};
struct EpiDown {
    static constexpr bool PERM = true; bf16_t* O; const float* gate;
    __device__ __forceinline__ void operator()(const f32x4 (&acc)[2][2][4][2], const Unit& u, int wr, int wc, int fr, int fq) const {
        const int row0 = u.pm * 256 + wr * 64 + fr, col0 = u.pn * 256 + wc * 32 + 8 * fq;
#pragma unroll
        for (int ai = 0; ai < 2; ++ai)
#pragma unroll
            for (int m = 0; m < 4; ++m) { const int r = row0 + ai * 128 + m * 16; const float g = gate[r]; bf16_t* rowp = O + (size_t)r * DMODEL + col0;
#pragma unroll
                for (int bj = 0; bj < 2; ++bj) { const f32x4 v0 = acc[ai][bj][m][0] * g, v1 = acc[ai][bj][m][1] * g;
                    u32x4 w; w.x = cvtpk(v0[0], v0[1]); w.y = cvtpk(v0[2], v0[3]); w.z = cvtpk(v1[0], v1[1]); w.w = cvtpk(v1[2], v1[3]);
                    __builtin_nontemporal_store(w, (u32x4*)(rowp + bj * 128)); } }
    }
};
__device__ __forceinline__ float sigm(float a) { return __builtin_amdgcn_rcpf(1.f + __builtin_amdgcn_exp2f(-a * LOG2E)); }
struct EpiPLE {
    static constexpr bool PERM = true; const bf16_t* x2b; const bf16_t* pj; bf16_t* y3;
    __device__ __forceinline__ void operator()(const f32x4 (&acc)[2][2][4][2], const Unit& u, int wr, int wc, int fr, int fq) const {
        const int row0 = u.pm * 256 + wr * 64 + fr, col0 = u.pn * 256 + wc * 32 + 8 * fq;
#pragma unroll
        for (int ai = 0; ai < 2; ++ai)
#pragma unroll
            for (int m = 0; m < 4; ++m) { const size_t off = (size_t)(row0 + ai * 128 + m * 16) * DMODEL + col0;
#pragma unroll
                for (int bj = 0; bj < 2; ++bj) { const u32x4 xw = *(const u32x4*)(x2b + off + bj * 128), pw = *(const u32x4*)(pj + off + bj * 128);
                    const f32x4 a0 = acc[ai][bj][m][0], a1 = acc[ai][bj][m][1]; u32x4 w;
                    w.x = cvtpk(bf_lo(xw.x) * ALPHA + sigm(a0[0]) * bf_lo(pw.x), bf_hi(xw.x) * ALPHA + sigm(a0[1]) * bf_hi(pw.x));
                    w.y = cvtpk(bf_lo(xw.y) * ALPHA + sigm(a0[2]) * bf_lo(pw.y), bf_hi(xw.y) * ALPHA + sigm(a0[3]) * bf_hi(pw.y));
                    w.z = cvtpk(bf_lo(xw.z) * ALPHA + sigm(a1[0]) * bf_lo(pw.z), bf_hi(xw.z) * ALPHA + sigm(a1[1]) * bf_hi(pw.z));
                    w.w = cvtpk(bf_lo(xw.w) * ALPHA + sigm(a1[2]) * bf_lo(pw.w), bf_hi(xw.w) * ALPHA + sigm(a1[3]) * bf_hi(pw.w));
                    *(u32x4*)(y3 + off + bj * 128) = w; } }
    }
};
}

namespace attn_body {
using bf16 = __hip_bfloat16;
using s16x4 = __attribute__((ext_vector_type(4))) short;
using f32x16 = __attribute__((ext_vector_type(16))) float;
constexpr int D = 64, PITCH = INW, OPITCH = DMODEL;
constexpr int NW = 8, QBLK = 32, QB = QBLK * NW, KVBLK = 64, NT = SEQ / KVBLK;
__device__ __forceinline__ int crow(int r, int hi) { return (r & 3) + 8 * (r >> 2) + 4 * hi; }
#define SBAR() __builtin_amdgcn_sched_barrier(0)
constexpr int NSLOT = 3, SLOTB = 8192;
constexpr int LDS_K = 0, LDS_V = NSLOT * SLOTB, LDS_WS = 2 * NSLOT * SLOTB, LDS_OST = LDS_WS + NW * 64 * 4, ATT_LDS_BYTES = LDS_OST + NW * 4096;
constexpr int LDS_STASH = 75776;
constexpr int LDS_TAB = 141312;
__device__ __forceinline__ void glds16(const void* gsrc, unsigned lds_dst) { unsigned keep;
    asm volatile("s_mov_b32 %0, m0\n\ts_mov_b32 m0, %2\n\ts_nop 0\n\tglobal_load_lds_dwordx4 %1, off\n\ts_mov_b32 m0, %0" : "=&s"(keep) : "v"(gsrc), "s"(lds_dst) : "memory"); }
__device__ __forceinline__ float max3f(float a, float b, float c) { float r; asm("v_max3_f32 %0, %1, %2, %3" : "=v"(r) : "v"(a), "v"(b), "v"(c)); return r; }
__device__ __forceinline__ float max2f(float a, float b) { float r; asm("v_max_f32_e32 %0, %1, %2" : "=v"(r) : "v"(a), "v"(b)); return r; }
__device__ __forceinline__ float fadd_s(float a, float b) { float r; asm("v_add_f32_e32 %0, %1, %2" : "=v"(r) : "v"(a), "v"(b)); return r; }
__device__ __forceinline__ float fsub_s(float a, float b) { float r; asm("v_sub_f32_e32 %0, %1, %2" : "=v"(r) : "v"(a), "v"(b)); return r; }
#define WAIT_BAR(N) asm volatile("s_waitcnt vmcnt(" #N ") lgkmcnt(0)\n\ts_barrier" ::: "memory")
__device__ __forceinline__ void qkt(f32x16& p0, f32x16& p1, const char* Kslot, const bf16x8* qr, const f32x16& negm, int r32, int hi) {
    const char* kb = Kslot + hi * 1024 + r32 * 16;
#pragma unroll
    for (int d0 = 0; d0 < 4; ++d0) {
        const bf16x8 b0 = *reinterpret_cast<const bf16x8*>(kb + d0 * 2048);
        const bf16x8 b1 = *reinterpret_cast<const bf16x8*>(kb + d0 * 2048 + 512);
        if (d0 == 0) { p0 = __builtin_amdgcn_mfma_f32_32x32x16_bf16(b0, qr[0], negm, 0, 0, 0); p1 = __builtin_amdgcn_mfma_f32_32x32x16_bf16(b1, qr[0], negm, 0, 0, 0); }
        else { p0 = __builtin_amdgcn_mfma_f32_32x32x16_bf16(b0, qr[d0], p0, 0, 0, 0); p1 = __builtin_amdgcn_mfma_f32_32x32x16_bf16(b1, qr[d0], p1, 0, 0, 0); } }
}
typedef __attribute__((address_space(3))) const char* lds_cptr;
typedef short v4i16_t __attribute__((ext_vector_type(4)));
__device__ __forceinline__ void kload8(bf16x8* kf, lds_cptr kp) {
    kf[0] = *(const LAS bf16x8*)(kp);        kf[1] = *(const LAS bf16x8*)(kp + 512);
    kf[2] = *(const LAS bf16x8*)(kp + 2048); kf[3] = *(const LAS bf16x8*)(kp + 2560);
    kf[4] = *(const LAS bf16x8*)(kp + 4096); kf[5] = *(const LAS bf16x8*)(kp + 4608);
    kf[6] = *(const LAS bf16x8*)(kp + 6144); kf[7] = *(const LAS bf16x8*)(kp + 6656);
}
__device__ __forceinline__ void kload2(bf16x8* kf, lds_cptr kp, int j) { kf[2 * j] = *(const LAS bf16x8*)(kp + j * 2048); kf[2 * j + 1] = *(const LAS bf16x8*)(kp + j * 2048 + 512); }
__device__ __forceinline__ s16x4 vtr(lds_cptr p) { return __builtin_bit_cast(s16x4, __builtin_amdgcn_ds_read_tr16_b64_v4i16((LAS v4i16_t*)p)); }
__device__ __forceinline__ float rowmax(const f32x16& p0, const f32x16& p1) {
    float a = max3f(p0[0], p0[1], p1[0]), b = max3f(p0[2], p0[3], p1[1]); a = max3f(a, p1[2], p1[3]);
#pragma unroll
    for (int r = 4; r < 16; r += 4) { a = max3f(a, p0[r], p0[r + 1]); b = max3f(b, p0[r + 2], p0[r + 3]); a = max3f(a, p1[r], p1[r + 1]); b = max3f(b, p1[r + 2], p1[r + 3]); }
    const float m = max2f(a, b);
    auto rr = __builtin_amdgcn_permlane32_swap(__float_as_uint(m), __float_as_uint(m), false, false);
    return max2f(__uint_as_float(rr[0]), __uint_as_float(rr[1]));
}
__device__ __forceinline__ void pv(f32x16* o, int vb, bf16x8 pa0, bf16x8 pa1, bf16x8 pa2, bf16x8 pa3) {
#pragma unroll
    for (int d0 = 0; d0 < 2; ++d0) { s16x4 lo[4], hi[4];
#pragma unroll
        for (int ks = 0; ks < 4; ++ks) {
            asm volatile("ds_read_b64_tr_b16 %0,%1 offset:%c2" : "=&v"(lo[ks]) : "v"(vb), "i"(d0 * 4096 + ks * 1024) : "memory");
            asm volatile("ds_read_b64_tr_b16 %0,%1 offset:%c2" : "=&v"(hi[ks]) : "v"(vb), "i"(d0 * 4096 + ks * 1024 + 512) : "memory"); }
        asm volatile("s_waitcnt lgkmcnt(0)" ::: "memory"); SBAR();
#define PK(k) (bf16x8){lo[k][0], lo[k][1], lo[k][2], lo[k][3], hi[k][0], hi[k][1], hi[k][2], hi[k][3]}
        o[d0] = __builtin_amdgcn_mfma_f32_32x32x16_bf16(pa0, PK(0), o[d0], 0, 0, 0);
        o[d0] = __builtin_amdgcn_mfma_f32_32x32x16_bf16(pa1, PK(1), o[d0], 0, 0, 0);
        o[d0] = __builtin_amdgcn_mfma_f32_32x32x16_bf16(pa2, PK(2), o[d0], 0, 0, 0);
        o[d0] = __builtin_amdgcn_mfma_f32_32x32x16_bf16(pa3, PK(3), o[d0], 0, 0, 0);
#undef PK
    }
}
template <int THRL> __device__ __forceinline__ void attn_unit(const bf16* Qp, const bf16* __restrict__ Kp, const bf16* __restrict__ Vp, bf16* Op, int q0, char* shm, int wv) {
    int tid_ = ltid(wv);
    const int tid = tid_, lane = tid & 63, r32 = lane & 31, hi = lane >> 5; const int wid = __builtin_amdgcn_readfirstlane(tid >> 6);
    const bf16* Qw = Qp + (long)(q0 + wid * QBLK) * PITCH;
    const unsigned lds0 = (unsigned)(uintptr_t)shm;
    float* wsf = (float*)(shm + LDS_WS) + wid * 64;
    const bf16* ksrc = Kp + (long)lane * PITCH + wid * 8;
    const bf16* vsrc = Vp + (long)(16 * (wid & 3) + (lane >> 2)) * PITCH + (wid >> 2) * 32 + (lane & 3) * 8;
    const unsigned kdst = lds0 + LDS_K + wid * 1024, vdst = lds0 + LDS_V + wid * 1024;
#define DMA_K(t, slot) glds16(ksrc + (long)(t) * KVBLK * PITCH, (unsigned)__builtin_amdgcn_readfirstlane(kdst + (slot)))
#define DMA_V(t, slot) glds16(vsrc + (long)(t) * KVBLK * PITCH, (unsigned)__builtin_amdgcn_readfirstlane(vdst + (slot)))
    const int vb0 = (int)(lds0 + LDS_V) + ((lane >> 4) & 1) * 32 + (lane & 3) * 8 + (4 * hi + ((lane & 15) >> 2)) * 64;
    const char* Kbase = shm + LDS_K; bf16x8 kf[8];
    const lds_cptr shm3 = (lds_cptr)shm; const lds_cptr kp0 = shm3 + LDS_K + hi * 1024 + r32 * 16; const lds_cptr vp0 = shm3 + LDS_V + ((lane >> 4) & 1) * 32 + (lane & 3) * 8 + (4 * hi + ((lane & 15) >> 2)) * 64;
    DMA_K(0, 0); DMA_V(0, 0); DMA_K(1, SLOTB);
    bf16x8 qr[4];
#pragma unroll
    for (int d0 = 0; d0 < 4; ++d0) qr[d0] = *reinterpret_cast<const bf16x8*>(&Qw[(long)r32 * PITCH + d0 * 16 + hi * 8]);
    const float cb = 0.f;
    float mhat = 0.f, l_reg = 0.f; f32x16 o[2]; o[0] = f32x16{}; o[1] = f32x16{}; f32x16 negm;
#pragma unroll
    for (int r = 0; r < 16; ++r) negm[r] = cb;
    asm volatile("" : "+v"(negm));
#define BIASADD(C0, C1, t) do { } while (0)
#define NEGM_UPD(tn) do { } while (0)
    bool resc = false;
#define START(P0, P1) do { const float rm = rowmax(P0, P1); resc = false; \
    { const float dl = rm; mhat = fadd_s(mhat, dl); \
      _Pragma("unroll") for (int r = 0; r < 16; ++r) { P0[r] = fsub_s(P0[r], dl); P1[r] = fsub_s(P1[r], dl); } \
      _Pragma("unroll") for (int r = 0; r < 16; ++r) negm[r] = cb - mhat; asm volatile("" : "+v"(negm)); } \
    _Pragma("unroll") for (int r = 0; r < 16; ++r) P0[r] = __builtin_amdgcn_exp2f(P0[r]); } while (0)
#define RESC() do { if (resc) { asm volatile("s_waitcnt lgkmcnt(0)" ::: "memory"); \
      _Pragma("unroll") for (int d_ = 0; d_ < 2; ++d_) _Pragma("unroll") for (int r = 0; r < 16; ++r) o[d_][r] *= wsf[crow(r, hi)]; } } while (0)
    f32x16 pA0, pA1, pB0, pB1;
    int sl_prev = 0, sl_cur = 0, sl_next = SLOTB;
#define ROT() do { sl_prev = sl_cur; sl_cur = sl_next; sl_next = (sl_next == (NSLOT - 1) * SLOTB) ? 0 : sl_next + SLOTB; } while (0)
    DMA_K(2, 2 * SLOTB);
    WAIT_BAR(3);
    qkt(pA0, pA1, Kbase, qr, negm, r32, hi); asm volatile("s_nop 15\n\ts_nop 7" : "+v"(pA0), "+v"(pA1)); BIASADD(pA0, pA1, 0);
    START(pA0, pA1);
    _Pragma("unroll") for (int r = 0; r < 16; ++r) pA1[r] = __builtin_amdgcn_exp2f(pA1[r]);
    WAIT_BAR(0);
    DMA_K(3, 0); DMA_V(1, SLOTB);
    ROT();
    kload8(kf, kp0 + sl_cur);
    NEGM_UPD(1);
    WAIT_BAR(2);
    s16x4 vlo[8], vhi[8]; u32x4 pw0, pw1, pw2, pw3;
#define PKW(P, B) cvtpk(P[B], P[B + 1])
#define PAF(k) __builtin_bit_cast(bf16x8, pw##k)
#define VFR(i) (bf16x8){vlo[i][0], vlo[i][1], vlo[i][2], vlo[i][3], vhi[i][0], vhi[i][1], vhi[i][2], vhi[i][3]}
#define PIN(x) asm volatile("" : "+v"(x))
#define MX3(a, b, c) __builtin_fmaxf(__builtin_fmaxf((a), (b)), (c))
#define GAPA(MF, A0, A1, A2, A3, W0, W1, PW) do { MF; sacc += A0; sacc += A1; sacc += A2; sacc += A3; PIN(sacc); W0; W1; PIN(PW); SBAR(); } while (0)
#define EX(v) __builtin_amdgcn_exp2f(v)
#define GAPB(MF, X, B) do { MF; X[B] = EX(X[B]); X[B + 1] = EX(X[B + 1]); X[B + 2] = EX(X[B + 2]); X[B + 3] = EX(X[B + 3]); PIN(X); SBAR(); } while (0)
#define VRD(i) do { vlo[i] = vtr(vp_ + (((i) >> 2) * 4096 + ((i) & 3) * 1024)); vhi[i] = vtr(vp_ + (((i) >> 2) * 4096 + ((i) & 3) * 1024 + 512)); } while (0)
#define KRD(G, j) do { if (G) { kload2(kf, kp0 + sl_next, j); SBAR(); } } while (0)
#define STEP(C0, C1, P0, P1, t, GK, GV, GL) do { SBAR(); \
    const lds_cptr vp_ = vp0 + sl_prev; \
    VRD(0); SBAR(); float sacc = (P0[0] + P0[1]); \
    GAPA(C0 = __builtin_amdgcn_mfma_f32_32x32x16_bf16(kf[0], qr[0], negm, 0, 0, 0), P0[2], P0[3], P0[4], P0[5],     pw0[0] = PKW(P0, 0), pw0[1] = PKW(P0, 2), pw0); \
    VRD(4); SBAR(); GAPA(C1 = __builtin_amdgcn_mfma_f32_32x32x16_bf16(kf[1], qr[0], negm, 0, 0, 0), P0[6], P0[7], P0[8], P0[9],     pw0[2] = PKW(P0, 4), pw0[3] = PKW(P0, 6), pw0); \
    VRD(1); SBAR(); GAPA(C0 = __builtin_amdgcn_mfma_f32_32x32x16_bf16(kf[2], qr[1], C0, 0, 0, 0),   P0[10], P0[11], P0[12], P0[13], pw1[0] = PKW(P0, 8), pw1[1] = PKW(P0, 10), pw1); \
    VRD(5); SBAR(); GAPA(C1 = __builtin_amdgcn_mfma_f32_32x32x16_bf16(kf[3], qr[1], C1, 0, 0, 0),   P0[14], P0[15], P1[0], P1[1],   pw1[2] = PKW(P0, 12), pw1[3] = PKW(P0, 14), pw1); \
    VRD(2); SBAR(); GAPA(C0 = __builtin_amdgcn_mfma_f32_32x32x16_bf16(kf[4], qr[2], C0, 0, 0, 0),   P1[2], P1[3], P1[4], P1[5],     pw2[0] = PKW(P1, 0), pw2[1] = PKW(P1, 2), pw2); \
    VRD(6); SBAR(); GAPA(C1 = __builtin_amdgcn_mfma_f32_32x32x16_bf16(kf[5], qr[2], C1, 0, 0, 0),   P1[6], P1[7], P1[8], P1[9],     pw2[2] = PKW(P1, 4), pw2[3] = PKW(P1, 6), pw2); \
    VRD(3); SBAR(); GAPA(C0 = __builtin_amdgcn_mfma_f32_32x32x16_bf16(kf[6], qr[3], C0, 0, 0, 0),   P1[10], P1[11], P1[12], P1[13], pw3[0] = PKW(P1, 8), pw3[1] = PKW(P1, 10), pw3); \
    VRD(7); SBAR(); GAPA(C1 = __builtin_amdgcn_mfma_f32_32x32x16_bf16(kf[7], qr[3], C1, 0, 0, 0),   P1[14], P1[15], 0.f, 0.f,       pw3[2] = PKW(P1, 12), pw3[3] = PKW(P1, 14), pw3); \
    l_reg += sacc; \
    if (GK) { DMA_K((t) + 3, sl_cur); } if (GV) { DMA_V((t) + 1, sl_next); } \
    BIASADD(C0, C1, t); \
    { float a = MX3(C0[0], C0[1], C1[0]), b = MX3(C0[2], C0[3], C1[1]); a = MX3(a, C1[2], C1[3]); \
      _Pragma("unroll") for (int r = 4; r < 16; r += 4) { a = MX3(a, C0[r], C0[r + 1]); b = MX3(b, C0[r + 2], C0[r + 3]); a = MX3(a, C1[r], C1[r + 1]); b = MX3(b, C1[r + 2], C1[r + 3]); } \
      float rm = __builtin_fmaxf(a, b); { auto rr = __builtin_amdgcn_permlane32_swap(__float_as_uint(rm), __float_as_uint(rm), false, false); rm = __builtin_fmaxf(__uint_as_float(rr[0]), __uint_as_float(rr[1])); } \
      resc = false; \
      if (__builtin_expect(__any(rm > (float)THRL), 0)) { const float dl = __builtin_fmaxf(rm, 0.f); mhat += dl; \
        _Pragma("unroll") for (int r = 0; r < 16; ++r) { C0[r] -= dl; C1[r] -= dl; } \
        _Pragma("unroll") for (int r = 0; r < 16; ++r) negm[r] = cb - mhat; asm volatile("" : "+v"(negm)); \
        const float f = __builtin_amdgcn_exp2f(-dl); l_reg *= f; if (hi == 0) wsf[r32] = f; resc = true; } } \
    SBAR(); \
    GAPB(o[0] = __builtin_amdgcn_mfma_f32_32x32x16_bf16(PAF(0), VFR(0), o[0], 0, 0, 0), C0, 0); \
    GAPB(o[1] = __builtin_amdgcn_mfma_f32_32x32x16_bf16(PAF(0), VFR(4), o[1], 0, 0, 0), C0, 4); \
    KRD(GL, 0); GAPB(o[0] = __builtin_amdgcn_mfma_f32_32x32x16_bf16(PAF(1), VFR(1), o[0], 0, 0, 0), C0, 8); \
    KRD(GL, 1); GAPB(o[1] = __builtin_amdgcn_mfma_f32_32x32x16_bf16(PAF(1), VFR(5), o[1], 0, 0, 0), C0, 12); \
    KRD(GL, 2); GAPB(o[0] = __builtin_amdgcn_mfma_f32_32x32x16_bf16(PAF(2), VFR(2), o[0], 0, 0, 0), C1, 0); \
    KRD(GL, 3); GAPB(o[1] = __builtin_amdgcn_mfma_f32_32x32x16_bf16(PAF(2), VFR(6), o[1], 0, 0, 0), C1, 4); \
    GAPB(o[0] = __builtin_amdgcn_mfma_f32_32x32x16_bf16(PAF(3), VFR(3), o[0], 0, 0, 0), C1, 8); \
    GAPB(o[1] = __builtin_amdgcn_mfma_f32_32x32x16_bf16(PAF(3), VFR(7), o[1], 0, 0, 0), C1, 12); \
    } while (0)
    int t = 1;
    for (; t + 5 < NT; t += 2) {
        STEP(pB0, pB1, pA0, pA1, t, true, true, true);     WAIT_BAR(2); RESC(); ROT(); NEGM_UPD(t + 1);
        STEP(pA0, pA1, pB0, pB1, t + 1, true, true, true); WAIT_BAR(2); RESC(); ROT(); NEGM_UPD(t + 2);
    }
#define ENDW(tt) do { if ((tt) + 3 < NT) { WAIT_BAR(2); } else if ((tt) + 2 < NT) { WAIT_BAR(1); } else { WAIT_BAR(0); } } while (0)
    for (; t + 1 < NT; t += 2) {
        STEP(pB0, pB1, pA0, pA1, t, (t + 3 < NT), (t + 1 < NT), (t + 1 < NT));       ENDW(t);     RESC(); ROT(); NEGM_UPD(t + 1);
        STEP(pA0, pA1, pB0, pB1, t + 1, (t + 4 < NT), (t + 2 < NT), (t + 2 < NT));   ENDW(t + 1); RESC(); ROT(); NEGM_UPD(t + 2);
    }
    STEP(pB0, pB1, pA0, pA1, NT - 1, false, false, false); RESC();
    { float sacc = pB0[0] + pB0[1]; _Pragma("unroll") for (int r = 2; r < 16; ++r) sacc += pB0[r]; _Pragma("unroll") for (int r = 0; r < 16; ++r) sacc += pB1[r]; l_reg += sacc;
      pw0 = (u32x4){PKW(pB0, 0), PKW(pB0, 2), PKW(pB0, 4), PKW(pB0, 6)}; pw1 = (u32x4){PKW(pB0, 8), PKW(pB0, 10), PKW(pB0, 12), PKW(pB0, 14)}; pw2 = (u32x4){PKW(pB1, 0), PKW(pB1, 2), PKW(pB1, 4), PKW(pB1, 6)}; pw3 = (u32x4){PKW(pB1, 8), PKW(pB1, 10), PKW(pB1, 12), PKW(pB1, 14)};
      SBAR(); pv(o, vb0 + sl_cur, PAF(0), PAF(1), PAF(2), PAF(3)); }
#undef PKW
#undef PAF
#undef VFR
#undef PIN
#undef MX3
#undef GAPA
#undef GAPB
#undef EX
#undef VRD
#undef KRD
#undef STEP
#undef ENDW
    { auto rr = __builtin_amdgcn_permlane32_swap(__float_as_uint(l_reg), __float_as_uint(l_reg), false, false); l_reg = __uint_as_float(rr[0]) + __uint_as_float(rr[1]); }
    if (hi == 0) wsf[32 + r32] = l_reg; asm volatile("s_waitcnt lgkmcnt(0)" ::: "memory");
    float rli[16];
#pragma unroll
    for (int r = 0; r < 16; ++r) rli[r] = __builtin_amdgcn_rcpf(wsf[32 + crow(r, hi)]);
    bf16* Ow = Op + (long)(q0 + wid * QBLK) * OPITCH;
    { bf16* stg = (bf16*)(shm + LDS_OST) + wid * 2048;
#pragma unroll
      for (int r = 0; r < 16; ++r) { const int orow = crow(r, hi);
#pragma unroll
          for (int d0 = 0; d0 < 2; ++d0) stg[orow * 64 + d0 * 32 + r32] = __float2bfloat16(o[d0][r] * rli[r]); }
      asm volatile("s_waitcnt lgkmcnt(0)" ::: "memory");
#pragma unroll
      for (int i = 0; i < 4; ++i) { const int row = i * 8 + (lane >> 3), ch = lane & 7; const u32x4 v = *(const u32x4*)(stg + row * 64 + ch * 8); *(u32x4*)(Ow + (long)row * OPITCH + ch * 8) = v; } }
    asm volatile("s_waitcnt lgkmcnt(0)\n\ts_barrier" ::: "memory");
#undef DMA_K
#undef DMA_V
#undef BIASADD
#undef NEGM_UPD
#undef START
#undef RESC
#undef ROT
}


__device__ __forceinline__ void attn_unit_nm(const bf16* Qp, const bf16* __restrict__ Kp, const bf16* __restrict__ Vp, bf16* Op, int q0, char* shm, int wv) {
    int tid_ = ltid(wv);
    const int tid = tid_, lane = tid & 63, r32 = lane & 31, hi = lane >> 5; const int wid = __builtin_amdgcn_readfirstlane(tid >> 6);
    const bf16* Qw = Qp + (long)(q0 + wid * QBLK) * PITCH;
    const unsigned lds0 = (unsigned)(uintptr_t)shm;
    const bf16* ksrc = Kp + (long)lane * PITCH + wid * 8;
    const bf16* vsrc = Vp + (long)(16 * (wid & 3) + (lane >> 2)) * PITCH + (wid >> 2) * 32 + (lane & 3) * 8;
    const unsigned kdst = lds0 + LDS_K + wid * 1024, vdst = lds0 + LDS_V + wid * 1024;
#define DMA_K(t, slot) glds16(ksrc + (long)(t) * KVBLK * PITCH, (unsigned)__builtin_amdgcn_readfirstlane(kdst + (slot)))
#define DMA_V(t, slot) glds16(vsrc + (long)(t) * KVBLK * PITCH, (unsigned)__builtin_amdgcn_readfirstlane(vdst + (slot)))
    const int vb0 = (int)(lds0 + LDS_V) + ((lane >> 4) & 1) * 32 + (lane & 3) * 8 + (4 * hi + ((lane & 15) >> 2)) * 64;
    const char* Kbase = shm + LDS_K; bf16x8 kf[8];
    const lds_cptr shm3 = (lds_cptr)shm; const lds_cptr kp0 = shm3 + LDS_K + hi * 1024 + r32 * 16; const lds_cptr vp0 = shm3 + LDS_V + ((lane >> 4) & 1) * 32 + (lane & 3) * 8 + (4 * hi + ((lane & 15) >> 2)) * 64;
    DMA_K(0, 0); DMA_V(0, 0); DMA_K(1, SLOTB);
    bf16x8 qr[4];
#pragma unroll
    for (int d0 = 0; d0 < 4; ++d0) qr[d0] = *reinterpret_cast<const bf16x8*>(&Qw[(long)r32 * PITCH + d0 * 16 + hi * 8]);
    f32x16 o[2]; o[0] = f32x16{}; o[1] = f32x16{}; float l_reg = 0.f;
    float* wsf = (float*)(shm + LDS_WS) + wid * 64;
    const f32x16 zero16 = f32x16{};
    f32x16 pA0, pA1, pB0, pB1;
    int sl_prev = 0, sl_cur = 0, sl_next = SLOTB;
#define ROT() do { sl_prev = sl_cur; sl_cur = sl_next; sl_next = (sl_next == (NSLOT - 1) * SLOTB) ? 0 : sl_next + SLOTB; } while (0)
    DMA_K(2, 2 * SLOTB);
    WAIT_BAR(3);
    qkt(pA0, pA1, Kbase, qr, zero16, r32, hi); asm volatile("s_nop 15\n\ts_nop 7" : "+v"(pA0), "+v"(pA1));
    _Pragma("unroll") for (int r = 0; r < 16; ++r) { pA0[r] = __builtin_amdgcn_exp2f(pA0[r]); pA1[r] = __builtin_amdgcn_exp2f(pA1[r]); }
    WAIT_BAR(0);
    DMA_K(3, 0); DMA_V(1, SLOTB);
    ROT();
    kload8(kf, kp0 + sl_cur);
    WAIT_BAR(2);
    s16x4 vlo[8], vhi[8]; u32x4 pw0, pw1, pw2, pw3;
#define PKW(P, B) cvtpk(P[B], P[B + 1])
#define PAF(k) __builtin_bit_cast(bf16x8, pw##k)
#define VFR(i) (bf16x8){vlo[i][0], vlo[i][1], vlo[i][2], vlo[i][3], vhi[i][0], vhi[i][1], vhi[i][2], vhi[i][3]}
#define PIN(x) asm volatile("" : "+v"(x))
#define GAPA(MF, A0, A1, A2, A3, W0, W1, PW) do { MF; sacc += A0; sacc += A1; sacc += A2; sacc += A3; PIN(sacc); W0; W1; PIN(PW); SBAR(); } while (0)
#define EX(v) __builtin_amdgcn_exp2f(v)
#define GAPB4(MF, X, B) do { MF; X[B] = EX(X[B]); X[B + 1] = EX(X[B + 1]); X[B + 2] = EX(X[B + 2]); X[B + 3] = EX(X[B + 3]); PIN(X); SBAR(); } while (0)
#define GAPB3(MF, E0, E1, E2, XA, XB) do { MF; E0 = EX(E0); E1 = EX(E1); E2 = EX(E2); PIN(XA); PIN(XB); SBAR(); } while (0)
#define GAPB2(MF, E0, E1, XA) do { MF; E0 = EX(E0); E1 = EX(E1); PIN(XA); SBAR(); } while (0)
#define VRD(i) do { vlo[i] = vtr(vp_ + (((i) >> 2) * 4096 + ((i) & 3) * 1024)); vhi[i] = vtr(vp_ + (((i) >> 2) * 4096 + ((i) & 3) * 1024 + 512)); } while (0)
#define KRD(G, j) do { if (G) { kload2(kf, kp0 + sl_next, j); SBAR(); } } while (0)
#define PVM(d, k, i) o[d] = __builtin_amdgcn_mfma_f32_32x32x16_bf16(PAF(k), VFR(i), o[d], 0, 0, 0)
#define LSM(k) lsum = __builtin_amdgcn_mfma_f32_32x32x16_bf16(PAF(k), ones, lsum, 0, 0, 0)
#define STEP(C0, C1, P0, P1, t, GK, GV, GL) do { SBAR(); \
    const lds_cptr vp_ = vp0 + sl_prev; \
    VRD(0); SBAR(); float sacc = (P0[0] + P0[1]); \
    GAPA(C0 = __builtin_amdgcn_mfma_f32_32x32x16_bf16(kf[0], qr[0], zero16, 0, 0, 0), P0[2], P0[3], P0[4], P0[5],     pw0[0] = PKW(P0, 0), pw0[1] = PKW(P0, 2), pw0); \
    VRD(4); SBAR(); GAPA(C1 = __builtin_amdgcn_mfma_f32_32x32x16_bf16(kf[1], qr[0], zero16, 0, 0, 0), P0[6], P0[7], P0[8], P0[9],     pw0[2] = PKW(P0, 4), pw0[3] = PKW(P0, 6), pw0); \
    VRD(1); SBAR(); GAPA(C0 = __builtin_amdgcn_mfma_f32_32x32x16_bf16(kf[2], qr[1], C0, 0, 0, 0),   P0[10], P0[11], P0[12], P0[13], pw1[0] = PKW(P0, 8), pw1[1] = PKW(P0, 10), pw1); \
    VRD(5); SBAR(); GAPA(C1 = __builtin_amdgcn_mfma_f32_32x32x16_bf16(kf[3], qr[1], C1, 0, 0, 0),   P0[14], P0[15], P1[0], P1[1],   pw1[2] = PKW(P0, 12), pw1[3] = PKW(P0, 14), pw1); \
    VRD(2); SBAR(); GAPA(C0 = __builtin_amdgcn_mfma_f32_32x32x16_bf16(kf[4], qr[2], C0, 0, 0, 0),   P1[2], P1[3], P1[4], P1[5],     pw2[0] = PKW(P1, 0), pw2[1] = PKW(P1, 2), pw2); \
    VRD(6); SBAR(); GAPA(C1 = __builtin_amdgcn_mfma_f32_32x32x16_bf16(kf[5], qr[2], C1, 0, 0, 0),   P1[6], P1[7], P1[8], P1[9],     pw2[2] = PKW(P1, 4), pw2[3] = PKW(P1, 6), pw2); \
    VRD(3); SBAR(); GAPA(C0 = __builtin_amdgcn_mfma_f32_32x32x16_bf16(kf[6], qr[3], C0, 0, 0, 0),   P1[10], P1[11], P1[12], P1[13], pw3[0] = PKW(P1, 8), pw3[1] = PKW(P1, 10), pw3); \
    VRD(7); SBAR(); GAPA(C1 = __builtin_amdgcn_mfma_f32_32x32x16_bf16(kf[7], qr[3], C1, 0, 0, 0),   P1[14], P1[15], 0.f, 0.f,       pw3[2] = PKW(P1, 12), pw3[3] = PKW(P1, 14), pw3); \
    l_reg += sacc; \
    if (GK) { DMA_K((t) + 3, sl_cur); } if (GV) { DMA_V((t) + 1, sl_next); } \
    SBAR(); \
    GAPB4(PVM(0, 0, 0), C0, 0); \
    GAPB4(PVM(1, 0, 4), C0, 4); \
    KRD(GL, 0); GAPB4(PVM(0, 1, 1), C0, 8); \
    KRD(GL, 1); GAPB4(PVM(1, 1, 5), C0, 12); \
    KRD(GL, 2); GAPB4(PVM(0, 2, 2), C1, 0); \
    KRD(GL, 3); GAPB4(PVM(1, 2, 6), C1, 4); \
    GAPB4(PVM(0, 3, 3), C1, 8); \
    GAPB4(PVM(1, 3, 7), C1, 12); \
    } while (0)
    int t = 1;
    for (; t + 5 < NT; t += 2) {
        STEP(pB0, pB1, pA0, pA1, t, true, true, true);     WAIT_BAR(2); ROT();
        STEP(pA0, pA1, pB0, pB1, t + 1, true, true, true); WAIT_BAR(2); ROT();
    }
#define ENDW(tt) do { if ((tt) + 3 < NT) { WAIT_BAR(2); } else if ((tt) + 2 < NT) { WAIT_BAR(1); } else { WAIT_BAR(0); } } while (0)
    for (; t + 1 < NT; t += 2) {
        STEP(pB0, pB1, pA0, pA1, t, (t + 3 < NT), (t + 1 < NT), (t + 1 < NT));       ENDW(t);     ROT();
        STEP(pA0, pA1, pB0, pB1, t + 1, (t + 4 < NT), (t + 2 < NT), (t + 2 < NT));   ENDW(t + 1); ROT();
    }
    STEP(pB0, pB1, pA0, pA1, NT - 1, false, false, false);
    { float sacc = pB0[0] + pB0[1]; _Pragma("unroll") for (int r = 2; r < 16; ++r) sacc += pB0[r]; _Pragma("unroll") for (int r = 0; r < 16; ++r) sacc += pB1[r]; l_reg += sacc;
      pw0 = (u32x4){PKW(pB0, 0), PKW(pB0, 2), PKW(pB0, 4), PKW(pB0, 6)}; pw1 = (u32x4){PKW(pB0, 8), PKW(pB0, 10), PKW(pB0, 12), PKW(pB0, 14)}; pw2 = (u32x4){PKW(pB1, 0), PKW(pB1, 2), PKW(pB1, 4), PKW(pB1, 6)}; pw3 = (u32x4){PKW(pB1, 8), PKW(pB1, 10), PKW(pB1, 12), PKW(pB1, 14)};
      SBAR(); pv(o, vb0 + sl_cur, PAF(0), PAF(1), PAF(2), PAF(3)); }
#undef PKW
#undef PAF
#undef VFR
#undef PIN
#undef GAPA
#undef GAPB3
#undef GAPB4
#undef GAPB2
#undef EX
#undef VRD
#undef KRD
#undef PVM
#undef LSM
#undef STEP
#undef ENDW
    { auto rr = __builtin_amdgcn_permlane32_swap(__float_as_uint(l_reg), __float_as_uint(l_reg), false, false); l_reg = __uint_as_float(rr[0]) + __uint_as_float(rr[1]); }
    if (hi == 0) wsf[32 + r32] = l_reg; asm volatile("s_waitcnt lgkmcnt(0)" ::: "memory");
    float rli[16];
#pragma unroll
    for (int r = 0; r < 16; ++r) rli[r] = __builtin_amdgcn_rcpf(wsf[32 + crow(r, hi)]);
    bf16* Ow = Op + (long)(q0 + wid * QBLK) * OPITCH;
    { bf16* stg = (bf16*)(shm + LDS_OST) + wid * 2048;
#pragma unroll
      for (int r = 0; r < 16; ++r) { const int orow = crow(r, hi);
#pragma unroll
          for (int d0 = 0; d0 < 2; ++d0) stg[orow * 64 + d0 * 32 + r32] = __float2bfloat16(o[d0][r] * rli[r]); }
      asm volatile("s_waitcnt lgkmcnt(0)" ::: "memory");
#pragma unroll
      for (int i = 0; i < 4; ++i) { const int row = i * 8 + (lane >> 3), ch = lane & 7; const u32x4 v = *(const u32x4*)(stg + row * 64 + ch * 8); *(u32x4*)(Ow + (long)row * OPITCH + ch * 8) = v; } }
    asm volatile("s_waitcnt lgkmcnt(0)\n\ts_barrier" ::: "memory");
#undef DMA_K
#undef DMA_V
#undef ROT
}

__device__ __forceinline__ void attn_unit_a8(const unsigned char* Q8p, const unsigned char* __restrict__ K8p, const unsigned char* __restrict__ VT8p, bf16* Op, int q0, float negR, char* shm, int wv) {
    constexpr int A8_K = 0, A8_V = 16384, A8_OST = 32768, A8_SLOT = 4096;
    int tid_ = ltid(wv);
    const int tid = tid_, lane = tid & 63, r32 = lane & 31, hi = lane >> 5; const int wid = __builtin_amdgcn_readfirstlane(tid >> 6);
    const unsigned lds0 = (unsigned)(uintptr_t)shm;
    const bool kwave = wid < 4;
    const unsigned char* dsrc = kwave ? K8p + (long)lane * 128 + wid * 16 : VT8p + (long)lane * SEQ + (wid - 4) * 16;
    const long dstep = kwave ? 64 * 128 : 64;
    const unsigned ddst = lds0 + (kwave ? A8_K + wid * 1024 : A8_V + (wid - 4) * 1024);
#define DMA8(t, slot) glds16(dsrc + (long)(t) * dstep, (unsigned)__builtin_amdgcn_readfirstlane(ddst + (slot)))
    const lds_cptr shm3 = (lds_cptr)shm; const lds_cptr kp0 = shm3 + A8_K + hi * 2048 + r32 * 16, vp0 = shm3 + A8_V + hi * 2048 + r32 * 16;
#define LD8(p) ({ const u32x4 l_ = *(const LAS u32x4*)(p), h_ = *(const LAS u32x4*)((p) + 1024); (v8i32){(int)l_.x, (int)l_.y, (int)l_.z, (int)l_.w, (int)h_.x, (int)h_.y, (int)h_.z, (int)h_.w}; })
    if (kwave) { DMA8(0, 0); DMA8(1, A8_SLOT); DMA8(2, 2 * A8_SLOT); DMA8(3, 3 * A8_SLOT); } else { DMA8(0, 0); DMA8(1, A8_SLOT); }
    v8i32 qf; { const u32x4* qp = (const u32x4*)(Q8p + (long)(q0 + wid * QBLK + r32) * 512 + hi * 32); const u32x4 a = qp[0], b = qp[1]; qf = (v8i32){(int)a.x, (int)a.y, (int)a.z, (int)a.w, (int)b.x, (int)b.y, (int)b.z, (int)b.w}; }
    f32x16 o[2]; o[0] = f32x16{}; o[1] = f32x16{};
    f32x16 cinit;
    { float nr = negR; asm volatile("" : "+v"(nr));
      _Pragma("unroll") for (int r = 0; r < 16; ++r) cinit[r] = nr; }
    asm volatile("" : "+v"(cinit));
    int scK = 0x7F7F7F7F, scQ = 0x7B7B7B7B, scP = 0x7F7F7F7F, scV = 0x7D7D7D7D; asm volatile("" : "+v"(scK), "+v"(scQ), "+v"(scP), "+v"(scV));
#define QK8(D, KF) asm volatile("v_mfma_scale_f32_32x32x64_f8f6f4 %0, %1, %2, %3, %4, %5 op_sel_hi:[0,0,0]" : "=&v"(D) : "v"(KF), "v"(qf), "v"(cinit), "v"(scK), "v"(scQ))
#define PV8(D, PW, VF) asm volatile("s_nop 3\n\tv_mfma_scale_f32_32x32x64_f8f6f4 %0, %1, %2, %0, %3, %4 op_sel_hi:[0,0,0]" : "+v"(D) : "v"(PW), "v"(VF), "v"(scP), "v"(scV))
#define NOPS2(A, B) asm volatile("s_nop 15\n\ts_nop 7" : "+v"(A), "+v"(B))
    f32x16 pA0, pA1, pB0, pB1; v8i32 kfA[2], kfB[2], vf[2], pw = {};
    v8i32 ones; { int o1 = 0x38383838; asm volatile("" : "+v"(o1)); ones = (v8i32){o1, o1, o1, o1, o1, o1, o1, o1}; }
    f32x16 lacc = f32x16{};
#define PVL() asm volatile("v_mfma_scale_f32_32x32x64_f8f6f4 %0, %1, %2, %0, %3, %3 op_sel_hi:[0,0,0]" : "+v"(lacc) : "v"(pw), "v"(ones), "v"(scP))
    int sl_prev = 0, sl_cur = 0, sl_next = A8_SLOT, sl_n2 = 2 * A8_SLOT;
#define ROT() do { sl_prev = sl_cur; sl_cur = sl_next; sl_next = sl_n2; sl_n2 = (sl_n2 == 3 * A8_SLOT) ? 0 : sl_n2 + A8_SLOT; } while (0)
    WAIT_BAR(3);
    kfB[0] = LD8(kp0); kfB[1] = LD8(kp0 + 512);
    QK8(pA0, kfB[0]); QK8(pA1, kfB[1]); NOPS2(pA0, pA1);
    _Pragma("unroll") for (int r = 0; r < 16; ++r) { pA0[r] = __builtin_amdgcn_exp2f(pA0[r]); pA1[r] = __builtin_amdgcn_exp2f(pA1[r]); }
    WAIT_BAR(0);
    if (kwave) { DMA8(4, 0); } else { DMA8(2, 2 * A8_SLOT); }
    ROT();
    kfA[0] = LD8(kp0 + sl_cur); kfA[1] = LD8(kp0 + sl_cur + 512);
    WAIT_BAR(1);
#define PK2(W, a, b, c, d) do { W = __builtin_amdgcn_cvt_pk_fp8_f32(a, b, W, false); W = __builtin_amdgcn_cvt_pk_fp8_f32(c, d, W, true); } while (0)
#define PACKH(W0, PP) do { PK2(pw[W0], PP[0], PP[1], PP[2], PP[3]); PK2(pw[W0 + 1], PP[4], PP[5], PP[6], PP[7]); PK2(pw[W0 + 2], PP[8], PP[9], PP[10], PP[11]); PK2(pw[W0 + 3], PP[12], PP[13], PP[14], PP[15]); } while (0)
#define STEP8(C0, C1, P0, P1, t, GK, GV, GL, KC, KN) do { SBAR(); \
    vf[0] = LD8(vp0 + sl_prev); vf[1] = LD8(vp0 + sl_prev + 512); \
    QK8(C0, KC[0]); SBAR(); \
    PACKH(0, P0); asm volatile("" : "+v"(pw)); SBAR(); \
    QK8(C1, KC[1]); \
    if (GL) { KN[0] = LD8(kp0 + sl_next); KN[1] = LD8(kp0 + sl_next + 512); } \
    SBAR(); asm volatile("" :: "v"(KC[0]), "v"(KC[1]));     \
    PACKH(4, P1); asm volatile("" : "+v"(pw)); \
    if (kwave) { if (GK) { DMA8((t) + 4, sl_cur); } } else { if (GV) { DMA8((t) + 2, sl_n2); } } \
    SBAR(); \
    PV8(o[0], pw, vf[0]); SBAR(); \
    asm volatile("s_nop 1" : "+v"(C0));              \
    _Pragma("unroll") for (int r = 0; r < 16; ++r) C0[r] = __builtin_amdgcn_exp2f(C0[r]); \
    asm volatile("" : "+v"(C0)); SBAR(); \
    PV8(o[1], pw, vf[1]); SBAR(); \
    asm volatile("" : "+v"(C1)); \
    _Pragma("unroll") for (int r = 0; r < 8; ++r) C1[r] = __builtin_amdgcn_exp2f(C1[r]); \
    asm volatile("" : "+v"(C1)); SBAR(); \
    PVL(); SBAR(); \
    asm volatile("" : "+v"(C1)); \
    _Pragma("unroll") for (int r = 8; r < 16; ++r) C1[r] = __builtin_amdgcn_exp2f(C1[r]); \
    asm volatile("" : "+v"(C1));                     \
    SBAR(); \
    } while (0)
    int t = 1;
    for (; t + 5 < NT; t += 2) {
        STEP8(pB0, pB1, pA0, pA1, t, true, true, true, kfA, kfB);     WAIT_BAR(2); ROT();
        STEP8(pA0, pA1, pB0, pB1, t + 1, true, true, true, kfB, kfA); WAIT_BAR(2); ROT();
    }
#define ENDW8(tt) do { WAIT_BAR(0); } while (0)
    for (; t + 1 < NT; t += 2) {
        STEP8(pB0, pB1, pA0, pA1, t, (t + 4 < NT), (t + 2 < NT), (t + 1 < NT), kfA, kfB);       ENDW8(t);     ROT();
        STEP8(pA0, pA1, pB0, pB1, t + 1, (t + 5 < NT), (t + 3 < NT), (t + 2 < NT), kfB, kfA);   ENDW8(t + 1); ROT();
    }
    STEP8(pB0, pB1, pA0, pA1, NT - 1, false, false, false, kfA, kfB);
    { PACKH(0, pB0); PACKH(4, pB1); vf[0] = LD8(vp0 + sl_cur); vf[1] = LD8(vp0 + sl_cur + 512);
      PV8(o[0], pw, vf[0]); PV8(o[1], pw, vf[1]); PVL(); NOPS2(o[0], o[1]); asm volatile("s_nop 15\n\ts_nop 7" : "+v"(lacc)); }
#undef PK2
#undef PACKH
#undef PVL
#undef STEP8
#undef ENDW8
#undef PACK8
#undef NOPS2
#undef PV8
#undef QK8
#undef LD8
#undef ROT
#undef DMA8
    float rli[16];
#pragma unroll
    for (int r = 0; r < 16; ++r) rli[r] = __builtin_amdgcn_rcpf(lacc[r]);
    bf16* Ow = Op + (long)(q0 + wid * QBLK) * OPITCH;
    { bf16* stg = (bf16*)(shm + A8_OST) + wid * 2048;
#pragma unroll
      for (int r = 0; r < 16; ++r) { const int orow = crow(r, hi);
#pragma unroll
          for (int d0 = 0; d0 < 2; ++d0) stg[orow * 64 + d0 * 32 + r32] = __float2bfloat16(o[d0][r] * rli[r]); }
      asm volatile("s_waitcnt lgkmcnt(0)" ::: "memory");
#pragma unroll
      for (int i = 0; i < 4; ++i) { const int row = i * 8 + (lane >> 3), ch = lane & 7; const u32x4 v = *(const u32x4*)(stg + row * 64 + ch * 8); *(u32x4*)(Ow + (long)row * OPITCH + ch * 8) = v; } }
    asm volatile("s_waitcnt lgkmcnt(0)\n\ts_barrier" ::: "memory");
}

__device__ __forceinline__ void b_pair_epilogue(f32x16 (&o)[4], const float (&rli)[16], int m, float lam, const float* subln, bf16* Ow, char* shm, int wid, int lane, int r32, int hi) {
    bf16* st = (bf16*)(shm + LDS_STASH) + wid * 4096;
    if (m == 0) {
#pragma unroll
        for (int r = 0; r < 16; ++r) { const int orow = crow(r, hi);
#pragma unroll
            for (int d0 = 0; d0 < 4; ++d0) st[orow * 128 + d0 * 32 + r32] = __float2bfloat16(o[d0][r] * rli[r]); }
    } else {
        float sg[4];
#pragma unroll
        for (int d0 = 0; d0 < 4; ++d0) sg[d0] = subln[d0 * 32 + r32] * (1.f - LAM_INIT);
        bf16* stg = (bf16*)shm + wid * 4096;
#pragma unroll
        for (int r = 0; r < 16; ++r) { const int orow = crow(r, hi); float ss = 0.f;
#pragma unroll
            for (int d0 = 0; d0 < 4; ++d0) { const float df = __bfloat162float(st[orow * 128 + d0 * 32 + r32]) - lam * (o[d0][r] * rli[r]); o[d0][r] = df; ss += df * df; }
            ss += swz_xor<1>(ss); ss += swz_xor<2>(ss); ss += swz_xor<4>(ss); ss += swz_xor<8>(ss); ss += swz_xor<16>(ss);
            const float rinv = 1.0f / sqrtf(ss * (1.f / 128.f) + LN_EPS);
#pragma unroll
            for (int d0 = 0; d0 < 4; ++d0) stg[orow * 128 + d0 * 32 + r32] = __float2bfloat16(o[d0][r] * rinv * sg[d0]); }
        asm volatile("s_waitcnt lgkmcnt(0)" ::: "memory");
#pragma unroll
        for (int i = 0; i < 8; ++i) { const int row = i * 4 + (lane >> 4), ch = lane & 15; const u32x4 v = *(const u32x4*)(stg + row * 128 + ch * 8); *(u32x4*)(Ow + (long)row * OPITCH + ch * 8) = v; }
    }
    asm volatile("s_waitcnt lgkmcnt(0)\n\ts_barrier" ::: "memory");
}
constexpr int V2_SLOTV = 16384, V2_LDS_V = NSLOT * SLOTB, V2_LDS_WS = V2_LDS_V + NSLOT * V2_SLOTV;
template <int THRL> __device__ __forceinline__ void attn_unit_v128(const bf16* Qp, const bf16* __restrict__ Kp, const bf16* __restrict__ Vp, bf16* Op, int q0, float cL, float cR, int tabofs, int m, float lam, const float* subln, char* shm, int wv) {
    int tid_ = ltid(wv);
    const int tid = tid_, lane = tid & 63, r32 = lane & 31, hi = lane >> 5; const int wid = __builtin_amdgcn_readfirstlane(tid >> 6);
    const bf16* Qw = Qp + (long)(q0 + wid * QBLK) * PITCH;
    const unsigned lds0 = (unsigned)(uintptr_t)shm;
    float* wsf = (float*)(shm + V2_LDS_WS) + wid * 64;
    const bf16* ksrc = Kp + (long)lane * PITCH + wid * 8;
    const bf16* vsrc = Vp + (long)(16 * (wid & 3) + (lane >> 2)) * PITCH + (wid >> 2) * 32 + (lane & 3) * 8;
    const unsigned kdst = lds0 + LDS_K + wid * 1024, vdst = lds0 + V2_LDS_V + wid * 1024;
#define DMA_K(t, slot) glds16(ksrc + (long)(t) * KVBLK * PITCH, (unsigned)__builtin_amdgcn_readfirstlane(kdst + (slot)))
#define DMA_V(t, slot) do { glds16(vsrc + (long)(t) * KVBLK * PITCH, (unsigned)__builtin_amdgcn_readfirstlane(vdst + 2 * (slot))); \
                            glds16(vsrc + (long)(t) * KVBLK * PITCH + 64, (unsigned)__builtin_amdgcn_readfirstlane(vdst + 2 * (slot) + 8192)); } while (0)
    const int vb0 = (int)(lds0 + V2_LDS_V) + ((lane >> 4) & 1) * 32 + (lane & 3) * 8 + (4 * hi + ((lane & 15) >> 2)) * 64;
    const char* Kbase = shm + LDS_K; bf16x8 kf[8];
    const lds_cptr shm3 = (lds_cptr)shm; const lds_cptr kp0 = shm3 + LDS_K + hi * 1024 + r32 * 16; const lds_cptr vp0 = shm3 + V2_LDS_V + ((lane >> 4) & 1) * 32 + (lane & 3) * 8 + (4 * hi + ((lane & 15) >> 2)) * 64;
    const int q0w = q0 + wid * QBLK;
    const LAS float* tabl = (const LAS float*)(shm3 + tabofs) + (256 - r32 + 4 * hi);
#define BCONST_T(t) ((64 * (t) - q0w <= -160) ? cL : ((64 * (t) - q0w >= 128) ? cR : 0.f))
#define BIASADD(C0, C1, t) do { const int dk_ = 64 * (t) - q0w; if (dk_ >= -128 && dk_ <= 96) { const LAS float* tb_ = tabl + dk_; \
      _Pragma("unroll") for (int r = 0; r < 16; ++r) { C0[r] += tb_[(r & 3) + 8 * (r >> 2)]; C1[r] += tb_[(r & 3) + 8 * (r >> 2) + 32]; } } } while (0)
    DMA_K(0, 0); DMA_V(0, 0); DMA_K(1, SLOTB);
    bf16x8 qr[4];
#pragma unroll
    for (int d0 = 0; d0 < 4; ++d0) qr[d0] = *reinterpret_cast<const bf16x8*>(&Qw[(long)r32 * PITCH + d0 * 16 + hi * 8]);
    float mhat = 0.f, moff = 0.f, l_reg = 0.f; f32x16 o[4]; o[0] = f32x16{}; o[1] = f32x16{}; o[2] = f32x16{}; o[3] = f32x16{};
    const f32x16 zero16 = f32x16{};
    bool resc = false;
#define RESC() do { if (resc) { asm volatile("s_waitcnt lgkmcnt(0)" ::: "memory"); \
      _Pragma("unroll") for (int d_ = 0; d_ < 4; ++d_) _Pragma("unroll") for (int r = 0; r < 16; ++r) o[d_][r] *= wsf[crow(r, hi)]; } } while (0)
    f32x16 pA0, pA1, pB0, pB1;
    int sl_prev = 0, sl_cur = 0, sl_next = SLOTB;
#define ROT() do { sl_prev = sl_cur; sl_cur = sl_next; sl_next = (sl_next == (NSLOT - 1) * SLOTB) ? 0 : sl_next + SLOTB; } while (0)
    DMA_K(2, 2 * SLOTB);
    WAIT_BAR(4);
    qkt(pA0, pA1, Kbase, qr, zero16, r32, hi); asm volatile("s_nop 15\n\ts_nop 7" : "+v"(pA0), "+v"(pA1)); BIASADD(pA0, pA1, 0);
    { const float rm = rowmax(pA0, pA1); mhat = rm + BCONST_T(0); moff = rm;
      _Pragma("unroll") for (int r = 0; r < 16; ++r) { pA0[r] = __builtin_amdgcn_exp2f(pA0[r] - moff); pA1[r] = __builtin_amdgcn_exp2f(pA1[r] - moff); } }
    WAIT_BAR(0);
    DMA_K(3, 0); DMA_V(1, SLOTB);
    ROT();
    kload8(kf, kp0 + sl_cur);
    WAIT_BAR(3);
    s16x4 vlo[16], vhi[16]; u32x4 pw0, pw1, pw2, pw3;
#define PKW(P, B) cvtpk(P[B], P[B + 1])
#define PAF(k) __builtin_bit_cast(bf16x8, pw##k)
#define VFR(i) (bf16x8){vlo[i][0], vlo[i][1], vlo[i][2], vlo[i][3], vhi[i][0], vhi[i][1], vhi[i][2], vhi[i][3]}
#define PIN(x) asm volatile("" : "+v"(x))
#define MX3(a, b, c) __builtin_fmaxf(__builtin_fmaxf((a), (b)), (c))
#define GAPA(MF, A0, A1, A2, A3, W0, W1, PW) do { MF; sacc += A0; sacc += A1; sacc += A2; sacc += A3; PIN(sacc); W0; W1; PIN(PW); SBAR(); } while (0)
#define EX(v) __builtin_amdgcn_exp2f((v) - moff)
#define GAPB(MF, X, B) do { MF; X[B] = EX(X[B]); X[B + 1] = EX(X[B + 1]); PIN(X); SBAR(); } while (0)
#define VRD(i) do { vlo[i] = vtr(vp_ + (((i) >> 2) * 4096 + ((i) & 3) * 1024)); vhi[i] = vtr(vp_ + (((i) >> 2) * 4096 + ((i) & 3) * 1024 + 512)); } while (0)
#define KRD(G, j) do { if (G) { kload2(kf, kp0 + sl_next, j); SBAR(); } } while (0)
#define PVM(d, k, i) o[d] = __builtin_amdgcn_mfma_f32_32x32x16_bf16(PAF(k), VFR(i), o[d], 0, 0, 0)
#define STEP(C0, C1, P0, P1, t, GK, GV, GL) do { SBAR(); \
    const lds_cptr vp_ = vp0 + 2 * sl_prev; \
    VRD(0); SBAR(); float sacc = (P0[0] + P0[1]); \
    GAPA(C0 = __builtin_amdgcn_mfma_f32_32x32x16_bf16(kf[0], qr[0], zero16, 0, 0, 0), P0[2], P0[3], P0[4], P0[5],     pw0[0] = PKW(P0, 0), pw0[1] = PKW(P0, 2), pw0); \
    VRD(4); SBAR(); GAPA(C1 = __builtin_amdgcn_mfma_f32_32x32x16_bf16(kf[1], qr[0], zero16, 0, 0, 0), P0[6], P0[7], P0[8], P0[9],     pw0[2] = PKW(P0, 4), pw0[3] = PKW(P0, 6), pw0); \
    VRD(1); SBAR(); GAPA(C0 = __builtin_amdgcn_mfma_f32_32x32x16_bf16(kf[2], qr[1], C0, 0, 0, 0),   P0[10], P0[11], P0[12], P0[13], pw1[0] = PKW(P0, 8), pw1[1] = PKW(P0, 10), pw1); \
    VRD(5); SBAR(); GAPA(C1 = __builtin_amdgcn_mfma_f32_32x32x16_bf16(kf[3], qr[1], C1, 0, 0, 0),   P0[14], P0[15], P1[0], P1[1],   pw1[2] = PKW(P0, 12), pw1[3] = PKW(P0, 14), pw1); \
    VRD(2); SBAR(); GAPA(C0 = __builtin_amdgcn_mfma_f32_32x32x16_bf16(kf[4], qr[2], C0, 0, 0, 0),   P1[2], P1[3], P1[4], P1[5],     pw2[0] = PKW(P1, 0), pw2[1] = PKW(P1, 2), pw2); \
    VRD(6); SBAR(); GAPA(C1 = __builtin_amdgcn_mfma_f32_32x32x16_bf16(kf[5], qr[2], C1, 0, 0, 0),   P1[6], P1[7], P1[8], P1[9],     pw2[2] = PKW(P1, 4), pw2[3] = PKW(P1, 6), pw2); \
    VRD(3); SBAR(); GAPA(C0 = __builtin_amdgcn_mfma_f32_32x32x16_bf16(kf[6], qr[3], C0, 0, 0, 0),   P1[10], P1[11], P1[12], P1[13], pw3[0] = PKW(P1, 8), pw3[1] = PKW(P1, 10), pw3); \
    VRD(7); SBAR(); GAPA(C1 = __builtin_amdgcn_mfma_f32_32x32x16_bf16(kf[7], qr[3], C1, 0, 0, 0),   P1[14], P1[15], 0.f, 0.f,       pw3[2] = PKW(P1, 12), pw3[3] = PKW(P1, 14), pw3); \
    l_reg += sacc; \
    if (GK) { DMA_K((t) + 3, sl_cur); } if (GV) { DMA_V((t) + 1, sl_next); } \
    BIASADD(C0, C1, t); \
    { float a = MX3(C0[0], C0[1], C1[0]), b = MX3(C0[2], C0[3], C1[1]); a = MX3(a, C1[2], C1[3]); \
      _Pragma("unroll") for (int r = 4; r < 16; r += 4) { a = MX3(a, C0[r], C0[r + 1]); b = MX3(b, C0[r + 2], C0[r + 3]); a = MX3(a, C1[r], C1[r + 1]); b = MX3(b, C1[r + 2], C1[r + 3]); } \
      float rm = __builtin_fmaxf(a, b); { auto rr = __builtin_amdgcn_permlane32_swap(__float_as_uint(rm), __float_as_uint(rm), false, false); rm = __builtin_fmaxf(__uint_as_float(rr[0]), __uint_as_float(rr[1])); } \
      const float cbt_ = BCONST_T(t); rm = rm + cbt_ - mhat; \
      resc = false; \
      if (__builtin_expect(__any(rm > (float)THRL), 0)) { const float dl = __builtin_fmaxf(rm, 0.f); mhat += dl; \
        const float f = __builtin_amdgcn_exp2f(-dl); l_reg *= f; if (hi == 0) wsf[r32] = f; resc = true; } \
      moff = mhat - cbt_; } \
    SBAR(); \
    GAPB(PVM(0, 0, 0), C0, 0);  VRD(8);  SBAR(); \
    GAPB(PVM(1, 0, 4), C0, 2);  VRD(12); SBAR(); \
    GAPB(PVM(0, 1, 1), C0, 4);  VRD(9);  SBAR(); \
    GAPB(PVM(1, 1, 5), C0, 6);  VRD(13); SBAR(); \
    KRD(GL, 0); GAPB(PVM(0, 2, 2), C0, 8);  VRD(10); SBAR(); \
    GAPB(PVM(1, 2, 6), C0, 10); VRD(14); SBAR(); \
    KRD(GL, 1); GAPB(PVM(0, 3, 3), C0, 12); VRD(11); SBAR(); \
    GAPB(PVM(1, 3, 7), C0, 14); VRD(15); SBAR(); \
    KRD(GL, 2); GAPB(PVM(2, 0, 8), C1, 0); \
    GAPB(PVM(3, 0, 12), C1, 2); \
    KRD(GL, 3); GAPB(PVM(2, 1, 9), C1, 4); \
    GAPB(PVM(3, 1, 13), C1, 6); \
    GAPB(PVM(2, 2, 10), C1, 8); \
    GAPB(PVM(3, 2, 14), C1, 10); \
    GAPB(PVM(2, 3, 11), C1, 12); \
    GAPB(PVM(3, 3, 15), C1, 14); \
    } while (0)
    int t = 1;
    for (; t + 5 < NT; t += 2) {
        STEP(pB0, pB1, pA0, pA1, t, true, true, true);     WAIT_BAR(3); RESC(); ROT();
        STEP(pA0, pA1, pB0, pB1, t + 1, true, true, true); WAIT_BAR(3); RESC(); ROT();
    }
#define ENDW(tt) do { if ((tt) + 3 < NT) { WAIT_BAR(3); } else if ((tt) + 2 < NT) { WAIT_BAR(2); } else { WAIT_BAR(0); } } while (0)
    for (; t + 1 < NT; t += 2) {
        STEP(pB0, pB1, pA0, pA1, t, (t + 3 < NT), (t + 1 < NT), (t + 1 < NT));       ENDW(t);     RESC(); ROT();
        STEP(pA0, pA1, pB0, pB1, t + 1, (t + 4 < NT), (t + 2 < NT), (t + 2 < NT));   ENDW(t + 1); RESC(); ROT();
    }
    STEP(pB0, pB1, pA0, pA1, NT - 1, false, false, false); RESC();
    { float sacc = pB0[0] + pB0[1]; _Pragma("unroll") for (int r = 2; r < 16; ++r) sacc += pB0[r]; _Pragma("unroll") for (int r = 0; r < 16; ++r) sacc += pB1[r]; l_reg += sacc;
      pw0 = (u32x4){PKW(pB0, 0), PKW(pB0, 2), PKW(pB0, 4), PKW(pB0, 6)}; pw1 = (u32x4){PKW(pB0, 8), PKW(pB0, 10), PKW(pB0, 12), PKW(pB0, 14)}; pw2 = (u32x4){PKW(pB1, 0), PKW(pB1, 2), PKW(pB1, 4), PKW(pB1, 6)}; pw3 = (u32x4){PKW(pB1, 8), PKW(pB1, 10), PKW(pB1, 12), PKW(pB1, 14)};
      SBAR(); pv(o, vb0 + 2 * sl_cur, PAF(0), PAF(1), PAF(2), PAF(3)); pv(o + 2, vb0 + 2 * sl_cur + 8192, PAF(0), PAF(1), PAF(2), PAF(3)); }
#undef PKW
#undef PAF
#undef VFR
#undef PIN
#undef MX3
#undef GAPA
#undef GAPB
#undef EX
#undef VRD
#undef KRD
#undef PVM
#undef STEP
#undef ENDW
    { auto rr = __builtin_amdgcn_permlane32_swap(__float_as_uint(l_reg), __float_as_uint(l_reg), false, false); l_reg = __uint_as_float(rr[0]) + __uint_as_float(rr[1]); }
    if (hi == 0) wsf[32 + r32] = l_reg;
    asm volatile("s_waitcnt lgkmcnt(0)\n\ts_barrier" ::: "memory");
    float rli[16];
#pragma unroll
    for (int r = 0; r < 16; ++r) rli[r] = __builtin_amdgcn_rcpf(wsf[32 + crow(r, hi)]);
    b_pair_epilogue(o, rli, m, lam, subln, Op + (long)(q0 + wid * QBLK) * OPITCH, shm, wid, lane, r32, hi);
#undef DMA_K
#undef DMA_V
#undef BCONST_T
#undef BIASADD
#undef RESC
#undef ROT
}
__device__ __forceinline__ void attn_unit_v128nm(const bf16* Qp, const bf16* __restrict__ Kp, const bf16* __restrict__ Vp, bf16* Op, int q0, float cL, float cR, int tabofs, int m, float lam, const float* subln, char* shm, int wv) {
    int tid_ = ltid(wv);
    const int tid = tid_, lane = tid & 63, r32 = lane & 31, hi = lane >> 5; const int wid = __builtin_amdgcn_readfirstlane(tid >> 6);
    const bf16* Qw = Qp + (long)(q0 + wid * QBLK) * PITCH;
    const unsigned lds0 = (unsigned)(uintptr_t)shm;
    float* wsf = (float*)(shm + V2_LDS_WS) + wid * 64;
    const bf16* ksrc = Kp + (long)lane * PITCH + wid * 8;
    const bf16* vsrc = Vp + (long)(16 * (wid & 3) + (lane >> 2)) * PITCH + (wid >> 2) * 32 + (lane & 3) * 8;
    const unsigned kdst = lds0 + LDS_K + wid * 1024, vdst = lds0 + V2_LDS_V + wid * 1024;
#define DMA_K(t, slot) glds16(ksrc + (long)(t) * KVBLK * PITCH, (unsigned)__builtin_amdgcn_readfirstlane(kdst + (slot)))
#define DMA_V(t, slot) do { glds16(vsrc + (long)(t) * KVBLK * PITCH, (unsigned)__builtin_amdgcn_readfirstlane(vdst + 2 * (slot))); \
                            glds16(vsrc + (long)(t) * KVBLK * PITCH + 64, (unsigned)__builtin_amdgcn_readfirstlane(vdst + 2 * (slot) + 8192)); } while (0)
    const int vb0 = (int)(lds0 + V2_LDS_V) + ((lane >> 4) & 1) * 32 + (lane & 3) * 8 + (4 * hi + ((lane & 15) >> 2)) * 64;
    const char* Kbase = shm + LDS_K; bf16x8 kf[8];
    const lds_cptr shm3 = (lds_cptr)shm; const lds_cptr kp0 = shm3 + LDS_K + hi * 1024 + r32 * 16; const lds_cptr vp0 = shm3 + V2_LDS_V + ((lane >> 4) & 1) * 32 + (lane & 3) * 8 + (4 * hi + ((lane & 15) >> 2)) * 64;
    const int q0w = q0 + wid * QBLK;
    const LAS float* tabl = (const LAS float*)(shm3 + tabofs) + (256 - r32 + 4 * hi);
#define BCONST_T(t) ((64 * (t) - q0w <= -160) ? cL : ((64 * (t) - q0w >= 128) ? cR : 0.f))
#define BIASADD(C0, C1, t) do { const int dk_ = 64 * (t) - q0w; if (dk_ >= -128 && dk_ <= 96) { const LAS float* tb_ = tabl + dk_; \
      _Pragma("unroll") for (int r = 0; r < 16; ++r) { C0[r] += tb_[(r & 3) + 8 * (r >> 2)]; C1[r] += tb_[(r & 3) + 8 * (r >> 2) + 32]; } } } while (0)
    DMA_K(0, 0); DMA_V(0, 0); DMA_K(1, SLOTB);
    bf16x8 qr[4];
#pragma unroll
    for (int d0 = 0; d0 < 4; ++d0) qr[d0] = *reinterpret_cast<const bf16x8*>(&Qw[(long)r32 * PITCH + d0 * 16 + hi * 8]);
    float l_reg = 0.f; f32x16 o[4]; o[0] = f32x16{}; o[1] = f32x16{}; o[2] = f32x16{}; o[3] = f32x16{};
    int bmode = (64 * 0 - q0w <= -160) ? 1 : ((64 * 0 - q0w >= 128) ? 2 : 0); f32x16 cbt;
    { const float c0_ = BCONST_T(0); _Pragma("unroll") for (int r = 0; r < 16; ++r) cbt[r] = c0_; } asm volatile("" : "+v"(cbt));
#define CB_UPD(tn) do { const int nm_ = (64 * (tn) - q0w <= -160) ? 1 : ((64 * (tn) - q0w >= 128) ? 2 : 0); if (nm_ != bmode) { bmode = nm_; const float c_ = BCONST_T(tn); \
      _Pragma("unroll") for (int r = 0; r < 16; ++r) cbt[r] = c_; asm volatile("" : "+v"(cbt)); } } while (0)
    f32x16 pA0, pA1, pB0, pB1;
    int sl_prev = 0, sl_cur = 0, sl_next = SLOTB;
#define ROT() do { sl_prev = sl_cur; sl_cur = sl_next; sl_next = (sl_next == (NSLOT - 1) * SLOTB) ? 0 : sl_next + SLOTB; } while (0)
    DMA_K(2, 2 * SLOTB);
    WAIT_BAR(4);
    qkt(pA0, pA1, Kbase, qr, cbt, r32, hi); asm volatile("s_nop 15\n\ts_nop 7" : "+v"(pA0), "+v"(pA1)); BIASADD(pA0, pA1, 0);
    _Pragma("unroll") for (int r = 0; r < 16; ++r) { pA0[r] = __builtin_amdgcn_exp2f(pA0[r]); pA1[r] = __builtin_amdgcn_exp2f(pA1[r]); }
    _Pragma("unroll") for (int r = 0; r < 16; ++r) { l_reg += pA0[r]; l_reg += pA1[r]; }
    WAIT_BAR(0);
    DMA_K(3, 0); DMA_V(1, SLOTB);
    ROT();
    kload8(kf, kp0 + sl_cur);
    CB_UPD(1);
    WAIT_BAR(3);
    s16x4 vlo[16], vhi[16]; u32x4 pw0, pw1, pw2, pw3;
#define PKW(P, B) cvtpk(P[B], P[B + 1])
#define PAF(k) __builtin_bit_cast(bf16x8, pw##k)
#define VFR(i) (bf16x8){vlo[i][0], vlo[i][1], vlo[i][2], vlo[i][3], vhi[i][0], vhi[i][1], vhi[i][2], vhi[i][3]}
#define PIN(x) asm volatile("" : "+v"(x))
#define MX3(a, b, c) __builtin_fmaxf(__builtin_fmaxf((a), (b)), (c))
#define GAPA(MF, W0, W1, PW) do { MF; W0; W1; PIN(PW); SBAR(); } while (0)
#define EX(v) __builtin_amdgcn_exp2f(v)
#define GAPB(MF, X, B, Y, BB) do { MF; X[B] = EX(X[B]); X[B + 1] = EX(X[B + 1]); sacc += Y[BB]; sacc += Y[BB + 1]; PIN(sacc); PIN(X); SBAR(); } while (0)
#define GAPB0(MF, X, B) do { MF; X[B] = EX(X[B]); X[B + 1] = EX(X[B + 1]); PIN(X); SBAR(); } while (0)
#define VRD(i) do { vlo[i] = vtr(vp_ + (((i) >> 2) * 4096 + ((i) & 3) * 1024)); vhi[i] = vtr(vp_ + (((i) >> 2) * 4096 + ((i) & 3) * 1024 + 512)); } while (0)
#define KRD(G, j) do { if (G) { kload2(kf, kp0 + sl_next, j); SBAR(); } } while (0)
#define PVM(d, k, i) o[d] = __builtin_amdgcn_mfma_f32_32x32x16_bf16(PAF(k), VFR(i), o[d], 0, 0, 0)
#define STEP(C0, C1, P0, P1, t, GK, GV, GL) do { SBAR(); \
    const lds_cptr vp_ = vp0 + 2 * sl_prev; \
    VRD(0); SBAR(); float sacc = 0.f; \
    GAPA(C0 = __builtin_amdgcn_mfma_f32_32x32x16_bf16(kf[0], qr[0], cbt, 0, 0, 0), pw0[0] = PKW(P0, 0), pw0[1] = PKW(P0, 2), pw0); \
    VRD(4); SBAR(); GAPA(C1 = __builtin_amdgcn_mfma_f32_32x32x16_bf16(kf[1], qr[0], cbt, 0, 0, 0), pw0[2] = PKW(P0, 4), pw0[3] = PKW(P0, 6), pw0); \
    VRD(1); SBAR(); GAPA(C0 = __builtin_amdgcn_mfma_f32_32x32x16_bf16(kf[2], qr[1], C0, 0, 0, 0),   pw1[0] = PKW(P0, 8), pw1[1] = PKW(P0, 10), pw1); \
    VRD(5); SBAR(); GAPA(C1 = __builtin_amdgcn_mfma_f32_32x32x16_bf16(kf[3], qr[1], C1, 0, 0, 0),   pw1[2] = PKW(P0, 12), pw1[3] = PKW(P0, 14), pw1); \
    VRD(2); SBAR(); GAPA(C0 = __builtin_amdgcn_mfma_f32_32x32x16_bf16(kf[4], qr[2], C0, 0, 0, 0),   pw2[0] = PKW(P1, 0), pw2[1] = PKW(P1, 2), pw2); \
    VRD(6); SBAR(); GAPA(C1 = __builtin_amdgcn_mfma_f32_32x32x16_bf16(kf[5], qr[2], C1, 0, 0, 0),   pw2[2] = PKW(P1, 4), pw2[3] = PKW(P1, 6), pw2); \
    VRD(3); SBAR(); GAPA(C0 = __builtin_amdgcn_mfma_f32_32x32x16_bf16(kf[6], qr[3], C0, 0, 0, 0),   pw3[0] = PKW(P1, 8), pw3[1] = PKW(P1, 10), pw3); \
    VRD(7); SBAR(); GAPA(C1 = __builtin_amdgcn_mfma_f32_32x32x16_bf16(kf[7], qr[3], C1, 0, 0, 0),   pw3[2] = PKW(P1, 12), pw3[3] = PKW(P1, 14), pw3); \
    if (GK) { DMA_K((t) + 3, sl_cur); } if (GV) { DMA_V((t) + 1, sl_next); } \
    BIASADD(C0, C1, t); \
    SBAR(); \
    GAPB0(PVM(0, 0, 0), C0, 0);  VRD(8);  SBAR(); \
    GAPB(PVM(1, 0, 4), C0, 2, C0, 0);  VRD(12); SBAR(); \
    GAPB(PVM(0, 1, 1), C0, 4, C0, 2);  VRD(9);  SBAR(); \
    GAPB(PVM(1, 1, 5), C0, 6, C0, 4);  VRD(13); SBAR(); \
    KRD(GL, 0); GAPB(PVM(0, 2, 2), C0, 8, C0, 6);  VRD(10); SBAR(); \
    GAPB(PVM(1, 2, 6), C0, 10, C0, 8); VRD(14); SBAR(); \
    KRD(GL, 1); GAPB(PVM(0, 3, 3), C0, 12, C0, 10); VRD(11); SBAR(); \
    GAPB(PVM(1, 3, 7), C0, 14, C0, 12); VRD(15); SBAR(); \
    KRD(GL, 2); GAPB(PVM(2, 0, 8), C1, 0, C0, 14); \
    GAPB(PVM(3, 0, 12), C1, 2, C1, 0); \
    KRD(GL, 3); GAPB(PVM(2, 1, 9), C1, 4, C1, 2); \
    GAPB(PVM(3, 1, 13), C1, 6, C1, 4); \
    GAPB(PVM(2, 2, 10), C1, 8, C1, 6); \
    GAPB(PVM(3, 2, 14), C1, 10, C1, 8); \
    GAPB(PVM(2, 3, 11), C1, 12, C1, 10); \
    GAPB(PVM(3, 3, 15), C1, 14, C1, 12); \
    sacc += C1[14]; sacc += C1[15]; l_reg += sacc; \
    } while (0)
    int t = 1;
    for (; t + 5 < NT; t += 2) {
        STEP(pB0, pB1, pA0, pA1, t, true, true, true);     WAIT_BAR(3); ROT(); CB_UPD(t + 1);
        STEP(pA0, pA1, pB0, pB1, t + 1, true, true, true); WAIT_BAR(3); ROT(); CB_UPD(t + 2);
    }
#define ENDW(tt) do { if ((tt) + 3 < NT) { WAIT_BAR(3); } else if ((tt) + 2 < NT) { WAIT_BAR(2); } else { WAIT_BAR(0); } } while (0)
    for (; t + 1 < NT; t += 2) {
        STEP(pB0, pB1, pA0, pA1, t, (t + 3 < NT), (t + 1 < NT), (t + 1 < NT));       ENDW(t);     ROT(); CB_UPD(t + 1);
        STEP(pA0, pA1, pB0, pB1, t + 1, (t + 4 < NT), (t + 2 < NT), (t + 2 < NT));   ENDW(t + 1); ROT(); CB_UPD(t + 2);
    }
    STEP(pB0, pB1, pA0, pA1, NT - 1, false, false, false);
    { pw0 = (u32x4){PKW(pB0, 0), PKW(pB0, 2), PKW(pB0, 4), PKW(pB0, 6)}; pw1 = (u32x4){PKW(pB0, 8), PKW(pB0, 10), PKW(pB0, 12), PKW(pB0, 14)}; pw2 = (u32x4){PKW(pB1, 0), PKW(pB1, 2), PKW(pB1, 4), PKW(pB1, 6)}; pw3 = (u32x4){PKW(pB1, 8), PKW(pB1, 10), PKW(pB1, 12), PKW(pB1, 14)};
      SBAR(); pv(o, vb0 + 2 * sl_cur, PAF(0), PAF(1), PAF(2), PAF(3)); pv(o + 2, vb0 + 2 * sl_cur + 8192, PAF(0), PAF(1), PAF(2), PAF(3)); }
#undef PKW
#undef PAF
#undef VFR
#undef PIN
#undef MX3
#undef GAPA
#undef GAPB
#undef GAPB0
#undef EX
#undef VRD
#undef KRD
#undef PVM
#undef STEP
#undef ENDW
    { auto rr = __builtin_amdgcn_permlane32_swap(__float_as_uint(l_reg), __float_as_uint(l_reg), false, false); l_reg = __uint_as_float(rr[0]) + __uint_as_float(rr[1]); }
    if (hi == 0) wsf[32 + r32] = l_reg;
    asm volatile("s_waitcnt lgkmcnt(0)\n\ts_barrier" ::: "memory");
    float rli[16];
#pragma unroll
    for (int r = 0; r < 16; ++r) rli[r] = __builtin_amdgcn_rcpf(wsf[32 + crow(r, hi)]);
    b_pair_epilogue(o, rli, m, lam, subln, Op + (long)(q0 + wid * QBLK) * OPITCH, shm, wid, lane, r32, hi);
#undef DMA_K
#undef DMA_V
#undef BCONST_T
#undef BIASADD
#undef CB_UPD
#undef ROT
}
#undef SBAR
#undef WAIT_BAR
}

__device__ __forceinline__ void p0_transpose_item(const float* W, int K, int N, bf16_t* WT, int k0, int n0, int rowbase, LAS float* scr, int lane) {
#pragma unroll 8
    for (int i = 0; i < 32; ++i) { const int kk = 2 * i + (lane >> 5); scr[kk * 33 + (lane & 31)] = __builtin_nontemporal_load(W + (size_t)(k0 + kk) * N + n0 + (lane & 31)); }
    LDS_WAIT(); asm volatile("" ::: "memory");
    const int c = lane & 7;
#pragma unroll
    for (int j = 0; j < 4; ++j) { const int n = (lane >> 3) + 8 * j; const LAS float* s = scr + (8 * c) * 33 + n;
        u32x4 o; o.x = cvtpk(s[0 * 33], s[1 * 33]); o.y = cvtpk(s[2 * 33], s[3 * 33]); o.z = cvtpk(s[4 * 33], s[5 * 33]); o.w = cvtpk(s[6 * 33], s[7 * 33]);
        *(u32x4*)(WT + (size_t)(rowbase + n) * K + k0 + 8 * c) = o; }
    LDS_WAIT(); asm volatile("" ::: "memory");
}
__device__ __forceinline__ void p0_transpose_item_q(const float* W, int K, int N, unsigned char* WT, int k0, int n0, int rowbase, LAS float* scr, int lane, float sc) {
#pragma unroll 8
    for (int i = 0; i < 32; ++i) { const int kk = 2 * i + (lane >> 5); scr[kk * 33 + (lane & 31)] = __builtin_nontemporal_load(W + (size_t)(k0 + kk) * N + n0 + (lane & 31)); }
    LDS_WAIT(); asm volatile("" ::: "memory");
    const int c = lane & 7;
#pragma unroll
    for (int j = 0; j < 4; ++j) { const int n = (lane >> 3) + 8 * j; const LAS float* s = scr + (8 * c) * 33 + n;
        u32x2 o; o.x = pk_fp8x4(s[0 * 33] * sc, s[1 * 33] * sc, s[2 * 33] * sc, s[3 * 33] * sc); o.y = pk_fp8x4(s[4 * 33] * sc, s[5 * 33] * sc, s[6 * 33] * sc, s[7 * 33] * sc);
        *(u32x2*)(WT + (size_t)(rowbase + n) * K + k0 + 8 * c) = o; }
    LDS_WAIT(); asm volatile("" ::: "memory");
}
constexpr int I_GU = 16 * 64, I_DN = 32 * 32, N_EXPERT_ITEMS = 16 * (2 * I_GU + I_DN);
struct XItem { const float* src; unsigned char* dst; int N, K; float sc; };
__device__ __forceinline__ XItem xitem(const Params& P, int r) {
    unsigned char* ws = P.ws; XItem x;
    if (r < 16 * I_GU) { const int e = r / I_GU, q = r % I_GU, kb = q / 64, n0 = (q % 64) * 32;
        x.src = P.w_gate + (size_t)e * 1024 * 2048 + (size_t)kb * 64 * 2048 + n0; x.dst = ws + WS_WGU + (size_t)e * 4096 * 1024 + (size_t)((n0 >> 7) * 256 + (n0 & 127)) * 1024 + kb * 64; x.N = 2048; x.K = 1024; x.sc = 32.f; return x; }
    r -= 16 * I_GU;
    if (r < 16 * I_GU) { const int e = r / I_GU, q = r % I_GU, kb = q / 64, n0 = (q % 64) * 32;
        x.src = P.w_up + (size_t)e * 1024 * 2048 + (size_t)kb * 64 * 2048 + n0; x.dst = ws + WS_WGU + (size_t)e * 4096 * 1024 + (size_t)((n0 >> 7) * 256 + 128 + (n0 & 127)) * 1024 + kb * 64; x.N = 2048; x.K = 1024; x.sc = 32.f; return x; }
    r -= 16 * I_GU;
    { const int e = r / I_DN, q = r % I_DN, kb = q / 32, n0 = (q % 32) * 32;
        x.src = P.w_down + (size_t)e * 2048 * 1024 + (size_t)kb * 64 * 1024 + n0; x.dst = ws + WS_WD + (size_t)e * 1024 * 2048 + (size_t)n0 * 2048 + kb * 64; x.N = 1024; x.K = 2048; x.sc = 64.f; return x; }
}
__device__ __forceinline__ void xitem_load(const XItem& x, f32x4 (&v)[8], int lane) {
    const float* p = x.src + (size_t)(lane >> 3) * x.N + (lane & 7) * 4;
#pragma unroll
    for (int i = 0; i < 8; ++i) v[i] = __builtin_nontemporal_load((const f32x4*)(p + (size_t)(8 * i) * x.N));
}
__device__ __forceinline__ void xitem_store(const XItem& x, const f32x4 (&v)[8], LAS float* scr, int lane) {
    LAS float* w = scr + (lane >> 3) * 33 + (lane & 7) * 4;
#pragma unroll
    for (int i = 0; i < 8; ++i) { w[(8 * i) * 33 + 0] = v[i][0]; w[(8 * i) * 33 + 1] = v[i][1]; w[(8 * i) * 33 + 2] = v[i][2]; w[(8 * i) * 33 + 3] = v[i][3]; }
    LDS_WAIT(); asm volatile("" ::: "memory");
    const int c = lane & 7; const float sc = x.sc;
#pragma unroll
    for (int j = 0; j < 4; ++j) { const int n = (lane >> 3) + 8 * j; const LAS float* s = scr + (8 * c) * 33 + n;
        u32x2 o; o.x = pk_fp8x4(s[0 * 33] * sc, s[1 * 33] * sc, s[2 * 33] * sc, s[3 * 33] * sc); o.y = pk_fp8x4(s[4 * 33] * sc, s[5 * 33] * sc, s[6 * 33] * sc, s[7 * 33] * sc);
        *(u32x2*)(x.dst + (size_t)n * x.K + 8 * c) = o; }
    LDS_WAIT(); asm volatile("" ::: "memory");
}
__device__ __forceinline__ void convert_expert_chunk(const Params& P, int first, int stride, int count, LAS float* scr, int lane) {
    f32x4 va[8], vb[8], vc[8];
    XItem xa = xitem(P, first), xb = xitem(P, first + stride), xc = xitem(P, first + 2 * stride);
    xitem_load(xa, va, lane); xitem_load(xb, vb, lane); xitem_load(xc, vc, lane);
#pragma unroll 1
    for (int j = 0; j < count; j += 3) {
        xitem_store(xa, va, scr, lane);
        if (j + 3 < count) { xa = xitem(P, first + (j + 3) * stride); xitem_load(xa, va, lane); }
        xitem_store(xb, vb, scr, lane);
        if (j + 4 < count) { xb = xitem(P, first + (j + 4) * stride); xitem_load(xb, vb, lane); }
        xitem_store(xc, vc, scr, lane);
        if (j + 5 < count) { xc = xitem(P, first + (j + 5) * stride); xitem_load(xc, vc, lane); }
    }
}
__device__ __forceinline__ void phase_prologue(const Params& P, LAS unsigned char* lds, int vcu, int G, int wv) {
    const int tid = ltid(wv), lane = tid & 63, wave = __builtin_amdgcn_readfirstlane(tid >> 6);
    unsigned char* ws = P.ws;
    LAS float* scr = (LAS float*)(lds + wave * 16384);
    const int gw = vcu * NWAVES + wave, NGW = G * NWAVES;
    constexpr int I_IN = 16 * 72, I_SQ = 16 * 32, I_PP = 4 * 32;
    const int NITEMS = I_IN + 2 * I_SQ + I_PP + (G == 256 ? 0 : N_EXPERT_ITEMS);
    for (int it = gw; it < NITEMS; it += NGW) {
        int r = it;
        if (r < I_IN) { const int nb = 72, kb = r / nb, n0 = (r % nb) * 32; p0_transpose_item(P.w_in, 1024, INW, (bf16_t*)(ws + WS_WIN), kb * 64, n0, n0, scr, lane); continue; } r -= I_IN;
        if (r < I_SQ) { const int kb = r / 32, n0 = (r % 32) * 32; p0_transpose_item(P.w_out, 1024, 1024, (bf16_t*)(ws + WS_WO), kb * 64, n0, n0, scr, lane); continue; } r -= I_SQ;
        if (r < I_SQ) { const int kb = r / 32, n0 = (r % 32) * 32; p0_transpose_item(P.w_pg, 1024, 1024, (bf16_t*)(ws + WS_WPG), kb * 64, n0, n0, scr, lane); continue; } r -= I_SQ;
        if (r < I_PP) { const int kb = r / 32, n0 = (r % 32) * 32; p0_transpose_item(P.w_pp, 256, 1024, (bf16_t*)(ws + WS_WPP), kb * 64, n0, n0, scr, lane); continue; } r -= I_PP;
        if (r < 16 * I_GU) { const int e = r / I_GU, q = r % I_GU, kb = q / 64, n0 = (q % 64) * 32;
            p0_transpose_item_q(P.w_gate + (size_t)e * 1024 * 2048, 1024, 2048, ws + WS_WGU + (size_t)e * 4096 * 1024, kb * 64, n0, (n0 >> 7) * 256 + (n0 & 127), scr, lane, 32.f); continue; } r -= 16 * I_GU;
        if (r < 16 * I_GU) { const int e = r / I_GU, q = r % I_GU, kb = q / 64, n0 = (q % 64) * 32;
            p0_transpose_item_q(P.w_up + (size_t)e * 1024 * 2048, 1024, 2048, ws + WS_WGU + (size_t)e * 4096 * 1024, kb * 64, n0, (n0 >> 7) * 256 + 128 + (n0 & 127), scr, lane, 32.f); continue; } r -= 16 * I_GU;
        { const int e = r / I_DN, q = r % I_DN, kb = q / 32, n0 = (q % 32) * 32;
            p0_transpose_item_q(P.w_down + (size_t)e * 2048 * 1024, 2048, 1024, ws + WS_WD + (size_t)e * 1024 * 2048, kb * 64, n0, n0, scr, lane, 64.f); }
    }
    const long gt = (long)vcu * 512 + tid, NTH = (long)G * 512;
    { const f32x4* src = (const f32x4*)P.x; u32x4* dst = (u32x4*)(ws + WS_RH);
      for (long i = gt; i < (long)MROWS * DMODEL / 8; i += NTH) { const f32x4 a = __builtin_nontemporal_load(src + 2 * i), b = __builtin_nontemporal_load(src + 2 * i + 1); u32x4 o; o.x = cvtpk(a[0], a[1]); o.y = cvtpk(a[2], a[3]); o.z = cvtpk(b[0], b[1]); o.w = cvtpk(b[2], b[3]); dst[i] = o; } }
    if (G != 256) { const f32x4* src = (const f32x4*)P.p; u32x4* dst = (u32x4*)(ws + WS_PB);
      for (long i = gt; i < (long)MROWS * PLE / 8; i += NTH) { const f32x4 a = __builtin_nontemporal_load(src + 2 * i), b = __builtin_nontemporal_load(src + 2 * i + 1); u32x4 o; o.x = cvtpk(a[0], a[1]); o.y = cvtpk(a[2], a[3]); o.z = cvtpk(b[0], b[1]); o.w = cvtpk(b[2], b[3]); dst[i] = o; } }
}

__device__ __forceinline__ void phase_qknorm_rope(const Params& P, LAS unsigned char* lds, int vcu, int G, int wv) {
    const int tid = ltid(wv);
    LAS f32x2* cs = (LAS f32x2*)lds;
    LAS float* gq = (LAS float*)(lds + 16384); LAS float* gk = gq + 64;
    for (int idx = tid; idx < 2048; idx += 512) { const int pos = idx >> 4, i = idx & 15; const float inv = powf(10000.f, -(float)(2 * i) / 32.f); const float ang = (float)pos * inv; cs[idx] = (f32x2){cosf(ang), sinf(ang)}; }
    if (tid < 64) { gq[tid] = P.a_q_norm[tid]; gk[tid] = P.a_k_norm[tid]; }
    __syncthreads();
    bf16_t* cols = (bf16_t*)(P.ws + WS_RH + 64 * MiB);
    const long NTH = (long)G * 512;
    for (long item = (long)vcu * 512 + tid; item < (long)MROWS * 10; item += NTH) {
        const int row = (int)(item / 10), head = (int)(item % 10);
        u32x4* ptr = (u32x4*)(cols + (size_t)row * INW + head * 64);
        float x[64]; float ss = 0.f;
#pragma unroll
        for (int c = 0; c < 8; ++c) { const u32x4 w = ptr[c];
            x[8 * c + 0] = bf_lo(w.x); x[8 * c + 1] = bf_hi(w.x); x[8 * c + 2] = bf_lo(w.y); x[8 * c + 3] = bf_hi(w.y);
            x[8 * c + 4] = bf_lo(w.z); x[8 * c + 5] = bf_hi(w.z); x[8 * c + 6] = bf_lo(w.w); x[8 * c + 7] = bf_hi(w.w); }
#pragma unroll
        for (int d = 0; d < 64; ++d) ss += x[d] * x[d];
        const float rinv = 1.0f / sqrtf(ss * (1.f / 64.f) + QK_EPS);
        const LAS float* g = head < 8 ? gq : gk;
#pragma unroll
        for (int d = 0; d < 64; ++d) x[d] = x[d] * rinv * g[d];
        const int t = row & (SEQ - 1), rp = t >> 6, cp = t & 63;
        const float sc = head < 8 ? C2 : 1.f;
#pragma unroll
        for (int i = 0; i < 16; ++i) {
            const f32x2 a = cs[rp * 16 + i], b = cs[cp * 16 + i];
            const float x1 = x[i], x2 = x[i + 16], y1 = x[32 + i], y2 = x[48 + i];
            x[i] = (x1 * a.x - x2 * a.y) * sc; x[i + 16] = (x2 * a.x + x1 * a.y) * sc;
            x[32 + i] = (y1 * b.x - y2 * b.y) * sc; x[48 + i] = (y2 * b.x + y1 * b.y) * sc;
        }
        const float s8 = head < 8 ? 16.f : 1.f;
        u32x2* q8 = head < 8 ? (u32x2*)((unsigned char*)P.out + OUT_Q8 + (size_t)row * 512 + head * 64) : (u32x2*)((unsigned char*)P.out + OUT_K8 + (size_t)row * 128 + (head - 8) * 64);
#pragma unroll
        for (int c = 0; c < 8; ++c) { u32x4 w; w.x = cvtpk(x[8 * c], x[8 * c + 1]); w.y = cvtpk(x[8 * c + 2], x[8 * c + 3]); w.z = cvtpk(x[8 * c + 4], x[8 * c + 5]); w.w = cvtpk(x[8 * c + 6], x[8 * c + 7]); ptr[c] = w;
            u32x2 e; e.x = pk_fp8x4(x[8 * c] * s8, x[8 * c + 1] * s8, x[8 * c + 2] * s8, x[8 * c + 3] * s8); e.y = pk_fp8x4(x[8 * c + 4] * s8, x[8 * c + 5] * s8, x[8 * c + 6] * s8, x[8 * c + 7] * s8); q8[c] = e;
            asm volatile("" ::: "memory"); }
    }
    __syncthreads();
    {
        const int tid2 = ltid(wv), lane = tid2 & 63, wave = wv;
        LAS unsigned char* tl = lds + wave * 4096;
        const int k5 = lane & 31, pk = 32 * ((k5 >> 2) & 1) + 16 * (lane >> 5) + (k5 & 3) + 4 * (k5 >> 3);
        for (int tile = vcu * NWAVES + wave; tile < BATCH * 2 * (SEQ / 64); tile += G * NWAVES) {
            const int b = tile >> 8, g = (tile >> 7) & 1, tt = tile & 127;
            const u32x4* vr = (const u32x4*)(cols + (size_t)(b * SEQ + tt * 64 + lane) * INW + COL_VA + g * 64);
#pragma unroll
            for (int c = 0; c < 8; ++c) { const u32x4 w = vr[c];
                const unsigned q0 = pk_fp8x4(bf_lo(w.x) * 4.f, bf_hi(w.x) * 4.f, bf_lo(w.y) * 4.f, bf_hi(w.y) * 4.f), q1 = pk_fp8x4(bf_lo(w.z) * 4.f, bf_hi(w.z) * 4.f, bf_lo(w.w) * 4.f, bf_hi(w.w) * 4.f);
#pragma unroll
                for (int j = 0; j < 4; ++j) { tl[(8 * c + j) * 64 + pk] = (unsigned char)(q0 >> (8 * j)); tl[(8 * c + 4 + j) * 64 + pk] = (unsigned char)(q1 >> (8 * j)); } }
            LDS_WAIT(); asm volatile("" ::: "memory");
            u32x4* dst = (u32x4*)((unsigned char*)P.out + OUT_VT8 + ((size_t)((b * 2 + g) * 64 + lane)) * SEQ + tt * 64);
#pragma unroll
            for (int c = 0; c < 4; ++c) dst[c] = *(const LAS u32x4*)(tl + lane * 64 + c * 16);
            LDS_WAIT(); asm volatile("" ::: "memory");
        }
    }
}

__device__ __forceinline__ void phase_attention(const Params& P, unsigned char* ldsg, int vcu, int G, int wv) {
    const int tid = ltid(wv);
    char* shm = (char*)ldsg;
    const attn_body::bf16* cols = (const attn_body::bf16*)(P.ws + WS_RH + 64 * MiB);
    attn_body::bf16* mix = (attn_body::bf16*)(P.ws + WS_R3);
    const float a_bound = 8.f * LOG2E * wave_max(fabsf(P.a_q_norm[tid & 63])) * wave_max(fabsf(P.a_k_norm[tid & 63])) * 1.02f;
    const bool a_bounded = a_bound < 64.f;
    const float a_negR = -fmaxf(a_bound - 8.f, 0.f);
    bool b_bounded;
    { const unsigned* bnd = (const unsigned*)P.ws + 3520;
      const float mq = __uint_as_float(__hip_atomic_load(bnd, __ATOMIC_RELAXED, __HIP_MEMORY_SCOPE_AGENT)), mk = __uint_as_float(__hip_atomic_load(bnd + 64, __ATOMIC_RELAXED, __HIP_MEMORY_SCOPE_AGENT));
      const float bmax = wave_max(fabsf(P.rel_bias[(tid & 63) * 2]) > fabsf(P.rel_bias[(tid & 63) * 2 + 1]) ? fabsf(P.rel_bias[(tid & 63) * 2]) : fabsf(P.rel_bias[(tid & 63) * 2 + 1])) * LOG2E;
      b_bounded = (2.f * sqrtf(mq * mk) + bmax) < 90.f; }
    const float lam = expf(wave_sum(P.lq1[tid & 63] * P.lk1[tid & 63])) - expf(wave_sum(P.lq2[tid & 63] * P.lk2[tid & 63])) + LAM_INIT;
    int ri = 0;
    for (int u = vcu; u < 1536; u += G, ++ri) {
        if (G == 256 && ri == (vcu & 3)) {
            const int lane_ = ltid(wv) & 63;
            LAS float* scr = (LAS float*)((LAS unsigned char*)(uintptr_t)(unsigned)(uintptr_t)shm + 65536 + wv * 8448);
            convert_expert_chunk(P, (vcu & 3) * (N_EXPERT_ITEMS / 4) + (vcu >> 2) * NWAVES + wv, 512, N_EXPERT_ITEMS / 4 / 512, scr, lane_);
            {
                const f32x4* src = (const f32x4*)P.p + 2 * ((long)vcu * 4096); u32x4* dst = (u32x4*)(P.ws + WS_PB) + (long)vcu * 4096; const int t_ = ltid(wv);
                f32x4 a[8], b2[8];
#pragma unroll
                for (int j = 0; j < 8; ++j) { a[j] = __builtin_nontemporal_load(src + 2 * (t_ + 512 * j)); b2[j] = __builtin_nontemporal_load(src + 2 * (t_ + 512 * j) + 1); }
#pragma unroll
                for (int j = 0; j < 8; ++j) { u32x4 o; o.x = cvtpk(a[j][0], a[j][1]); o.y = cvtpk(a[j][2], a[j][3]); o.z = cvtpk(b2[j][0], b2[j][1]); o.w = cvtpk(b2[j][2], b2[j][3]); dst[t_ + 512 * j] = o; }
            }
            __syncthreads();
        }
        const int i = u >> 8, v = u & 255, x = v >> 5, qb = v & 31, b = x >> 1;
        const attn_body::bf16* base = cols + (size_t)b * SEQ * INW;
        if (i < 4) { const int g = x & 1, h = g * 4 + i;
            if (a_bounded) attn_body::attn_unit_a8((const unsigned char*)P.out + OUT_Q8 + (size_t)b * SEQ * 512 + h * 64, (const unsigned char*)P.out + OUT_K8 + (size_t)b * SEQ * 128 + g * 64,
                                                   (const unsigned char*)P.out + OUT_VT8 + (size_t)((b * 2 + g) * 64) * SEQ, mix + (size_t)b * SEQ * DMODEL + h * 64, qb * 256, a_negR, shm, wv);
            else attn_body::attn_unit<8>(base + COL_QA + h * 64, base + COL_KA + g * 64, base + COL_VA + g * 64, mix + (size_t)b * SEQ * DMODEL + h * 64, qb * 256, shm, wv); }
        else { const int h = (x & 1) * 2 + (i - 4);
            {
                float* tab = (float*)(shm + attn_body::LDS_TAB);
                const int idx = tid, rel = idx - 256, n = rel < 0 ? -rel : rel;
                int bk = (n < 8) ? n : (2 + (31 - __builtin_clz((unsigned)(n * n)))); if (bk > 15) bk = 15;
                bk += (rel > 0) ? 16 : 0;
                tab[idx] = P.rel_bias[bk * 4 + h] * LOG2E;
                __syncthreads();
            }
            const float cL = P.rel_bias[15 * 4 + h] * LOG2E, cR = P.rel_bias[31 * 4 + h] * LOG2E;
            attn_body::bf16* Ob = mix + (size_t)b * SEQ * DMODEL + 512 + h * 128;
#pragma unroll 1
            for (int m = 0; m < 2; ++m) {
                if (b_bounded) attn_body::attn_unit_v128nm(base + COL_QB + (h * 2 + m) * 64, base + COL_KB + (h * 2 + m) * 64, base + COL_VB + h * 128, Ob, qb * 256, cL, cR, attn_body::LDS_TAB, m, lam, P.subln, shm, wv);
                else attn_body::attn_unit_v128<8>(base + COL_QB + (h * 2 + m) * 64, base + COL_KB + (h * 2 + m) * 64, base + COL_VB + h * 128, Ob, qb * 256, cL, cR, attn_body::LDS_TAB, m, lam, P.subln, shm, wv);
            }
        }
    }
}

__device__ __forceinline__ void ln_row(f32x4 (&v)[4], const float* g, const float* bta, int lane) {
    float s = 0.f;
#pragma unroll
    for (int j = 0; j < 4; ++j) s += (v[j][0] + v[j][1]) + (v[j][2] + v[j][3]);
    const float mean = wave_sum(s) * (1.f / DMODEL); float s2 = 0.f;
#pragma unroll
    for (int j = 0; j < 4; ++j) { v[j] = v[j] - mean; s2 += (v[j][0] * v[j][0] + v[j][1] * v[j][1]) + (v[j][2] * v[j][2] + v[j][3] * v[j][3]); }
    const float rstd = 1.0f / sqrtf(wave_sum(s2) * (1.f / DMODEL) + LN_EPS);
#pragma unroll
    for (int j = 0; j < 4; ++j) { const f32x4 gg = *(const f32x4*)(g + 256 * j + 4 * lane), bb = *(const f32x4*)(bta + 256 * j + 4 * lane); v[j] = v[j] * rstd * gg + bb; }
}
__device__ __forceinline__ void load_row_raw(const bf16_t* irow, u32x2 (&w)[4], int lane) {
#pragma unroll
    for (int j = 0; j < 4; ++j) w[j] = *(const u32x2*)(irow + 256 * j + 4 * lane);
}
__device__ __forceinline__ void cvt_row_raw(const u32x2 (&w)[4], f32x4 (&v)[4]) {
#pragma unroll
    for (int j = 0; j < 4; ++j) v[j] = (f32x4){bf_lo(w[j].x), bf_hi(w[j].x), bf_lo(w[j].y), bf_hi(w[j].y)};
}
__device__ __forceinline__ void load_row_bf16(const bf16_t* irow, f32x4 (&v)[4], int lane) {
#pragma unroll
    for (int j = 0; j < 4; ++j) { const u32x2 w = *(const u32x2*)(irow + 256 * j + 4 * lane); v[j] = (f32x4){bf_lo(w.x), bf_hi(w.x), bf_lo(w.y), bf_hi(w.y)}; }
}
__device__ __forceinline__ void store_row_bf16(bf16_t* orow, const f32x4 (&v)[4], int lane) {
#pragma unroll
    for (int j = 0; j < 4; ++j) { u32x2 w; w.x = cvtpk(v[j][0], v[j][1]); w.y = cvtpk(v[j][2], v[j][3]); *(u32x2*)(orow + 256 * j + 4 * lane) = w; }
}

__device__ __forceinline__ float router_reduce16(const f32x4 (&lgv)[4], int lane) {
    float b[8], c[4], d[2];
#pragma unroll
    for (int e = 0; e < 8; ++e) { auto rr = __builtin_amdgcn_permlane32_swap(__float_as_uint(lgv[e >> 2][e & 3]), __float_as_uint(lgv[2 + (e >> 2)][e & 3]), false, false); b[e] = __uint_as_float(rr[0]) + __uint_as_float(rr[1]); }
    const bool b4 = (lane & 16) != 0, b3 = (lane & 8) != 0, b2 = (lane & 4) != 0;
#pragma unroll
    for (int e = 0; e < 4; ++e) { const float keep = b4 ? b[e + 4] : b[e], send = b4 ? b[e] : b[e + 4]; c[e] = keep + swz_xor<16>(send); }
#pragma unroll
    for (int e = 0; e < 2; ++e) { const float keep = b3 ? c[e + 2] : c[e], send = b3 ? c[e] : c[e + 2]; d[e] = keep + swz_xor<8>(send); }
    float f; { const float keep = b2 ? d[1] : d[0], send = b2 ? d[0] : d[1]; f = keep + swz_xor<4>(send); }
    f += swz_xor<2>(f); f += swz_xor<1>(f);
    return f;
}
__device__ __forceinline__ void phase_ln1_router(const Params& P, LAS unsigned char* lds, int vcu, int G, int wv) {
    const int tid = ltid(wv), lane = tid & 63, wave = tid >> 6, r = lane & 15, g = lane >> 4;
    LAS u32x4* whi = (LAS u32x4*)lds; LAS u32x4* wlo = (LAS u32x4*)(lds + 32768);
    for (int i = tid; i < 2048; i += 512) { const int ks = i >> 6, ln = i & 63, e = ln & 15, gg = ln >> 4; float w[8]; unsigned hb[8], lb[8];
#pragma unroll
        for (int j = 0; j < 8; ++j) { w[j] = P.w_router[(size_t)(32 * ks + 8 * gg + j) * 16 + e]; }
#pragma unroll
        for (int j = 0; j < 8; j += 2) { const unsigned h2 = cvtpk(w[j], w[j + 1]); hb[j / 2] = h2; lb[j / 2] = cvtpk(w[j] - bf_lo(h2), w[j + 1] - bf_hi(h2)); }
        whi[i] = (u32x4){hb[0], hb[1], hb[2], hb[3]}; wlo[i] = (u32x4){lb[0], lb[1], lb[2], lb[3]}; }
    __syncthreads();
    float* aff = (float*)(P.ws + WS_AFF); bf16_t* x1b = (bf16_t*)(P.ws + WS_R3); unsigned char* x1q = (unsigned char*)P.out + 64 * MiB;
    const bf16_t* xb = (const bf16_t*)(P.ws + WS_RH); const bf16_t* mixo = (const bf16_t*)P.out;
    const int gw = vcu * NWAVES + wave, NGW = G * NWAVES;
    for (int tile = gw; tile < MROWS / 16; tile += NGW) {
        const size_t rowoff = (size_t)(tile * 16 + r) * DMODEL + 8 * g;
        float s1 = 0.f, s2 = 0.f;
#pragma unroll 8
        for (int ks = 0; ks < 32; ++ks) { const u32x4 a = *(const u32x4*)(xb + rowoff + 32 * ks), m = *(const u32x4*)(mixo + rowoff + 32 * ks);
            float y[8] = {bf_lo(a.x) * ALPHA + bf_lo(m.x), bf_hi(a.x) * ALPHA + bf_hi(m.x), bf_lo(a.y) * ALPHA + bf_lo(m.y), bf_hi(a.y) * ALPHA + bf_hi(m.y),
                          bf_lo(a.z) * ALPHA + bf_lo(m.z), bf_hi(a.z) * ALPHA + bf_hi(m.z), bf_lo(a.w) * ALPHA + bf_lo(m.w), bf_hi(a.w) * ALPHA + bf_hi(m.w)};
#pragma unroll
            for (int j = 0; j < 8; ++j) { s1 += y[j]; s2 += y[j] * y[j]; } }
        s1 += swz_xor<16>(s1); s2 += swz_xor<16>(s2);
        { auto rr = __builtin_amdgcn_permlane32_swap(__float_as_uint(s1), __float_as_uint(s1), false, false); s1 = __uint_as_float(rr[0]) + __uint_as_float(rr[1]); }
        { auto rr = __builtin_amdgcn_permlane32_swap(__float_as_uint(s2), __float_as_uint(s2), false, false); s2 = __uint_as_float(rr[0]) + __uint_as_float(rr[1]); }
        const float mean = s1 * (1.f / DMODEL); const float var = fmaxf(s2 * (1.f / DMODEL) - mean * mean, 0.f); const float rstd = 1.0f / sqrtf(var + LN_EPS);
        f32x4 acc = {0.f, 0.f, 0.f, 0.f};
#pragma unroll 4
        for (int ks = 0; ks < 32; ++ks) { const u32x4 a = *(const u32x4*)(xb + rowoff + 32 * ks), m = *(const u32x4*)(mixo + rowoff + 32 * ks);
            const f32x4 g0 = *(const f32x4*)(P.ln1_g + 32 * ks + 8 * g), g1 = *(const f32x4*)(P.ln1_g + 32 * ks + 8 * g + 4), b0 = *(const f32x4*)(P.ln1_b + 32 * ks + 8 * g), b1 = *(const f32x4*)(P.ln1_b + 32 * ks + 8 * g + 4);
            float x[8] = {bf_lo(a.x) * ALPHA + bf_lo(m.x), bf_hi(a.x) * ALPHA + bf_hi(m.x), bf_lo(a.y) * ALPHA + bf_lo(m.y), bf_hi(a.y) * ALPHA + bf_hi(m.y),
                          bf_lo(a.z) * ALPHA + bf_lo(m.z), bf_hi(a.z) * ALPHA + bf_hi(m.z), bf_lo(a.w) * ALPHA + bf_lo(m.w), bf_hi(a.w) * ALPHA + bf_hi(m.w)};
#pragma unroll
            for (int j = 0; j < 4; ++j) { x[j] = (x[j] - mean) * rstd * g0[j] + b0[j]; x[4 + j] = (x[4 + j] - mean) * rstd * g1[j] + b1[j]; }
            u32x4 hi, lo;
            hi.x = cvtpk(x[0], x[1]); hi.y = cvtpk(x[2], x[3]); hi.z = cvtpk(x[4], x[5]); hi.w = cvtpk(x[6], x[7]);
            lo.x = cvtpk(x[0] - bf_lo(hi.x), x[1] - bf_hi(hi.x)); lo.y = cvtpk(x[2] - bf_lo(hi.y), x[3] - bf_hi(hi.y)); lo.z = cvtpk(x[4] - bf_lo(hi.z), x[5] - bf_hi(hi.z)); lo.w = cvtpk(x[6] - bf_lo(hi.w), x[7] - bf_hi(hi.w));
            *(u32x4*)(x1b + rowoff + 32 * ks) = hi;
            { u32x2 qv; qv.x = pk_fp8x4(x[0], x[1], x[2], x[3]); qv.y = pk_fp8x4(x[4], x[5], x[6], x[7]); *(u32x2*)(x1q + rowoff + 32 * ks) = qv; }
            const bf16x8 ah = __builtin_bit_cast(bf16x8, hi), al = __builtin_bit_cast(bf16x8, lo);
            const bf16x8 wh = __builtin_bit_cast(bf16x8, whi[ks * 64 + lane]), wl = __builtin_bit_cast(bf16x8, wlo[ks * 64 + lane]);
            acc = __builtin_amdgcn_mfma_f32_16x16x32_bf16(ah, wh, acc, 0, 0, 0);
            acc = __builtin_amdgcn_mfma_f32_16x16x32_bf16(al, wh, acc, 0, 0, 0);
            acc = __builtin_amdgcn_mfma_f32_16x16x32_bf16(ah, wl, acc, 0, 0, 0); }
#pragma unroll
        for (int q = 0; q < 4; ++q) { float f = acc[q], mx = f;
            mx = fmaxf(mx, swz_xor<1>(mx)); mx = fmaxf(mx, swz_xor<2>(mx)); mx = fmaxf(mx, swz_xor<4>(mx)); mx = fmaxf(mx, swz_xor<8>(mx));
            const float pe = expf(f - mx); float sm = pe; sm += swz_xor<1>(sm); sm += swz_xor<2>(sm); sm += swz_xor<4>(sm); sm += swz_xor<8>(sm);
            aff[(size_t)(tile * 16 + 4 * g + q) * 16 + r] = pe / sm; }
    }
}

__device__ __forceinline__ void phase_topk(const Params& P, LAS unsigned char* lds, int blk, int G, int wv) {
    const int tid = ltid(wv), lane = tid & 63, wid = tid >> 6;
    LAS unsigned* cntb = (LAS unsigned*)lds;
    LAS unsigned* wtot = (LAS unsigned*)(lds + 256);
    const float* affp = (const float*)(P.ws + WS_AFF); int* slotmap = (int*)(P.ws + WS_SLOT); int* tok = (int*)(P.ws + WS_TOK); float* gate = (float*)(P.ws + WS_GATE);
    for (int item = blk; item < BATCH * NEXP; item += G) {
        const int b = item >> 4, e = item & 15;
        unsigned ku[16];
#pragma unroll
        for (int j = 0; j < 16; ++j) ku[j] = __float_as_uint(affp[((size_t)b * SEQ + tid + 512 * j) * 16 + e]);
        unsigned T = 0;
        {
            const unsigned cand = 1u << 30; unsigned c = 0;
#pragma unroll
            for (int j = 0; j < 16; ++j) c += (ku[j] >= cand) ? 1u : 0u;
            c = wave_sum_u(c);
            if (lane == 0) cntb[wid] = c;
            __syncthreads();
            unsigned tot = 0;
#pragma unroll
            for (int w = 0; w < 8; ++w) tot += cntb[w];
            if (tot >= (unsigned)CAP) T = cand;
        }
        for (int b0 = 28, it = 1; b0 >= 0; b0 -= 2, ++it) {
            const unsigned c1 = T | (1u << b0), c2 = T | (2u << b0), c3 = T | (3u << b0);
            unsigned n32 = 0, n1 = 0;
#pragma unroll
            for (int j = 0; j < 16; ++j) { n32 += ((ku[j] >= c3) ? 1u : 0u) + ((ku[j] >= c2) ? 0x10000u : 0u); n1 += (ku[j] >= c1) ? 1u : 0u; }
            n32 = wave_sum_u(n32); n1 = wave_sum_u(n1);
            const int par = it & 1;
            if (lane == 0) { cntb[par * 16 + wid] = n32; cntb[par * 16 + 8 + wid] = n1; }
            __syncthreads();
            unsigned t32 = 0, t1 = 0;
#pragma unroll
            for (int w = 0; w < 8; ++w) { t32 += cntb[par * 16 + w]; t1 += cntb[par * 16 + 8 + w]; }
            const unsigned t3 = t32 & 0xffffu, t2 = t32 >> 16;
            if (t3 >= (unsigned)CAP) T = c3; else if (t2 >= (unsigned)CAP) T = c2; else if (t1 >= (unsigned)CAP) T = c1;
        }
        __syncthreads();
        unsigned cg_ = 0;
#pragma unroll
        for (int j = 0; j < 16; ++j) cg_ += (ku[j] > T) ? 1u : 0u;
        cg_ = wave_sum_u(cg_);
        if (lane == 0) cntb[wid] = cg_;
        __syncthreads();
        unsigned ngt = 0;
#pragma unroll
        for (int w = 0; w < 8; ++w) ngt += cntb[w];
        const unsigned need_eq = (unsigned)CAP - ngt;
        unsigned selmask = 0;
        {
            unsigned below[16];
#pragma unroll
            for (int j = 0; j < 16; ++j) { const unsigned long long bal = __ballot(ku[j] == T); below[j] = __builtin_amdgcn_mbcnt_hi((unsigned)(bal >> 32), __builtin_amdgcn_mbcnt_lo((unsigned)bal, 0u)); if (lane == 0) wtot[j * 8 + wid] = (unsigned)__popcll(bal); }
            __syncthreads();
            unsigned run = 0;
#pragma unroll
            for (int j = 0; j < 16; ++j) { unsigned before = run;
#pragma unroll
                for (int w = 0; w < 8; ++w) { const unsigned c = wtot[j * 8 + w]; before += (w < wid) ? c : 0u; run += c; }
                const bool sel = (ku[j] > T) || ((ku[j] == T) && (before + below[j] < need_eq));
                selmask |= sel ? (1u << j) : 0u; }
            __syncthreads();
        }
        {
            unsigned below[16];
#pragma unroll
            for (int j = 0; j < 16; ++j) { const unsigned long long bal = __ballot((selmask >> j) & 1u); below[j] = __builtin_amdgcn_mbcnt_hi((unsigned)(bal >> 32), __builtin_amdgcn_mbcnt_lo((unsigned)bal, 0u)); if (lane == 0) wtot[j * 8 + wid] = (unsigned)__popcll(bal); }
            __syncthreads();
            unsigned run = 0;
#pragma unroll
            for (int j = 0; j < 16; ++j) { unsigned before = run;
#pragma unroll
                for (int w = 0; w < 8; ++w) { const unsigned c = wtot[j * 8 + w]; before += (w < wid) ? c : 0u; run += c; }
                const int t = tid + 512 * j; const bool sel = (selmask >> j) & 1u; const int slot = (int)(before + below[j]);
                slotmap[((size_t)b * SEQ + t) * 16 + e] = sel ? slot : -1;
                if (sel) { const int vr = (e * 4 + b) * CAP + slot; tok[vr] = b * SEQ + t; gate[vr] = __uint_as_float(ku[j]); } }
            __syncthreads();
        }
    }
}

__device__ __forceinline__ void phase_combine_ln2(const Params& P, int vcu, int G, int wv) {
    const int tid = ltid(wv), lane = tid & 63, wave = tid >> 6;
    const int* slotmap = (const int*)(P.ws + WS_SLOT); const bf16_t* ye = (const bf16_t*)(P.ws + WS_WGU); bf16_t* x2b = (bf16_t*)(P.ws + WS_R3);
    const int gw = vcu * NWAVES + wave, NGW = G * NWAVES;
    for (int row = gw; row < MROWS; row += NGW) {
        bf16_t* xr = x2b + (size_t)row * DMODEL; const int b = row >> 13;
        f32x4 v[4];
        load_row_bf16(xr, v, lane);
#pragma unroll
        for (int j = 0; j < 4; ++j) v[j] = v[j] * ALPHA;
        const int sl = slotmap[(size_t)row * 16 + (lane & 15)];
        unsigned long long m = __ballot(sl >= 0) & 0xffffull;
        while (m) { const int e = __builtin_ctzll(m); m &= m - 1; const int s = __builtin_amdgcn_readlane(sl, e);
            const bf16_t* yr = ye + (size_t)((e * 4 + b) * CAP + s) * DMODEL;
#pragma unroll
            for (int j = 0; j < 4; ++j) { const u32x2 w = *(const u32x2*)(yr + 256 * j + 4 * lane); v[j][0] += bf_lo(w.x); v[j][1] += bf_hi(w.x); v[j][2] += bf_lo(w.y); v[j][3] += bf_hi(w.y); } }
        ln_row(v, P.ln2_g, P.ln2_b, lane);
        store_row_bf16(xr, v, lane);
    }
}
__device__ __forceinline__ void phase_ln3(const Params& P, int vcu, int G, int wv) {
    const int tid = ltid(wv), lane = tid & 63, wave = tid >> 6;
    const bf16_t* y3 = (const bf16_t*)(P.ws + WS_RH + 64 * MiB);
    const int gw = vcu * NWAVES + wave, NGW = G * NWAVES;
    for (int row = gw; row < MROWS; row += NGW) {
        float* xr = P.out + (size_t)row * DMODEL; f32x4 v[4];
        load_row_bf16(y3 + (size_t)row * DMODEL, v, lane);
        ln_row(v, P.ln3_g, P.ln3_b, lane);
#pragma unroll
        for (int j = 0; j < 4; ++j) __builtin_nontemporal_store(v[j], (f32x4*)(xr + 256 * j + 4 * lane));
    }
}

#define XB_TMO      128
#define XB_XCNT(j)  (256  + 64 * (j))
#define XB_XSUB(j)  (1280 + 64 * (j))
#define XB_XGEN(j)  (2304 + 64 * (j))
#define XB_TOP      3328
#define XB_TOPGEN   3392
#define XCD_BAR_WORDS 3456
#define XB_SPIN_CAP (1u << 22)
__device__ __forceinline__ unsigned xb_ld(unsigned* p)              { return __hip_atomic_load(p, __ATOMIC_RELAXED, __HIP_MEMORY_SCOPE_AGENT); }
__device__ __forceinline__ unsigned xb_add(unsigned* p, unsigned v) { return __hip_atomic_fetch_add(p, v, __ATOMIC_RELAXED, __HIP_MEMORY_SCOPE_AGENT); }
__device__ __forceinline__ unsigned xb_xcc_id() { return (unsigned)__builtin_amdgcn_s_getreg((3 << 11) | 20) & 0xFu; }
#define XB_SPIN(cond, bar) do { unsigned _sp = 0; while (cond) { __builtin_amdgcn_s_sleep(1); \
    if ((++_sp & 255u) == 0u) { if (xb_ld(&(bar)[XB_TMO])) break; if (_sp > XB_SPIN_CAP) { atomicAdd(&(bar)[XB_TMO], 1u); break; } } } } while (0)
struct XcdBarrier { unsigned* bar; unsigned x; volatile LAS unsigned* st; };
__device__ __forceinline__ XcdBarrier xcd_barrier_post(unsigned* bar, volatile LAS unsigned* st, int wv) {
    XcdBarrier b; b.bar = bar; b.x = xb_xcc_id(); b.st = st;
    if (ltid(wv) == 0) (void)xb_add(&bar[XB_XCNT(b.x)], 1u);
    return b;
}
__device__ __forceinline__ void xcd_barrier_complete(unsigned* bar, unsigned x, unsigned& nloc, unsigned& nx) {
    const unsigned G = gridDim.x * gridDim.y * gridDim.z;
    unsigned sum, cnt, mine, sp = 0u;
    for (;;) {
        sum = 0u; cnt = 0u; mine = 0u;
#pragma unroll
        for (unsigned j = 0; j < 16; ++j) { const unsigned c = xb_ld(&bar[XB_XCNT(j)]); sum += c; cnt += (c > 0u) ? 1u : 0u; mine = (j == x) ? c : mine; }
        if (sum == G) break;
        __builtin_amdgcn_s_sleep(1);
        if ((++sp & 255u) == 0u) { if (xb_ld(&bar[XB_TMO])) break; if (sp > XB_SPIN_CAP) { atomicAdd(&bar[XB_TMO], 1u); break; } }
    }
    nloc = mine > 0u ? mine : 1u; nx = cnt > 0u ? cnt : 1u;
}
__device__ __forceinline__ void xcd_barrier(const XcdBarrier& b, int wv) {
    asm volatile("s_waitcnt vmcnt(0)" ::: "memory");
    __syncthreads();
    if (ltid(wv) == 0) {
        unsigned* bar = b.bar;
        __builtin_amdgcn_s_waitcnt(0);
        unsigned nloc = b.st[0], nx = b.st[1];
        if (nloc == 0u) { xcd_barrier_complete(bar, b.x, nloc, nx); b.st[0] = nloc; b.st[1] = nx; }
        const unsigned old = xb_add(&bar[XB_XSUB(b.x)], 1u);
        const unsigned gen = old / nloc;
        if (old + 1u == (gen + 1u) * nloc) {
            __builtin_amdgcn_fence(__ATOMIC_RELEASE, "agent");
            asm volatile("s_waitcnt vmcnt(0)" ::: "memory");
            const unsigned og = xb_add(&bar[XB_TOP], 1u);
            const unsigned tg = og / nx;
            if (og + 1u == (tg + 1u) * nx) xb_add(&bar[XB_TOPGEN], 1u);
            else XB_SPIN(xb_ld(&bar[XB_TOPGEN]) == tg, bar);
            __builtin_amdgcn_fence(__ATOMIC_ACQUIRE, "agent");
            xb_add(&bar[XB_XGEN(b.x)], 1u);
            asm volatile("s_waitcnt vmcnt(0)" ::: "memory");
        } else {
            XB_SPIN(xb_ld(&bar[XB_XGEN(b.x)]) == gen, bar);
            __builtin_amdgcn_fence(__ATOMIC_ACQUIRE, "agent");
            asm volatile("s_waitcnt vmcnt(0)" ::: "memory");
        }
    }
    __syncthreads();
}

#ifndef MK_PH_LO
#define MK_PH_LO 0
#endif
#ifndef MK_PH_HI
#define MK_PH_HI 13
#endif
__global__ void __launch_bounds__(NWAVES * 64, 2) fwd_megakernel(Params P) {
    extern __shared__ __attribute__((aligned(16))) unsigned char lds[];
    LAS unsigned char* ldsl = (LAS unsigned char*)lds;
    const int G = gridDim.x, bx = blockIdx.x;
    const int wv = __builtin_amdgcn_readfirstlane((int)(threadIdx.x >> 6));
    const int vcu = (G % 8 == 0) ? (bx % 8) * (G / 8) + bx / 8 : bx;
    unsigned char* ws = P.ws;
    bf16_t* XB = (bf16_t*)(ws + WS_RH); bf16_t* COLS = (bf16_t*)(ws + WS_RH + 64 * MiB); bf16_t* HB = (bf16_t*)(ws + WS_RH); bf16_t* PJ = (bf16_t*)P.out;
    bf16_t* R3 = (bf16_t*)(ws + WS_R3); bf16_t* YE = (bf16_t*)(ws + WS_WGU);
#define PH(k) ((k) >= MK_PH_LO && (k) < MK_PH_HI)
    unsigned* barw = (unsigned*)ws;
    volatile LAS unsigned* bst = (volatile LAS unsigned*)(ldsl + 143360);
    if (ltid(wv) < 2) bst[ltid(wv)] = 0u;
    __syncthreads();
    const XcdBarrier xbar = xcd_barrier_post(barw, bst, wv);
    if (PH(0)) { phase_prologue(P, ldsl, vcu, G, wv); }
    xcd_barrier(xbar, wv);
#define GRID_BAR() xcd_barrier(xbar, wv)
    const bool split_qkv = (G >= 256);
    if (PH(1)) { pg8::ProbPlain S; S.K = 1024; S.ord.init(MROWS / 256, split_qkv ? 8 : INW / 256, G, bx); S.A = (const char*)XB; S.Bt = (const char*)(ws + WS_WIN);
        pg8::EpiQKV E{COLS, (unsigned*)ws + 3520}; pg8::gemm_phase<pg8::ProbPlain, pg8::EpiQKV, true>(ldsl, S, E, wv); }
    GRID_BAR();
    if (PH(2)) {
        if (split_qkv) {
            if (bx < 128) { pg8::ProbPlain S; S.K = 1024; S.ord.init(MROWS / 256, 1, 128, bx, 8); S.A = (const char*)XB; S.Bt = (const char*)(ws + WS_WIN);
                pg8::EpiQKV E{COLS, (unsigned*)ws + 3520}; pg8::gemm_phase<pg8::ProbPlain, pg8::EpiQKV, true>(ldsl, S, E, wv); }
            else phase_qknorm_rope(P, ldsl, bx - 128, G - 128, wv);
        } else phase_qknorm_rope(P, ldsl, vcu, G, wv);
    }
    GRID_BAR();
    if (PH(3)) { phase_attention(P, lds, vcu, G, wv); }
    GRID_BAR();
    if (PH(5)) { pg8::ProbPlain S; S.K = 1024; S.ord.init(MROWS / 256, DMODEL / 256, G, bx); S.A = (const char*)R3; S.Bt = (const char*)(ws + WS_WO);
        pg8::EpiBf16Plain E{(bf16_t*)P.out, DMODEL}; pg8::gemm_phase<pg8::ProbPlain, pg8::EpiBf16Plain, true>(ldsl, S, E, wv); }
    GRID_BAR();
    if (PH(6)) { phase_ln1_router(P, ldsl, vcu, G, wv); }
    GRID_BAR();
    if (PH(7)) {
        if (G >= 128) {
            if (bx < 64) phase_topk(P, ldsl, bx, 64, wv);
            else { pg8::ProbPlain S; S.K = PLE; S.ord.init(MROWS / 256, DMODEL / 256, G - 64, bx - 64); S.A = (const char*)(ws + WS_PB); S.Bt = (const char*)(ws + WS_WPP);
                pg8::EpiBf16Plain E{PJ, DMODEL}; pg8::gemm_phase<pg8::ProbPlain, pg8::EpiBf16Plain, true>(ldsl, S, E, wv); }
        } else {
            phase_topk(P, ldsl, bx, G, wv); __syncthreads();
            pg8::ProbPlain S; S.K = PLE; S.ord.init(MROWS / 256, DMODEL / 256, G, bx); S.A = (const char*)(ws + WS_PB); S.Bt = (const char*)(ws + WS_WPP);
            pg8::EpiBf16Plain E{PJ, DMODEL}; pg8::gemm_phase<pg8::ProbPlain, pg8::EpiBf16Plain, true>(ldsl, S, E, wv);
        }
    }
    GRID_BAR();
    if (PH(8)) { pg8::ProbExpertGatherQ S; S.K = 512; S.scale_a = 0x7F7F7F7F; S.scale_b = 0x7A7A7A7A; S.ord.init(VROWS / 256, 16, G, bx); S.A = (const char*)((unsigned char*)P.out + 64 * MiB); S.Bt = (const char*)(ws + WS_WGU); S.tok = (const int*)(ws + WS_TOK);
        pg8::EpiSwiGLU E{(unsigned char*)HB}; pg8::gemm_phase_q<pg8::ProbExpertGatherQ, pg8::EpiSwiGLU, true>(ldsl, S, E, wv); }
    GRID_BAR();
    if (PH(9)) { pg8::ProbExpertDownQ S; S.K = 1024; S.scale_a = 0x7B7B7B7B; S.scale_b = 0x79797979; S.ord.init(VROWS / 256, 4, G, bx); S.A = (const char*)HB; S.Bt = (const char*)(ws + WS_WD);
        pg8::EpiDown E{YE, (const float*)(ws + WS_GATE)}; pg8::gemm_phase_q<pg8::ProbExpertDownQ, pg8::EpiDown, true>(ldsl, S, E, wv); }
    GRID_BAR();
    if (PH(10)) { phase_combine_ln2(P, vcu, G, wv); }
    GRID_BAR();
    if (PH(11)) { pg8::ProbPlain S; S.K = 1024; S.ord.init(MROWS / 256, DMODEL / 256, G, bx); S.A = (const char*)R3; S.Bt = (const char*)(ws + WS_WPG);
        pg8::EpiPLE E{R3, PJ, (bf16_t*)(ws + WS_RH + 64 * MiB)}; pg8::gemm_phase<pg8::ProbPlain, pg8::EpiPLE, true>(ldsl, S, E, wv); }
    GRID_BAR();
    if (PH(12)) { phase_ln3(P, vcu, G, wv); }
#undef PH
}

extern "C" void kernel_launch(void* const* d_in, const int* in_sizes, int n_in, void* d_out, int out_size, void* d_ws, size_t ws_size, hipStream_t stream) {
    static int grid = 0;
    if (grid == 0) {
        if (n_in != 24 || out_size != MROWS * DMODEL || ws_size < WS_END) { fprintf(stderr, "kernel_launch: unexpected shapes (n_in %d, out %d, ws %zu < %zu); nothing launched\n", n_in, out_size, ws_size, (size_t)WS_END); grid = -1; return; }
        int dev = 0, cus = 0, per_cu = 0;
        hipGetDevice(&dev); hipDeviceGetAttribute(&cus, hipDeviceAttributeMultiprocessorCount, dev);
        hipFuncSetAttribute((const void*)fwd_megakernel, hipFuncAttributeMaxDynamicSharedMemorySize, LDS_BYTES);
        hipOccupancyMaxActiveBlocksPerMultiprocessor(&per_cu, (const void*)fwd_megakernel, NWAVES * 64, LDS_BYTES);
        (void)hipGetLastError();
        if (per_cu < 1) { fprintf(stderr, "kernel_launch: occupancy query reports %d blocks per CU\n", per_cu); grid = -1; return; }
        grid = cus;
    }
    if (grid < 0) return;
    if (hipMemsetAsync(d_ws, 0, 16384, stream) != hipSuccess) { fprintf(stderr, "kernel_launch: memset of the barrier words failed\n"); return; }
    Params p{};
    const float** f = (const float**)&p;
    for (int i = 0; i < 24; ++i) f[i] = (const float*)d_in[i];
    p.out = (float*)d_out; p.ws = (unsigned char*)d_ws;
    void* args[] = {&p};
    hipError_t e = hipLaunchCooperativeKernel((const void*)fwd_megakernel, dim3(grid), dim3(NWAVES * 64), args, LDS_BYTES, stream);
    if (e != hipSuccess) fprintf(stderr, "kernel_launch: cooperative launch failed: %s (grid %d)\n", hipGetErrorString(e), grid);
}
```

```cpp
#include <hip/hip_runtime.h>
#include <hip/hip_cooperative_groups.h>
#include <hip/hip_bf16.h>
#include <cstdio>
#include <cstdint>
#include <cmath>
namespace cg = cooperative_groups;

#define LAS __attribute__((address_space(3)))
typedef unsigned short bf16_t;
typedef short bf16x8 __attribute__((ext_vector_type(8)));
typedef float f32x4 __attribute__((ext_vector_type(4)));
typedef float f32x2 __attribute__((ext_vector_type(2)));
typedef unsigned u32x4 __attribute__((ext_vector_type(4)));
typedef unsigned u32x2 __attribute__((ext_vector_type(2)));
typedef __bf16 bf16x2_t __attribute__((ext_vector_type(2)));
typedef int v8i32 __attribute__((ext_vector_type(8)));

constexpr int BATCH = 4, SEQ = 8192, DMODEL = 1024, MROWS = BATCH * SEQ;
constexpr int INW = 2304, NEXP = 16, CAP = 1024, DEXP = 2048, PLE = 256;
constexpr int HP = DEXP + 128, WDP = DEXP + 128;
constexpr int VROWS = BATCH * NEXP * CAP;
constexpr float ALPHA = 1.189207115002721f, LN_EPS = 1e-5f, QK_EPS = 1e-6f;
constexpr float LOG2E = 1.4426950408889634f, C2 = 0.125f * LOG2E;
constexpr float LAM_INIT = 0.2f;
constexpr int COL_QA = 0, COL_KA = 512, COL_VA = 640, COL_QB = 768, COL_KB = 1280, COL_VB = 1792;

constexpr size_t MiB = 1u << 20;
constexpr size_t WS_AFF = 1 * MiB, WS_SLOT = 3 * MiB, WS_TOK = 5 * MiB, WS_GATE = 5 * MiB + 512 * 1024;
constexpr size_t WS_WIN = 8 * MiB, WS_WO = 13 * MiB, WS_WPG = 15 * MiB, WS_WPP = 17 * MiB;
constexpr size_t WS_WGU = 18 * MiB;
constexpr size_t WS_WD = 146 * MiB;
constexpr size_t WS_RH = 210 * MiB;
constexpr size_t WS_R3 = 466 * MiB;
constexpr size_t WS_PB = 530 * MiB;
constexpr size_t WS_END = 546 * MiB;

constexpr size_t OUT_Q8 = 0, OUT_K8 = 16 * MiB, OUT_VT8 = 20 * MiB;
constexpr int LDS_BYTES = 147456;
constexpr int NWAVES = 8;

struct Params {
    const float *x, *p, *w_in, *w_out, *a_q_norm, *a_k_norm, *lq1, *lk1, *lq2, *lk2, *subln, *rel_bias, *ln1_g, *ln1_b, *w_router,
                *w_gate, *w_up, *w_down, *ln2_g, *ln2_b, *w_pg, *w_pp, *ln3_g, *ln3_b;
    float* out; unsigned char* ws;
};

__device__ __forceinline__ unsigned cvtpk(float lo, float hi) { f32x2 v = {lo, hi}; bf16x2_t b = __builtin_convertvector(v, bf16x2_t); return __builtin_bit_cast(unsigned, b); }
__device__ __forceinline__ float bf_lo(unsigned w) { return __uint_as_float(w << 16); }
__device__ __forceinline__ float bf_hi(unsigned w) { return __uint_as_float(w & 0xffff0000u); }
template <int O> __device__ __forceinline__ float swz_xor(float v) { return __int_as_float(__builtin_amdgcn_ds_swizzle(__float_as_int(v), (O << 10) | 0x1f)); }
template <int O> __device__ __forceinline__ unsigned swz_xor_u(unsigned v) { return (unsigned)__builtin_amdgcn_ds_swizzle((int)v, (O << 10) | 0x1f); }
__device__ __forceinline__ float wave_sum(float v) {
    v += swz_xor<1>(v); v += swz_xor<2>(v); v += swz_xor<4>(v); v += swz_xor<8>(v); v += swz_xor<16>(v);
    auto rr = __builtin_amdgcn_permlane32_swap(__float_as_uint(v), __float_as_uint(v), false, false);
    return __uint_as_float(rr[0]) + __uint_as_float(rr[1]);
}
__device__ __forceinline__ float wave_max(float v) {
    v = fmaxf(v, swz_xor<1>(v)); v = fmaxf(v, swz_xor<2>(v)); v = fmaxf(v, swz_xor<4>(v)); v = fmaxf(v, swz_xor<8>(v)); v = fmaxf(v, swz_xor<16>(v));
    auto rr = __builtin_amdgcn_permlane32_swap(__float_as_uint(v), __float_as_uint(v), false, false);
    return fmaxf(__uint_as_float(rr[0]), __uint_as_float(rr[1]));
}
__device__ __forceinline__ unsigned wave_sum_u(unsigned v) {
    v += swz_xor_u<1>(v); v += swz_xor_u<2>(v); v += swz_xor_u<4>(v); v += swz_xor_u<8>(v); v += swz_xor_u<16>(v);
    auto rr = __builtin_amdgcn_permlane32_swap(v, v, false, false);
    return rr[0] + rr[1];
}
__device__ __forceinline__ unsigned pk_fp8x4(float a, float b, float c, float d) { int p = __builtin_amdgcn_cvt_pk_fp8_f32(a, b, 0, false); p = __builtin_amdgcn_cvt_pk_fp8_f32(c, d, p, true); return (unsigned)p; }
#define LDS_WAIT() asm volatile("s_waitcnt lgkmcnt(0)" ::: "memory")
__device__ __forceinline__ int ltid(int wv) { int l; asm volatile("v_mbcnt_lo_u32_b32 %0, -1, 0\n\tv_mbcnt_hi_u32_b32 %0, -1, %0" : "=v"(l)); return (wv << 6) | l; }

namespace pg8 {
constexpr int BM = 256, BK = 64, HALF = 128, HTB = HALF * BK * 2, STAGE_BYTES = 8 * HTB, NXCD = 8, WGM = 8;
__host__ __device__ __forceinline__ int lds_byte(int r, int c) { const int st = (r >> 4) * 2 + (c >> 5), rr = r & 15, cc = c & 31, ob = rr * 64 + cc * 2; return st * 1024 + (ob ^ (((ob >> 9) & 1) << 5)); }
__host__ __device__ __forceinline__ void stage_rc(int b, int& R, int& C) { const int st = b / 1024, sb = b % 1024, swz = sb ^ (((sb >> 9) & 1) << 5); R = (st >> 1) * 16 + swz / 64; C = (st & 1) * 32 + (swz % 64) / 2; }
__host__ __device__ __forceinline__ int perm32(int rho) { const int n = rho >> 4, i = rho & 15; return 8 * (i >> 2) + 4 * n + (i & 3); }
struct Unit { int pm, pn; };
struct Order {
    int nM, nN, nwg, G, c, pn0;
    __device__ __forceinline__ void init(int nM_, int nN_, int G_, int c_, int pn0_ = 0) { nM = nM_; nN = nN_; nwg = nM * nN; G = G_; c = c_; pn0 = pn0_; }
    __device__ __forceinline__ bool next(int i, Unit& u) const {
        const long L = (long)i * G + c; if (L >= nwg) return false;
        int wgid = (int)L; { const int q = nwg / NXCD, r = nwg % NXCD, xcd = wgid % NXCD, off = wgid / NXCD; wgid = (xcd < r ? xcd * (q + 1) : r * (q + 1) + (xcd - r) * q) + off; }
        const int nig = WGM * nN, gid = wgid / nig, fm = gid * WGM, gsz = (nM - fm) < WGM ? (nM - fm) : WGM;
        u.pm = fm + ((wgid % nig) % gsz); u.pn = pn0 + (wgid % nig) / gsz; return true;
    }
};
template <class Prob, class Epi, bool ALIGN_EPI>
__device__ __forceinline__ void gemm_phase(LAS unsigned char* lds, const Prob& S, const Epi& E, int wv) {
    int tid_ = ltid(wv);
    const int tid = tid_, wid = __builtin_amdgcn_readfirstlane(tid >> 6), lane = tid & 63, wr = wid >> 2, wc = wid & 3, fr = lane & 15, fq = lane >> 4;
    const int K = S.K, nt = K / BK;
    int Rr[2], Cc[2]; unsigned voffB[2];
#pragma unroll
    for (int i = 0; i < 2; ++i) { int R, C; stage_rc(tid * 16 + i * 8192, R, C); Rr[i] = R; Cc[i] = C; const int Rb = Epi::PERM ? ((R & ~31) + perm32(R & 31)) : R; voffB[i] = (unsigned)(Rb * K + C) * 2u; }
    const size_t kstep = (size_t)(BK * 2);
    const size_t hstepB = (size_t)HALF * K * 2;
    const unsigned ldsw = (unsigned)wid * 1024u;
    const int aoff = lds_byte(wr * 64 + fr, fq * 8), boff = lds_byte(wc * 32 + fr, fq * 8);
#define PG8_SA(b, h) (((b) * 2 + (h)) * HTB)
#define PG8_SB(b, h) ((4 + (b) * 2 + (h)) * HTB)
#define PG8_STAGEB(bufoff, gbase, voff) do { _Pragma("unroll") for (int _i = 0; _i < 2; ++_i) \
        __builtin_amdgcn_global_load_lds((const unsigned*)((const char*)(gbase) + (voff)[_i]), (LAS unsigned*)(lds + (bufoff) + ldsw + _i * 8192), 16, 0, 0); } while (0)
#define PG8_STAGEA(bufoff, kb, OFFh) do { _Pragma("unroll") for (int _i = 0; _i < 2; ++_i) \
        __builtin_amdgcn_global_load_lds((const unsigned*)(Ab + (kb) + (OFFh)[_i]), (LAS unsigned*)(lds + (bufoff) + ldsw + _i * 8192), 16, 0, 0); } while (0)
#define PG8_LDA(dst, b, h) do { _Pragma("unroll") for (int m = 0; m < 4; ++m) _Pragma("unroll") for (int k = 0; k < 2; ++k) dst[m][k] = *(const LAS bf16x8*)(lds + PG8_SA(b, h) + aoff + m * 2048 + k * 1024); } while (0)
#define PG8_LDB(dst, b, h) do { _Pragma("unroll") for (int n = 0; n < 2; ++n) _Pragma("unroll") for (int k = 0; k < 2; ++k) dst[n][k] = *(const LAS bf16x8*)(lds + PG8_SB(b, h) + boff + n * 2048 + k * 1024); } while (0)
#define PG8_MMA(ai, bj, At, Bt) do { __builtin_amdgcn_s_setprio(1); _Pragma("unroll") for (int m = 0; m < 4; ++m) _Pragma("unroll") for (int n = 0; n < 2; ++n) _Pragma("unroll") for (int k = 0; k < 2; ++k) \
        acc[ai][bj][m][n] = __builtin_amdgcn_mfma_f32_16x16x32_bf16(Bt[n][k], At[m][k], acc[ai][bj][m][n], 0, 0, 0); __builtin_amdgcn_s_setprio(0); } while (0)
#define PG8_WAIT_V(n) asm volatile("s_waitcnt vmcnt(" #n ")" ::: "memory")
#define PG8_WAIT_L(n) asm volatile("s_waitcnt lgkmcnt(" #n ")" ::: "memory")
#define PG8_BAR __builtin_amdgcn_s_barrier()
#define PG8_SCHED __builtin_amdgcn_sched_barrier(0)
    Unit cur, nxt; int ui = 0;
    if (!S.ord.next(0, cur)) return;
    f32x4 acc[2][2][4][2];
#pragma unroll
    for (int a = 0; a < 2; ++a)
#pragma unroll
        for (int b = 0; b < 2; ++b)
#pragma unroll
            for (int m = 0; m < 4; ++m)
#pragma unroll
                for (int n = 0; n < 2; ++n) acc[a][b][m][n] = (f32x4){0.f, 0.f, 0.f, 0.f};
    bf16x8 At[4][2], B0[2][2], B1[2][2];
    unsigned curA[2][2], nxtA[2][2];
    S.a_off(cur, Rr, Cc, curA);
    const char* Ab = S.A;
    const char* cB = S.b_base(cur);
    PG8_STAGEB(PG8_SB(0, 0), cB, voffB); PG8_STAGEB(PG8_SB(0, 1), cB + hstepB, voffB); PG8_STAGEA(PG8_SA(0, 0), 0, curA[0]); PG8_STAGEA(PG8_SA(0, 1), 0, curA[1]);
    if (wr == 1) PG8_BAR;
    PG8_WAIT_V(2); PG8_BAR;
    PG8_STAGEB(PG8_SB(1, 0), cB + kstep, voffB); PG8_STAGEA(PG8_SA(1, 0), kstep, curA[0]); PG8_STAGEB(PG8_SB(1, 1), cB + hstepB + kstep, voffB);
    PG8_WAIT_V(6); PG8_BAR;
    for (;;) {
        const bool has_next = S.ord.next(ui + 1, nxt);
        if (has_next) S.a_off(nxt, Rr, Cc, nxtA);
        else {
#pragma unroll
            for (int h = 0; h < 2; ++h)
#pragma unroll
                for (int i = 0; i < 2; ++i) nxtA[h][i] = curA[h][i];
        }
        const char* nB = has_next ? S.b_base(nxt) : cB;
        for (int t = 0; t < nt; t += 2) {
            const bool last = (t == nt - 2);
            const size_t k1 = (size_t)(t + 1) * kstep;
            const size_t k2 = last ? 0 : (size_t)(t + 2) * kstep; const char* b2 = last ? nB : cB + (size_t)(t + 2) * kstep;
            const size_t k3 = k2 + kstep; const char* b3 = b2 + kstep;
            unsigned a2o[2][2];
#pragma unroll
            for (int h = 0; h < 2; ++h)
#pragma unroll
                for (int i = 0; i < 2; ++i) a2o[h][i] = last ? nxtA[h][i] : curA[h][i];
            PG8_LDB(B0, 0, 0); PG8_LDB(B1, 0, 1); PG8_SCHED; PG8_LDA(At, 0, 0); PG8_STAGEA(PG8_SA(1, 1), k1, curA[1]);
            PG8_WAIT_V(8); PG8_WAIT_L(0); PG8_BAR; PG8_MMA(0, 0, At, B0); PG8_MMA(0, 1, At, B1); PG8_BAR; PG8_SCHED;
            PG8_LDA(At, 0, 1); PG8_STAGEB(PG8_SB(0, 0), b2, voffB); PG8_STAGEB(PG8_SB(0, 1), b2 + hstepB, voffB); PG8_STAGEA(PG8_SA(0, 0), k2, a2o[0]);
            PG8_WAIT_V(8); PG8_WAIT_L(0); PG8_BAR; PG8_MMA(1, 0, At, B0); PG8_MMA(1, 1, At, B1); PG8_BAR; PG8_SCHED;
            PG8_LDB(B0, 1, 0); PG8_LDB(B1, 1, 1); PG8_SCHED; PG8_LDA(At, 1, 0); PG8_STAGEA(PG8_SA(0, 1), k2, a2o[1]);
            PG8_WAIT_V(8); PG8_WAIT_L(0); PG8_BAR; PG8_MMA(0, 0, At, B0); PG8_MMA(0, 1, At, B1); PG8_BAR; PG8_SCHED;
            PG8_LDA(At, 1, 1); PG8_STAGEB(PG8_SB(1, 0), b3, voffB); PG8_STAGEB(PG8_SB(1, 1), b3 + hstepB, voffB); PG8_STAGEA(PG8_SA(1, 0), k3, a2o[0]);
            PG8_WAIT_V(8); PG8_WAIT_L(0); PG8_BAR; PG8_MMA(1, 0, At, B0); PG8_MMA(1, 1, At, B1); PG8_BAR; PG8_SCHED;
        }
        if constexpr (ALIGN_EPI) { if (wr == 0) PG8_BAR; }
        E(acc, cur, wr, wc, fr, fq);
        if (!has_next) break;
#pragma unroll
        for (int a = 0; a < 2; ++a)
#pragma unroll
            for (int b = 0; b < 2; ++b)
#pragma unroll
                for (int m = 0; m < 4; ++m)
#pragma unroll
                    for (int n = 0; n < 2; ++n) acc[a][b][m][n] = (f32x4){0.f, 0.f, 0.f, 0.f};
        cur = nxt; cB = nB; ++ui;
#pragma unroll
        for (int h = 0; h < 2; ++h)
#pragma unroll
            for (int i = 0; i < 2; ++i) curA[h][i] = nxtA[h][i];
        if constexpr (ALIGN_EPI) { if (wr == 1) PG8_BAR; }
    }
    PG8_WAIT_V(0);
    if constexpr (!ALIGN_EPI) { if (wr == 0) PG8_BAR; }
    PG8_BAR;
#undef PG8_SA
#undef PG8_SB
#undef PG8_STAGEA
#undef PG8_STAGEB
#undef PG8_LDA
#undef PG8_LDB
#undef PG8_MMA
#undef PG8_WAIT_V
#undef PG8_WAIT_L
#undef PG8_BAR
#undef PG8_SCHED
}
template <class Prob, class Epi, bool ALIGN_EPI>
__device__ __forceinline__ void gemm_phase_q(LAS unsigned char* lds, const Prob& S, const Epi& E, int wv) {
    int tid_ = ltid(wv);
    const int tid = tid_, wid = __builtin_amdgcn_readfirstlane(tid >> 6), lane = tid & 63, wr = wid >> 2, wc = wid & 3, fr = lane & 15, fq = lane >> 4;
    const int K = S.K, nt = K / BK;
    int Rr[2], Cc[2]; unsigned voffB[2];
    const int KPB = S.bpitch();
#pragma unroll
    for (int i = 0; i < 2; ++i) { int R, C; stage_rc(tid * 16 + i * 8192, R, C); Rr[i] = R; Cc[i] = C; const int Rb = Epi::PERM ? ((R & ~31) + perm32(R & 31)) : R; voffB[i] = (unsigned)(Rb * KPB + C) * 2u; }
    const size_t kstep = (size_t)(BK * 2);
    const size_t hstepB = (size_t)HALF * KPB * 2;
    const unsigned ldsw = (unsigned)wid * 1024u;
    const int aq0 = lds_byte(wr * 64 + fr, fq * 8), aq1 = aq0 + 1024, bq0 = lds_byte(wc * 32 + fr, fq * 8), bq1 = bq0 + 1024;
    int sc_w = S.scale_b, sc_a = S.scale_a; asm volatile("" : "+v"(sc_w), "+v"(sc_a));
#define PG8_SA(b, h) (((b) * 2 + (h)) * HTB)
#define PG8_SB(b, h) ((4 + (b) * 2 + (h)) * HTB)
#define PG8_STAGEB(bufoff, gbase, voff) do { _Pragma("unroll") for (int _i = 0; _i < 2; ++_i) \
        __builtin_amdgcn_global_load_lds((const unsigned*)((const char*)(gbase) + (voff)[_i]), (LAS unsigned*)(lds + (bufoff) + ldsw + _i * 8192), 16, 0, 0); } while (0)
#define PG8_STAGEA(bufoff, kb, OFFh) do { _Pragma("unroll") for (int _i = 0; _i < 2; ++_i) \
        __builtin_amdgcn_global_load_lds((const unsigned*)(Ab + (kb) + (OFFh)[_i]), (LAS unsigned*)(lds + (bufoff) + ldsw + _i * 8192), 16, 0, 0); } while (0)
#define PG8_LDA(dst, b, h) do { _Pragma("unroll") for (int m = 0; m < 4; ++m) { const u32x4 l_ = *(const LAS u32x4*)(lds + PG8_SA(b, h) + aq0 + m * 2048), h_ = *(const LAS u32x4*)(lds + PG8_SA(b, h) + aq1 + m * 2048); \
        dst[m] = (v8i32){(int)l_.x, (int)l_.y, (int)l_.z, (int)l_.w, (int)h_.x, (int)h_.y, (int)h_.z, (int)h_.w}; } } while (0)
#define PG8_LDB(dst, b, h) do { _Pragma("unroll") for (int n = 0; n < 2; ++n) { const u32x4 l_ = *(const LAS u32x4*)(lds + PG8_SB(b, h) + bq0 + n * 2048), h_ = *(const LAS u32x4*)(lds + PG8_SB(b, h) + bq1 + n * 2048); \
        dst[n] = (v8i32){(int)l_.x, (int)l_.y, (int)l_.z, (int)l_.w, (int)h_.x, (int)h_.y, (int)h_.z, (int)h_.w}; } } while (0)
#define PG8_MMA(ai, bj, At, Bt) do { __builtin_amdgcn_s_setprio(1); _Pragma("unroll") for (int m = 0; m < 4; ++m) _Pragma("unroll") for (int n = 0; n < 2; ++n) \
        asm volatile("v_mfma_scale_f32_16x16x128_f8f6f4 %0, %1, %2, %0, %3, %4 op_sel_hi:[0,0,0]" : "+v"(acc[ai][bj][m][n]) : "v"(Bt[n]), "v"(At[m]), "v"(sc_w), "v"(sc_a)); __builtin_amdgcn_s_setprio(0); } while (0)
#define PG8_WAIT_V(n) asm volatile("s_waitcnt vmcnt(" #n ")" ::: "memory")
#define PG8_WAIT_L(n) asm volatile("s_waitcnt lgkmcnt(" #n ")" ::: "memory")
#define PG8_BAR __builtin_amdgcn_s_barrier()
#define PG8_SCHED __builtin_amdgcn_sched_barrier(0)
    Unit cur, nxt; int ui = 0;
    if (!S.ord.next(0, cur)) return;
    f32x4 acc[2][2][4][2];
#pragma unroll
    for (int a = 0; a < 2; ++a)
#pragma unroll
        for (int b = 0; b < 2; ++b)
#pragma unroll
            for (int m = 0; m < 4; ++m)
#pragma unroll
                for (int n = 0; n < 2; ++n) acc[a][b][m][n] = (f32x4){0.f, 0.f, 0.f, 0.f};
    v8i32 At[4], B0[2], B1[2];
    unsigned curA[2][2], nxtA[2][2];
    S.a_off(cur, Rr, Cc, curA);
    const char* Ab = S.A;
    const char* cB = S.b_base(cur);
    PG8_STAGEB(PG8_SB(0, 0), cB, voffB); PG8_STAGEB(PG8_SB(0, 1), cB + hstepB, voffB); PG8_STAGEA(PG8_SA(0, 0), 0, curA[0]); PG8_STAGEA(PG8_SA(0, 1), 0, curA[1]);
    if (wr == 1) PG8_BAR;
    PG8_WAIT_V(2); PG8_BAR;
    PG8_STAGEB(PG8_SB(1, 0), cB + kstep, voffB); PG8_STAGEA(PG8_SA(1, 0), kstep, curA[0]); PG8_STAGEB(PG8_SB(1, 1), cB + hstepB + kstep, voffB);
    PG8_WAIT_V(6); PG8_BAR;
    for (;;) {
        const bool has_next = S.ord.next(ui + 1, nxt);
        if (has_next) S.a_off(nxt, Rr, Cc, nxtA);
        else {
#pragma unroll
            for (int h = 0; h < 2; ++h)
#pragma unroll
                for (int i = 0; i < 2; ++i) nxtA[h][i] = curA[h][i];
        }
        const char* nB = has_next ? S.b_base(nxt) : cB;
        for (int t = 0; t < nt; t += 2) {
            const bool last = (t == nt - 2);
            const size_t k1 = (size_t)(t + 1) * kstep;
            const size_t k2 = last ? 0 : (size_t)(t + 2) * kstep; const char* b2 = last ? nB : cB + (size_t)(t + 2) * kstep;
            const size_t k3 = k2 + kstep; const char* b3 = b2 + kstep;
            unsigned a2o[2][2];
#pragma unroll
            for (int h = 0; h < 2; ++h)
#pragma unroll
                for (int i = 0; i < 2; ++i) a2o[h][i] = last ? nxtA[h][i] : curA[h][i];
            PG8_LDB(B0, 0, 0); PG8_LDB(B1, 0, 1); PG8_SCHED; PG8_LDA(At, 0, 0); PG8_STAGEA(PG8_SA(1, 1), k1, curA[1]);
            PG8_WAIT_V(8); PG8_WAIT_L(0); PG8_BAR; PG8_MMA(0, 0, At, B0); PG8_MMA(0, 1, At, B1); PG8_BAR; PG8_SCHED;
            PG8_LDA(At, 0, 1); PG8_STAGEB(PG8_SB(0, 0), b2, voffB); PG8_STAGEB(PG8_SB(0, 1), b2 + hstepB, voffB); PG8_STAGEA(PG8_SA(0, 0), k2, a2o[0]);
            PG8_WAIT_V(8); PG8_WAIT_L(0); PG8_BAR; PG8_MMA(1, 0, At, B0); PG8_MMA(1, 1, At, B1); PG8_BAR; PG8_SCHED;
            PG8_LDB(B0, 1, 0); PG8_LDB(B1, 1, 1); PG8_SCHED; PG8_LDA(At, 1, 0); PG8_STAGEA(PG8_SA(0, 1), k2, a2o[1]);
            PG8_WAIT_V(8); PG8_WAIT_L(0); PG8_BAR; PG8_MMA(0, 0, At, B0); PG8_MMA(0, 1, At, B1); PG8_BAR; PG8_SCHED;
            PG8_LDA(At, 1, 1); PG8_STAGEB(PG8_SB(1, 0), b3, voffB); PG8_STAGEB(PG8_SB(1, 1), b3 + hstepB, voffB); PG8_STAGEA(PG8_SA(1, 0), k3, a2o[0]);
            PG8_WAIT_V(8); PG8_WAIT_L(0); PG8_BAR; PG8_MMA(1, 0, At, B0); PG8_MMA(1, 1, At, B1); PG8_BAR; PG8_SCHED;
        }
        if constexpr (ALIGN_EPI) { if (wr == 0) PG8_BAR; }
#pragma unroll
        for (int a = 0; a < 2; ++a)
#pragma unroll
            for (int b = 0; b < 2; ++b) asm volatile("s_nop 15\n\ts_nop 15" : "+v"(acc[a][b][0][0]), "+v"(acc[a][b][0][1]), "+v"(acc[a][b][1][0]), "+v"(acc[a][b][1][1]), "+v"(acc[a][b][2][0]), "+v"(acc[a][b][2][1]), "+v"(acc[a][b][3][0]), "+v"(acc[a][b][3][1]));
        E(acc, cur, wr, wc, fr, fq);
        if (!has_next) break;
#pragma unroll
        for (int a = 0; a < 2; ++a)
#pragma unroll
            for (int b = 0; b < 2; ++b)
#pragma unroll
                for (int m = 0; m < 4; ++m)
#pragma unroll
                    for (int n = 0; n < 2; ++n) acc[a][b][m][n] = (f32x4){0.f, 0.f, 0.f, 0.f};
        cur = nxt; cB = nB; ++ui;
#pragma unroll
        for (int h = 0; h < 2; ++h)
#pragma unroll
            for (int i = 0; i < 2; ++i) curA[h][i] = nxtA[h][i];
        if constexpr (ALIGN_EPI) { if (wr == 1) PG8_BAR; }
    }
    PG8_WAIT_V(0);
    if constexpr (!ALIGN_EPI) { if (wr == 0) PG8_BAR; }
    PG8_BAR;
#undef PG8_SA
#undef PG8_SB
#undef PG8_STAGEA
#undef PG8_STAGEB
#undef PG8_LDA
#undef PG8_LDB
#undef PG8_MMA
#undef PG8_WAIT_V
#undef PG8_WAIT_L
#undef PG8_BAR
#undef PG8_SCHED
}
struct ProbPlain {
    int K; Order ord; const char* A; const char* Bt;
    __device__ __forceinline__ const char* b_base(const Unit& u) const { return Bt + (size_t)u.pn * 256 * K * 2; }
    __device__ __forceinline__ void a_off(const Unit& u, const int (&R)[2], const int (&C)[2], unsigned (&off)[2][2]) const {
#pragma unroll
        for (int h = 0; h < 2; ++h)
#pragma unroll
            for (int i = 0; i < 2; ++i) off[h][i] = (unsigned)((u.pm * 256 + h * 128 + R[i]) * K + C[i]) * 2u;
    }
};
struct ProbExpertGather {
    int K; Order ord; const char* A; const char* Bt; const int* tok;
    __device__ __forceinline__ const char* b_base(const Unit& u) const { return Bt + ((size_t)(u.pm >> 4) * 4096 + (size_t)u.pn * 256) * 1024 * 2; }
    __device__ __forceinline__ void a_off(const Unit& u, const int (&R)[2], const int (&C)[2], unsigned (&off)[2][2]) const {
#pragma unroll
        for (int h = 0; h < 2; ++h)
#pragma unroll
            for (int i = 0; i < 2; ++i) { const int row = tok[u.pm * 256 + h * 128 + R[i]]; off[h][i] = (unsigned)(row * 1024 + C[i]) * 2u; }
    }
};
struct ProbExpertDown {
    int K; Order ord; const char* A; const char* Bt;
    __device__ __forceinline__ const char* b_base(const Unit& u) const { return Bt + ((size_t)(u.pm >> 4) * 1024 + (size_t)u.pn * 256) * 2048 * 2; }
    __device__ __forceinline__ void a_off(const Unit& u, const int (&R)[2], const int (&C)[2], unsigned (&off)[2][2]) const {
#pragma unroll
        for (int h = 0; h < 2; ++h)
#pragma unroll
            for (int i = 0; i < 2; ++i) off[h][i] = (unsigned)((u.pm * 256 + h * 128 + R[i]) * 2048 + C[i]) * 2u;
    }
};
struct ProbExpertGatherQ {
    int K; int scale_a, scale_b; Order ord; const char* A; const char* Bt; const int* tok;
    __device__ __forceinline__ int bpitch() const { return K; }
    __device__ __forceinline__ const char* b_base(const Unit& u) const { return Bt + ((size_t)(u.pm >> 4) * 4096 + (size_t)u.pn * 256) * 1024; }
    __device__ __forceinline__ void a_off(const Unit& u, const int (&R)[2], const int (&C)[2], unsigned (&off)[2][2]) const {
#pragma unroll
        for (int h = 0; h < 2; ++h)
#pragma unroll
            for (int i = 0; i < 2; ++i) { const int row = tok[u.pm * 256 + h * 128 + R[i]]; off[h][i] = (unsigned)(row * 512 + C[i]) * 2u; }
    }
};
struct ProbExpertDownQ {
    int K; int scale_a, scale_b; Order ord; const char* A; const char* Bt;
    __device__ __forceinline__ int bpitch() const { return WDP / 2; }
    __device__ __forceinline__ const char* b_base(const Unit& u) const { return Bt + ((size_t)(u.pm >> 4) * 1024 + (size_t)u.pn * 256) * WDP; }
    __device__ __forceinline__ void a_off(const Unit& u, const int (&R)[2], const int (&C)[2], unsigned (&off)[2][2]) const {
#pragma unroll
        for (int h = 0; h < 2; ++h)
#pragma unroll
            for (int i = 0; i < 2; ++i) off[h][i] = (unsigned)((u.pm * 256 + h * 128 + R[i]) * (HP / 2) + C[i]) * 2u;
    }
};
struct EpiQKV {
    static constexpr bool PERM = true; bf16_t* O; unsigned* bnd;
    __device__ __forceinline__ void operator()(const f32x4 (&acc)[2][2][4][2], const Unit& u, int wr, int wc, int fr, int fq) const {
        const int row0 = u.pm * 256 + wr * 64 + fr, col0 = u.pn * 256 + wc * 32 + 8 * fq;
        const float sc = (u.pn == 3 || u.pn == 4) ? C2 : 1.f;
        const bool track = (u.pn >= 3 && u.pn <= 6);
        float mx = 0.f;
#pragma unroll
        for (int ai = 0; ai < 2; ++ai)
#pragma unroll
            for (int m = 0; m < 4; ++m) { bf16_t* rowp = O + (size_t)(row0 + ai * 128 + m * 16) * INW + col0;
#pragma unroll
                for (int bj = 0; bj < 2; ++bj) { const f32x4 v0 = acc[ai][bj][m][0] * sc, v1 = acc[ai][bj][m][1] * sc;
                    u32x4 w; w.x = cvtpk(v0[0], v0[1]); w.y = cvtpk(v0[2], v0[3]); w.z = cvtpk(v1[0], v1[1]); w.w = cvtpk(v1[2], v1[3]);
                    *(u32x4*)(rowp + bj * 128) = w;
                    if (track) { float ss = (v0[0] * v0[0] + v0[1] * v0[1]) + (v0[2] * v0[2] + v0[3] * v0[3]) + (v1[0] * v1[0] + v1[1] * v1[1]) + (v1[2] * v1[2] + v1[3] * v1[3]);
                        ss += swz_xor<16>(ss); { auto rr = __builtin_amdgcn_permlane32_swap(__float_as_uint(ss), __float_as_uint(ss), false, false); ss = __uint_as_float(rr[0]) + __uint_as_float(rr[1]); }
                        mx = fmaxf(mx, ss); } } }
        if (track) { mx = wave_max(mx) * 1.02f;
            if (fr == 0 && fq == 0) atomicMax(bnd + (u.pn >= 5 ? 64 : 0), __float_as_uint(mx)); }
    }
};
struct EpiBf16Plain {
    static constexpr bool PERM = true; bf16_t* O; int ldc;
    __device__ __forceinline__ void operator()(const f32x4 (&acc)[2][2][4][2], const Unit& u, int wr, int wc, int fr, int fq) const {
        const int row0 = u.pm * 256 + wr * 64 + fr, col0 = u.pn * 256 + wc * 32 + 8 * fq;
#pragma unroll
        for (int ai = 0; ai < 2; ++ai)
#pragma unroll
            for (int m = 0; m < 4; ++m) { bf16_t* rowp = O + (size_t)(row0 + ai * 128 + m * 16) * ldc + col0;
#pragma unroll
                for (int bj = 0; bj < 2; ++bj) { const f32x4 v0 = acc[ai][bj][m][0], v1 = acc[ai][bj][m][1];
                    u32x4 w; w.x = cvtpk(v0[0], v0[1]); w.y = cvtpk(v0[2], v0[3]); w.z = cvtpk(v1[0], v1[1]); w.w = cvtpk(v1[2], v1[3]);
                    *(u32x4*)(rowp + bj * 128) = w; } }
    }
};
struct EpiResF32 {
    static constexpr bool PERM = false; const bf16_t* xb; float* out;
    __device__ __forceinline__ void operator()(const f32x4 (&acc)[2][2][4][2], const Unit& u, int wr, int wc, int fr, int fq) const {
        const int col0 = u.pn * 256 + wc * 32 + 4 * fq;
#pragma unroll
        for (int ai = 0; ai < 2; ++ai)
#pragma unroll
            for (int m = 0; m < 4; ++m) { const size_t off = (size_t)(u.pm * 256 + ai * 128 + wr * 64 + m * 16 + fr) * DMODEL + col0;
#pragma unroll
                for (int bj = 0; bj < 2; ++bj)
#pragma unroll
                    for (int n = 0; n < 2; ++n) { const u32x2 w = *(const u32x2*)(xb + off + bj * 128 + n * 16); const f32x4 bs = {bf_lo(w.x), bf_hi(w.x), bf_lo(w.y), bf_hi(w.y)};
                        *(f32x4*)(out + off + bj * 128 + n * 16) = bs * ALPHA + acc[ai][bj][m][n]; } }
    }
};
__device__ __forceinline__ float silu_mul(float g, float u) { return g * __builtin_amdgcn_rcpf(1.f + __builtin_amdgcn_exp2f(-g * LOG2E)) * u; }
struct EpiSwiGLU {
    static constexpr bool PERM = true; unsigned char* H;
    __device__ __forceinline__ void operator()(const f32x4 (&acc)[2][2][4][2], const Unit& u, int wr, int wc, int fr, int fq) const {
        const int row0 = u.pm * 256 + wr * 64 + fr, col0 = u.pn * 128 + wc * 32 + 8 * fq;
#pragma unroll
        for (int ai = 0; ai < 2; ++ai)
#pragma unroll
            for (int m = 0; m < 4; ++m) { unsigned char* rowp = H + (size_t)(row0 + ai * 128 + m * 16) * HP + col0;
                const f32x4 g0 = acc[ai][0][m][0], g1 = acc[ai][0][m][1], u0 = acc[ai][1][m][0], u1 = acc[ai][1][m][1];
                u32x2 w; w.x = pk_fp8x4(silu_mul(g0[0], u0[0]) * 16.f, silu_mul(g0[1], u0[1]) * 16.f, silu_mul(g0[2], u0[2]) * 16.f, silu_mul(g0[3], u0[3]) * 16.f);
                w.y = pk_fp8x4(silu_mul(g1[0], u1[0]) * 16.f, silu_mul(g1[1], u1[1]) * 16.f, silu_mul(g1[2], u1[2]) * 16.f, silu_mul(g1[3], u1[3]) * 16.f);
                __builtin_nontemporal_store(w, (u32x2*)rowp); }
    }
};
struct EpiDown {
    static constexpr bool PERM = true; bf16_t* O; const float* gate;
    __device__ __forceinline__ void operator()(const f32x4 (&acc)[2][2][4][2], const Unit& u, int wr, int wc, int fr, int fq) const {
        const int row0 = u.pm * 256 + wr * 64 + fr, col0 = u.pn * 256 + wc * 32 + 8 * fq;
#pragma unroll
        for (int ai = 0; ai < 2; ++ai)
#pragma unroll
            for (int m = 0; m < 4; ++m) { const int r = row0 + ai * 128 + m * 16; const float g = gate[r]; bf16_t* rowp = O + (size_t)r * DMODEL + col0;
#pragma unroll
                for (int bj = 0; bj < 2; ++bj) { const f32x4 v0 = acc[ai][bj][m][0] * g, v1 = acc[ai][bj][m][1] * g;
                    u32x4 w; w.x = cvtpk(v0[0], v0[1]); w.y = cvtpk(v0[2], v0[3]); w.z = cvtpk(v1[0], v1[1]); w.w = cvtpk(v1[2], v1[3]);
                    __builtin_nontemporal_store(w, (u32x4*)(rowp + bj * 128)); } }
    }
};
__device__ __forceinline__ float sigm(float a) { return __builtin_amdgcn_rcpf(1.f + __builtin_amdgcn_exp2f(-a * LOG2E)); }
struct EpiPLE {
    static constexpr bool PERM = true; const bf16_t* x2b; const bf16_t* pj; bf16_t* y3;
    __device__ __forceinline__ void operator()(const f32x4 (&acc)[2][2][4][2], const Unit& u, int wr, int wc, int fr, int fq) const {
        const int row0 = u.pm * 256 + wr * 64 + fr, col0 = u.pn * 256 + wc * 32 + 8 * fq;
#pragma unroll
        for (int ai = 0; ai < 2; ++ai)
#pragma unroll
            for (int m = 0; m < 4; ++m) { const size_t off = (size_t)(row0 + ai * 128 + m * 16) * DMODEL + col0;
#pragma unroll
                for (int bj = 0; bj < 2; ++bj) { const u32x4 xw = *(const u32x4*)(x2b + off + bj * 128), pw = *(const u32x4*)(pj + off + bj * 128);
                    const f32x4 a0 = acc[ai][bj][m][0], a1 = acc[ai][bj][m][1]; u32x4 w;
                    w.x = cvtpk(bf_lo(xw.x) * ALPHA + sigm(a0[0]) * bf_lo(pw.x), bf_hi(xw.x) * ALPHA + sigm(a0[1]) * bf_hi(pw.x));
                    w.y = cvtpk(bf_lo(xw.y) * ALPHA + sigm(a0[2]) * bf_lo(pw.y), bf_hi(xw.y) * ALPHA + sigm(a0[3]) * bf_hi(pw.y));
                    w.z = cvtpk(bf_lo(xw.z) * ALPHA + sigm(a1[0]) * bf_lo(pw.z), bf_hi(xw.z) * ALPHA + sigm(a1[1]) * bf_hi(pw.z));
                    w.w = cvtpk(bf_lo(xw.w) * ALPHA + sigm(a1[2]) * bf_lo(pw.w), bf_hi(xw.w) * ALPHA + sigm(a1[3]) * bf_hi(pw.w));
                    *(u32x4*)(y3 + off + bj * 128) = w; } }
    }
};
}

namespace attn_body {
using bf16 = __hip_bfloat16;
using s16x4 = __attribute__((ext_vector_type(4))) short;
using f32x16 = __attribute__((ext_vector_type(16))) float;
constexpr int D = 64, PITCH = INW, OPITCH = DMODEL;
constexpr int NW = 8, QBLK = 32, QB = QBLK * NW, KVBLK = 64, NT = SEQ / KVBLK;
__device__ __forceinline__ int crow(int r, int hi) { return (r & 3) + 8 * (r >> 2) + 4 * hi; }
#define SBAR() __builtin_amdgcn_sched_barrier(0)
constexpr int NSLOT = 3, SLOTB = 8192;
constexpr int LDS_K = 0, LDS_V = NSLOT * SLOTB, LDS_WS = 2 * NSLOT * SLOTB, LDS_OST = LDS_WS + NW * 64 * 4, ATT_LDS_BYTES = LDS_OST + NW * 4096;
constexpr int LDS_STASH = 75776;
constexpr int LDS_TAB = 141312;
__device__ __forceinline__ void glds16(const void* gsrc, unsigned lds_dst) { unsigned keep;
    asm volatile("s_mov_b32 %0, m0\n\ts_mov_b32 m0, %2\n\ts_nop 0\n\tglobal_load_lds_dwordx4 %1, off\n\ts_mov_b32 m0, %0" : "=&s"(keep) : "v"(gsrc), "s"(lds_dst) : "memory"); }
__device__ __forceinline__ float max3f(float a, float b, float c) { float r; asm("v_max3_f32 %0, %1, %2, %3" : "=v"(r) : "v"(a), "v"(b), "v"(c)); return r; }
__device__ __forceinline__ float max2f(float a, float b) { float r; asm("v_max_f32_e32 %0, %1, %2" : "=v"(r) : "v"(a), "v"(b)); return r; }
__device__ __forceinline__ float fadd_s(float a, float b) { float r; asm("v_add_f32_e32 %0, %1, %2" : "=v"(r) : "v"(a), "v"(b)); return r; }
__device__ __forceinline__ float fsub_s(float a, float b) { float r; asm("v_sub_f32_e32 %0, %1, %2" : "=v"(r) : "v"(a), "v"(b)); return r; }
#define WAIT_BAR(N) asm volatile("s_waitcnt vmcnt(" #N ") lgkmcnt(0)\n\ts_barrier" ::: "memory")
__device__ __forceinline__ void qkt(f32x16& p0, f32x16& p1, const char* Kslot, const bf16x8* qr, const f32x16& negm, int r32, int hi) {
    const char* kb = Kslot + hi * 1024 + r32 * 16;
#pragma unroll
    for (int d0 = 0; d0 < 4; ++d0) {
        const bf16x8 b0 = *reinterpret_cast<const bf16x8*>(kb + d0 * 2048);
        const bf16x8 b1 = *reinterpret_cast<const bf16x8*>(kb + d0 * 2048 + 512);
        if (d0 == 0) { p0 = __builtin_amdgcn_mfma_f32_32x32x16_bf16(b0, qr[0], negm, 0, 0, 0); p1 = __builtin_amdgcn_mfma_f32_32x32x16_bf16(b1, qr[0], negm, 0, 0, 0); }
        else { p0 = __builtin_amdgcn_mfma_f32_32x32x16_bf16(b0, qr[d0], p0, 0, 0, 0); p1 = __builtin_amdgcn_mfma_f32_32x32x16_bf16(b1, qr[d0], p1, 0, 0, 0); } }
}
typedef __attribute__((address_space(3))) const char* lds_cptr;
typedef short v4i16_t __attribute__((ext_vector_type(4)));
__device__ __forceinline__ void kload8(bf16x8* kf, lds_cptr kp) {
    kf[0] = *(const LAS bf16x8*)(kp);        kf[1] = *(const LAS bf16x8*)(kp + 512);
    kf[2] = *(const LAS bf16x8*)(kp + 2048); kf[3] = *(const LAS bf16x8*)(kp + 2560);
    kf[4] = *(const LAS bf16x8*)(kp + 4096); kf[5] = *(const LAS bf16x8*)(kp + 4608);
    kf[6] = *(const LAS bf16x8*)(kp + 6144); kf[7] = *(const LAS bf16x8*)(kp + 6656);
}
__device__ __forceinline__ void kload2(bf16x8* kf, lds_cptr kp, int j) { kf[2 * j] = *(const LAS bf16x8*)(kp + j * 2048); kf[2 * j + 1] = *(const LAS bf16x8*)(kp + j * 2048 + 512); }
__device__ __forceinline__ s16x4 vtr(lds_cptr p) { return __builtin_bit_cast(s16x4, __builtin_amdgcn_ds_read_tr16_b64_v4i16((LAS v4i16_t*)p)); }
__device__ __forceinline__ float rowmax(const f32x16& p0, const f32x16& p1) {
    float a = max3f(p0[0], p0[1], p1[0]), b = max3f(p0[2], p0[3], p1[1]); a = max3f(a, p1[2], p1[3]);
#pragma unroll
    for (int r = 4; r < 16; r += 4) { a = max3f(a, p0[r], p0[r + 1]); b = max3f(b, p0[r + 2], p0[r + 3]); a = max3f(a, p1[r], p1[r + 1]); b = max3f(b, p1[r + 2], p1[r + 3]); }
    const float m = max2f(a, b);
    auto rr = __builtin_amdgcn_permlane32_swap(__float_as_uint(m), __float_as_uint(m), false, false);
    return max2f(__uint_as_float(rr[0]), __uint_as_float(rr[1]));
}
__device__ __forceinline__ void pv(f32x16* o, int vb, bf16x8 pa0, bf16x8 pa1, bf16x8 pa2, bf16x8 pa3) {
#pragma unroll
    for (int d0 = 0; d0 < 2; ++d0) { s16x4 lo[4], hi[4];
#pragma unroll
        for (int ks = 0; ks < 4; ++ks) {
            asm volatile("ds_read_b64_tr_b16 %0,%1 offset:%c2" : "=&v"(lo[ks]) : "v"(vb), "i"(d0 * 4096 + ks * 1024) : "memory");
            asm volatile("ds_read_b64_tr_b16 %0,%1 offset:%c2" : "=&v"(hi[ks]) : "v"(vb), "i"(d0 * 4096 + ks * 1024 + 512) : "memory"); }
        asm volatile("s_waitcnt lgkmcnt(0)" ::: "memory"); SBAR();
#define PK(k) (bf16x8){lo[k][0], lo[k][1], lo[k][2], lo[k][3], hi[k][0], hi[k][1], hi[k][2], hi[k][3]}
        o[d0] = __builtin_amdgcn_mfma_f32_32x32x16_bf16(pa0, PK(0), o[d0], 0, 0, 0);
        o[d0] = __builtin_amdgcn_mfma_f32_32x32x16_bf16(pa1, PK(1), o[d0], 0, 0, 0);
        o[d0] = __builtin_amdgcn_mfma_f32_32x32x16_bf16(pa2, PK(2), o[d0], 0, 0, 0);
        o[d0] = __builtin_amdgcn_mfma_f32_32x32x16_bf16(pa3, PK(3), o[d0], 0, 0, 0);
#undef PK
    }
}
template <int THRL> __device__ __forceinline__ void attn_unit(const bf16* Qp, const bf16* __restrict__ Kp, const bf16* __restrict__ Vp, bf16* Op, int q0, char* shm, int wv) {
    int tid_ = ltid(wv);
    const int tid = tid_, lane = tid & 63, r32 = lane & 31, hi = lane >> 5; const int wid = __builtin_amdgcn_readfirstlane(tid >> 6);
    const bf16* Qw = Qp + (long)(q0 + wid * QBLK) * PITCH;
    const unsigned lds0 = (unsigned)(uintptr_t)shm;
    float* wsf = (float*)(shm + LDS_WS) + wid * 64;
    const bf16* ksrc = Kp + (long)lane * PITCH + wid * 8;
    const bf16* vsrc = Vp + (long)(16 * (wid & 3) + (lane >> 2)) * PITCH + (wid >> 2) * 32 + (lane & 3) * 8;
    const unsigned kdst = lds0 + LDS_K + wid * 1024, vdst = lds0 + LDS_V + wid * 1024;
#define DMA_K(t, slot) glds16(ksrc + (long)(t) * KVBLK * PITCH, (unsigned)__builtin_amdgcn_readfirstlane(kdst + (slot)))
#define DMA_V(t, slot) glds16(vsrc + (long)(t) * KVBLK * PITCH, (unsigned)__builtin_amdgcn_readfirstlane(vdst + (slot)))
    const int vb0 = (int)(lds0 + LDS_V) + ((lane >> 4) & 1) * 32 + (lane & 3) * 8 + (4 * hi + ((lane & 15) >> 2)) * 64;
    const char* Kbase = shm + LDS_K; bf16x8 kf[8];
    const lds_cptr shm3 = (lds_cptr)shm; const lds_cptr kp0 = shm3 + LDS_K + hi * 1024 + r32 * 16; const lds_cptr vp0 = shm3 + LDS_V + ((lane >> 4) & 1) * 32 + (lane & 3) * 8 + (4 * hi + ((lane & 15) >> 2)) * 64;
    DMA_K(0, 0); DMA_V(0, 0); DMA_K(1, SLOTB);
    bf16x8 qr[4];
#pragma unroll
    for (int d0 = 0; d0 < 4; ++d0) qr[d0] = *reinterpret_cast<const bf16x8*>(&Qw[(long)r32 * PITCH + d0 * 16 + hi * 8]);
    const float cb = 0.f;
    float mhat = 0.f, l_reg = 0.f; f32x16 o[2]; o[0] = f32x16{}; o[1] = f32x16{}; f32x16 negm;
#pragma unroll
    for (int r = 0; r < 16; ++r) negm[r] = cb;
    asm volatile("" : "+v"(negm));
#define BIASADD(C0, C1, t) do { } while (0)
#define NEGM_UPD(tn) do { } while (0)
    bool resc = false;
#define START(P0, P1) do { const float rm = rowmax(P0, P1); resc = false; \
    { const float dl = rm; mhat = fadd_s(mhat, dl); \
      _Pragma("unroll") for (int r = 0; r < 16; ++r) { P0[r] = fsub_s(P0[r], dl); P1[r] = fsub_s(P1[r], dl); } \
      _Pragma("unroll") for (int r = 0; r < 16; ++r) negm[r] = cb - mhat; asm volatile("" : "+v"(negm)); } \
    _Pragma("unroll") for (int r = 0; r < 16; ++r) P0[r] = __builtin_amdgcn_exp2f(P0[r]); } while (0)
#define RESC() do { if (resc) { asm volatile("s_waitcnt lgkmcnt(0)" ::: "memory"); \
      _Pragma("unroll") for (int d_ = 0; d_ < 2; ++d_) _Pragma("unroll") for (int r = 0; r < 16; ++r) o[d_][r] *= wsf[crow(r, hi)]; } } while (0)
    f32x16 pA0, pA1, pB0, pB1;
    int sl_prev = 0, sl_cur = 0, sl_next = SLOTB;
#define ROT() do { sl_prev = sl_cur; sl_cur = sl_next; sl_next = (sl_next == (NSLOT - 1) * SLOTB) ? 0 : sl_next + SLOTB; } while (0)
    DMA_K(2, 2 * SLOTB);
    WAIT_BAR(3);
    qkt(pA0, pA1, Kbase, qr, negm, r32, hi); asm volatile("s_nop 15\n\ts_nop 7" : "+v"(pA0), "+v"(pA1)); BIASADD(pA0, pA1, 0);
    START(pA0, pA1);
    _Pragma("unroll") for (int r = 0; r < 16; ++r) pA1[r] = __builtin_amdgcn_exp2f(pA1[r]);
    WAIT_BAR(0);
    DMA_K(3, 0); DMA_V(1, SLOTB);
    ROT();
    kload8(kf, kp0 + sl_cur);
    NEGM_UPD(1);
    WAIT_BAR(2);
    s16x4 vlo[8], vhi[8]; u32x4 pw0, pw1, pw2, pw3;
#define PKW(P, B) cvtpk(P[B], P[B + 1])
#define PAF(k) __builtin_bit_cast(bf16x8, pw##k)
#define VFR(i) (bf16x8){vlo[i][0], vlo[i][1], vlo[i][2], vlo[i][3], vhi[i][0], vhi[i][1], vhi[i][2], vhi[i][3]}
#define PIN(x) asm volatile("" : "+v"(x))
#define MX3(a, b, c) __builtin_fmaxf(__builtin_fmaxf((a), (b)), (c))
#define GAPA(MF, A0, A1, A2, A3, W0, W1, PW) do { MF; sacc += A0; sacc += A1; sacc += A2; sacc += A3; PIN(sacc); W0; W1; PIN(PW); SBAR(); } while (0)
#define EX(v) __builtin_amdgcn_exp2f(v)
#define GAPB(MF, X, B) do { MF; X[B] = EX(X[B]); X[B + 1] = EX(X[B + 1]); X[B + 2] = EX(X[B + 2]); X[B + 3] = EX(X[B + 3]); PIN(X); SBAR(); } while (0)
#define VRD(i) do { vlo[i] = vtr(vp_ + (((i) >> 2) * 4096 + ((i) & 3) * 1024)); vhi[i] = vtr(vp_ + (((i) >> 2) * 4096 + ((i) & 3) * 1024 + 512)); } while (0)
#define KRD(G, j) do { if (G) { kload2(kf, kp0 + sl_next, j); SBAR(); } } while (0)
#define STEP(C0, C1, P0, P1, t, GK, GV, GL) do { SBAR(); \
    const lds_cptr vp_ = vp0 + sl_prev; \
    VRD(0); SBAR(); float sacc = (P0[0] + P0[1]); \
    GAPA(C0 = __builtin_amdgcn_mfma_f32_32x32x16_bf16(kf[0], qr[0], negm, 0, 0, 0), P0[2], P0[3], P0[4], P0[5],     pw0[0] = PKW(P0, 0), pw0[1] = PKW(P0, 2), pw0); \
    VRD(4); SBAR(); GAPA(C1 = __builtin_amdgcn_mfma_f32_32x32x16_bf16(kf[1], qr[0], negm, 0, 0, 0), P0[6], P0[7], P0[8], P0[9],     pw0[2] = PKW(P0, 4), pw0[3] = PKW(P0, 6), pw0); \
    VRD(1); SBAR(); GAPA(C0 = __builtin_amdgcn_mfma_f32_32x32x16_bf16(kf[2], qr[1], C0, 0, 0, 0),   P0[10], P0[11], P0[12], P0[13], pw1[0] = PKW(P0, 8), pw1[1] = PKW(P0, 10), pw1); \
    VRD(5); SBAR(); GAPA(C1 = __builtin_amdgcn_mfma_f32_32x32x16_bf16(kf[3], qr[1], C1, 0, 0, 0),   P0[14], P0[15], P1[0], P1[1],   pw1[2] = PKW(P0, 12), pw1[3] = PKW(P0, 14), pw1); \
    VRD(2); SBAR(); GAPA(C0 = __builtin_amdgcn_mfma_f32_32x32x16_bf16(kf[4], qr[2], C0, 0, 0, 0),   P1[2], P1[3], P1[4], P1[5],     pw2[0] = PKW(P1, 0), pw2[1] = PKW(P1, 2), pw2); \
    VRD(6); SBAR(); GAPA(C1 = __builtin_amdgcn_mfma_f32_32x32x16_bf16(kf[5], qr[2], C1, 0, 0, 0),   P1[6], P1[7], P1[8], P1[9],     pw2[2] = PKW(P1, 4), pw2[3] = PKW(P1, 6), pw2); \
    VRD(3); SBAR(); GAPA(C0 = __builtin_amdgcn_mfma_f32_32x32x16_bf16(kf[6], qr[3], C0, 0, 0, 0),   P1[10], P1[11], P1[12], P1[13], pw3[0] = PKW(P1, 8), pw3[1] = PKW(P1, 10), pw3); \
    VRD(7); SBAR(); GAPA(C1 = __builtin_amdgcn_mfma_f32_32x32x16_bf16(kf[7], qr[3], C1, 0, 0, 0),   P1[14], P1[15], 0.f, 0.f,       pw3[2] = PKW(P1, 12), pw3[3] = PKW(P1, 14), pw3); \
    l_reg += sacc; \
    if (GK) { DMA_K((t) + 3, sl_cur); } if (GV) { DMA_V((t) + 1, sl_next); } \
    BIASADD(C0, C1, t); \
    { float a = MX3(C0[0], C0[1], C1[0]), b = MX3(C0[2], C0[3], C1[1]); a = MX3(a, C1[2], C1[3]); \
      _Pragma("unroll") for (int r = 4; r < 16; r += 4) { a = MX3(a, C0[r], C0[r + 1]); b = MX3(b, C0[r + 2], C0[r + 3]); a = MX3(a, C1[r], C1[r + 1]); b = MX3(b, C1[r + 2], C1[r + 3]); } \
      float rm = __builtin_fmaxf(a, b); { auto rr = __builtin_amdgcn_permlane32_swap(__float_as_uint(rm), __float_as_uint(rm), false, false); rm = __builtin_fmaxf(__uint_as_float(rr[0]), __uint_as_float(rr[1])); } \
      resc = false; \
      if (__builtin_expect(__any(rm > (float)THRL), 0)) { const float dl = __builtin_fmaxf(rm, 0.f); mhat += dl; \
        _Pragma("unroll") for (int r = 0; r < 16; ++r) { C0[r] -= dl; C1[r] -= dl; } \
        _Pragma("unroll") for (int r = 0; r < 16; ++r) negm[r] = cb - mhat; asm volatile("" : "+v"(negm)); \
        const float f = __builtin_amdgcn_exp2f(-dl); l_reg *= f; if (hi == 0) wsf[r32] = f; resc = true; } } \
    SBAR(); \
    GAPB(o[0] = __builtin_amdgcn_mfma_f32_32x32x16_bf16(PAF(0), VFR(0), o[0], 0, 0, 0), C0, 0); \
    GAPB(o[1] = __builtin_amdgcn_mfma_f32_32x32x16_bf16(PAF(0), VFR(4), o[1], 0, 0, 0), C0, 4); \
    KRD(GL, 0); GAPB(o[0] = __builtin_amdgcn_mfma_f32_32x32x16_bf16(PAF(1), VFR(1), o[0], 0, 0, 0), C0, 8); \
    KRD(GL, 1); GAPB(o[1] = __builtin_amdgcn_mfma_f32_32x32x16_bf16(PAF(1), VFR(5), o[1], 0, 0, 0), C0, 12); \
    KRD(GL, 2); GAPB(o[0] = __builtin_amdgcn_mfma_f32_32x32x16_bf16(PAF(2), VFR(2), o[0], 0, 0, 0), C1, 0); \
    KRD(GL, 3); GAPB(o[1] = __builtin_amdgcn_mfma_f32_32x32x16_bf16(PAF(2), VFR(6), o[1], 0, 0, 0), C1, 4); \
    GAPB(o[0] = __builtin_amdgcn_mfma_f32_32x32x16_bf16(PAF(3), VFR(3), o[0], 0, 0, 0), C1, 8); \
    GAPB(o[1] = __builtin_amdgcn_mfma_f32_32x32x16_bf16(PAF(3), VFR(7), o[1], 0, 0, 0), C1, 12); \
    } while (0)
    int t = 1;
    for (; t + 5 < NT; t += 2) {
        STEP(pB0, pB1, pA0, pA1, t, true, true, true);     WAIT_BAR(2); RESC(); ROT(); NEGM_UPD(t + 1);
        STEP(pA0, pA1, pB0, pB1, t + 1, true, true, true); WAIT_BAR(2); RESC(); ROT(); NEGM_UPD(t + 2);
    }
#define ENDW(tt) do { if ((tt) + 3 < NT) { WAIT_BAR(2); } else if ((tt) + 2 < NT) { WAIT_BAR(1); } else { WAIT_BAR(0); } } while (0)
    for (; t + 1 < NT; t += 2) {
        STEP(pB0, pB1, pA0, pA1, t, (t + 3 < NT), (t + 1 < NT), (t + 1 < NT));       ENDW(t);     RESC(); ROT(); NEGM_UPD(t + 1);
        STEP(pA0, pA1, pB0, pB1, t + 1, (t + 4 < NT), (t + 2 < NT), (t + 2 < NT));   ENDW(t + 1); RESC(); ROT(); NEGM_UPD(t + 2);
    }
    STEP(pB0, pB1, pA0, pA1, NT - 1, false, false, false); RESC();
    { float sacc = pB0[0] + pB0[1]; _Pragma("unroll") for (int r = 2; r < 16; ++r) sacc += pB0[r]; _Pragma("unroll") for (int r = 0; r < 16; ++r) sacc += pB1[r]; l_reg += sacc;
      pw0 = (u32x4){PKW(pB0, 0), PKW(pB0, 2), PKW(pB0, 4), PKW(pB0, 6)}; pw1 = (u32x4){PKW(pB0, 8), PKW(pB0, 10), PKW(pB0, 12), PKW(pB0, 14)}; pw2 = (u32x4){PKW(pB1, 0), PKW(pB1, 2), PKW(pB1, 4), PKW(pB1, 6)}; pw3 = (u32x4){PKW(pB1, 8), PKW(pB1, 10), PKW(pB1, 12), PKW(pB1, 14)};
      SBAR(); pv(o, vb0 + sl_cur, PAF(0), PAF(1), PAF(2), PAF(3)); }
#undef PKW
#undef PAF
#undef VFR
#undef PIN
#undef MX3
#undef GAPA
#undef GAPB
#undef EX
#undef VRD
#undef KRD
#undef STEP
#undef ENDW
    { auto rr = __builtin_amdgcn_permlane32_swap(__float_as_uint(l_reg), __float_as_uint(l_reg), false, false); l_reg = __uint_as_float(rr[0]) + __uint_as_float(rr[1]); }
    if (hi == 0) wsf[32 + r32] = l_reg; asm volatile("s_waitcnt lgkmcnt(0)" ::: "memory");
    float rli[16];
#pragma unroll
    for (int r = 0; r < 16; ++r) rli[r] = __builtin_amdgcn_rcpf(wsf[32 + crow(r, hi)]);
    bf16* Ow = Op + (long)(q0 + wid * QBLK) * OPITCH;
    { bf16* stg = (bf16*)(shm + LDS_OST) + wid * 2048;
#pragma unroll
      for (int r = 0; r < 16; ++r) { const int orow = crow(r, hi);
#pragma unroll
          for (int d0 = 0; d0 < 2; ++d0) stg[orow * 64 + d0 * 32 + r32] = __float2bfloat16(o[d0][r] * rli[r]); }
      asm volatile("s_waitcnt lgkmcnt(0)" ::: "memory");
#pragma unroll
      for (int i = 0; i < 4; ++i) { const int row = i * 8 + (lane >> 3), ch = lane & 7; const u32x4 v = *(const u32x4*)(stg + row * 64 + ch * 8); *(u32x4*)(Ow + (long)row * OPITCH + ch * 8) = v; } }
    asm volatile("s_waitcnt lgkmcnt(0)\n\ts_barrier" ::: "memory");
#undef DMA_K
#undef DMA_V
#undef BIASADD
#undef NEGM_UPD
#undef START
#undef RESC
#undef ROT
}


__device__ __forceinline__ void attn_unit_nm(const bf16* Qp, const bf16* __restrict__ Kp, const bf16* __restrict__ Vp, bf16* Op, int q0, char* shm, int wv) {
    int tid_ = ltid(wv);
    const int tid = tid_, lane = tid & 63, r32 = lane & 31, hi = lane >> 5; const int wid = __builtin_amdgcn_readfirstlane(tid >> 6);
    const bf16* Qw = Qp + (long)(q0 + wid * QBLK) * PITCH;
    const unsigned lds0 = (unsigned)(uintptr_t)shm;
    const bf16* ksrc = Kp + (long)lane * PITCH + wid * 8;
    const bf16* vsrc = Vp + (long)(16 * (wid & 3) + (lane >> 2)) * PITCH + (wid >> 2) * 32 + (lane & 3) * 8;
    const unsigned kdst = lds0 + LDS_K + wid * 1024, vdst = lds0 + LDS_V + wid * 1024;
#define DMA_K(t, slot) glds16(ksrc + (long)(t) * KVBLK * PITCH, (unsigned)__builtin_amdgcn_readfirstlane(kdst + (slot)))
#define DMA_V(t, slot) glds16(vsrc + (long)(t) * KVBLK * PITCH, (unsigned)__builtin_amdgcn_readfirstlane(vdst + (slot)))
    const int vb0 = (int)(lds0 + LDS_V) + ((lane >> 4) & 1) * 32 + (lane & 3) * 8 + (4 * hi + ((lane & 15) >> 2)) * 64;
    const char* Kbase = shm + LDS_K; bf16x8 kf[8];
    const lds_cptr shm3 = (lds_cptr)shm; const lds_cptr kp0 = shm3 + LDS_K + hi * 1024 + r32 * 16; const lds_cptr vp0 = shm3 + LDS_V + ((lane >> 4) & 1) * 32 + (lane & 3) * 8 + (4 * hi + ((lane & 15) >> 2)) * 64;
    DMA_K(0, 0); DMA_V(0, 0); DMA_K(1, SLOTB);
    bf16x8 qr[4];
#pragma unroll
    for (int d0 = 0; d0 < 4; ++d0) qr[d0] = *reinterpret_cast<const bf16x8*>(&Qw[(long)r32 * PITCH + d0 * 16 + hi * 8]);
    f32x16 o[2]; o[0] = f32x16{}; o[1] = f32x16{}; float l_reg = 0.f;
    float* wsf = (float*)(shm + LDS_WS) + wid * 64;
    const f32x16 zero16 = f32x16{};
    f32x16 pA0, pA1, pB0, pB1;
    int sl_prev = 0, sl_cur = 0, sl_next = SLOTB;
#define ROT() do { sl_prev = sl_cur; sl_cur = sl_next; sl_next = (sl_next == (NSLOT - 1) * SLOTB) ? 0 : sl_next + SLOTB; } while (0)
    DMA_K(2, 2 * SLOTB);
    WAIT_BAR(3);
    qkt(pA0, pA1, Kbase, qr, zero16, r32, hi); asm volatile("s_nop 15\n\ts_nop 7" : "+v"(pA0), "+v"(pA1));
    _Pragma("unroll") for (int r = 0; r < 16; ++r) { pA0[r] = __builtin_amdgcn_exp2f(pA0[r]); pA1[r] = __builtin_amdgcn_exp2f(pA1[r]); }
    WAIT_BAR(0);
    DMA_K(3, 0); DMA_V(1, SLOTB);
    ROT();
    kload8(kf, kp0 + sl_cur);
    WAIT_BAR(2);
    s16x4 vlo[8], vhi[8]; u32x4 pw0, pw1, pw2, pw3;
#define PKW(P, B) cvtpk(P[B], P[B + 1])
#define PAF(k) __builtin_bit_cast(bf16x8, pw##k)
#define VFR(i) (bf16x8){vlo[i][0], vlo[i][1], vlo[i][2], vlo[i][3], vhi[i][0], vhi[i][1], vhi[i][2], vhi[i][3]}
#define PIN(x) asm volatile("" : "+v"(x))
#define GAPA(MF, A0, A1, A2, A3, W0, W1, PW) do { MF; sacc += A0; sacc += A1; sacc += A2; sacc += A3; PIN(sacc); W0; W1; PIN(PW); SBAR(); } while (0)
#define EX(v) __builtin_amdgcn_exp2f(v)
#define GAPB4(MF, X, B) do { MF; X[B] = EX(X[B]); X[B + 1] = EX(X[B + 1]); X[B + 2] = EX(X[B + 2]); X[B + 3] = EX(X[B + 3]); PIN(X); SBAR(); } while (0)
#define GAPB3(MF, E0, E1, E2, XA, XB) do { MF; E0 = EX(E0); E1 = EX(E1); E2 = EX(E2); PIN(XA); PIN(XB); SBAR(); } while (0)
#define GAPB2(MF, E0, E1, XA) do { MF; E0 = EX(E0); E1 = EX(E1); PIN(XA); SBAR(); } while (0)
#define VRD(i) do { vlo[i] = vtr(vp_ + (((i) >> 2) * 4096 + ((i) & 3) * 1024)); vhi[i] = vtr(vp_ + (((i) >> 2) * 4096 + ((i) & 3) * 1024 + 512)); } while (0)
#define KRD(G, j) do { if (G) { kload2(kf, kp0 + sl_next, j); SBAR(); } } while (0)
#define PVM(d, k, i) o[d] = __builtin_amdgcn_mfma_f32_32x32x16_bf16(PAF(k), VFR(i), o[d], 0, 0, 0)
#define LSM(k) lsum = __builtin_amdgcn_mfma_f32_32x32x16_bf16(PAF(k), ones, lsum, 0, 0, 0)
#define STEP(C0, C1, P0, P1, t, GK, GV, GL) do { SBAR(); \
    const lds_cptr vp_ = vp0 + sl_prev; \
    VRD(0); SBAR(); float sacc = (P0[0] + P0[1]); \
    GAPA(C0 = __builtin_amdgcn_mfma_f32_32x32x16_bf16(kf[0], qr[0], zero16, 0, 0, 0), P0[2], P0[3], P0[4], P0[5],     pw0[0] = PKW(P0, 0), pw0[1] = PKW(P0, 2), pw0); \
    VRD(4); SBAR(); GAPA(C1 = __builtin_amdgcn_mfma_f32_32x32x16_bf16(kf[1], qr[0], zero16, 0, 0, 0), P0[6], P0[7], P0[8], P0[9],     pw0[2] = PKW(P0, 4), pw0[3] = PKW(P0, 6), pw0); \
    VRD(1); SBAR(); GAPA(C0 = __builtin_amdgcn_mfma_f32_32x32x16_bf16(kf[2], qr[1], C0, 0, 0, 0),   P0[10], P0[11], P0[12], P0[13], pw1[0] = PKW(P0, 8), pw1[1] = PKW(P0, 10), pw1); \
    VRD(5); SBAR(); GAPA(C1 = __builtin_amdgcn_mfma_f32_32x32x16_bf16(kf[3], qr[1], C1, 0, 0, 0),   P0[14], P0[15], P1[0], P1[1],   pw1[2] = PKW(P0, 12), pw1[3] = PKW(P0, 14), pw1); \
    VRD(2); SBAR(); GAPA(C0 = __builtin_amdgcn_mfma_f32_32x32x16_bf16(kf[4], qr[2], C0, 0, 0, 0),   P1[2], P1[3], P1[4], P1[5],     pw2[0] = PKW(P1, 0), pw2[1] = PKW(P1, 2), pw2); \
    VRD(6); SBAR(); GAPA(C1 = __builtin_amdgcn_mfma_f32_32x32x16_bf16(kf[5], qr[2], C1, 0, 0, 0),   P1[6], P1[7], P1[8], P1[9],     pw2[2] = PKW(P1, 4), pw2[3] = PKW(P1, 6), pw2); \
    VRD(3); SBAR(); GAPA(C0 = __builtin_amdgcn_mfma_f32_32x32x16_bf16(kf[6], qr[3], C0, 0, 0, 0),   P1[10], P1[11], P1[12], P1[13], pw3[0] = PKW(P1, 8), pw3[1] = PKW(P1, 10), pw3); \
    VRD(7); SBAR(); GAPA(C1 = __builtin_amdgcn_mfma_f32_32x32x16_bf16(kf[7], qr[3], C1, 0, 0, 0),   P1[14], P1[15], 0.f, 0.f,       pw3[2] = PKW(P1, 12), pw3[3] = PKW(P1, 14), pw3); \
    l_reg += sacc; \
    if (GK) { DMA_K((t) + 3, sl_cur); } if (GV) { DMA_V((t) + 1, sl_next); } \
    SBAR(); \
    GAPB4(PVM(0, 0, 0), C0, 0); \
    GAPB4(PVM(1, 0, 4), C0, 4); \
    KRD(GL, 0); GAPB4(PVM(0, 1, 1), C0, 8); \
    KRD(GL, 1); GAPB4(PVM(1, 1, 5), C0, 12); \
    KRD(GL, 2); GAPB4(PVM(0, 2, 2), C1, 0); \
    KRD(GL, 3); GAPB4(PVM(1, 2, 6), C1, 4); \
    GAPB4(PVM(0, 3, 3), C1, 8); \
    GAPB4(PVM(1, 3, 7), C1, 12); \
    } while (0)
    int t = 1;
    for (; t + 5 < NT; t += 2) {
        STEP(pB0, pB1, pA0, pA1, t, true, true, true);     WAIT_BAR(2); ROT();
        STEP(pA0, pA1, pB0, pB1, t + 1, true, true, true); WAIT_BAR(2); ROT();
    }
#define ENDW(tt) do { if ((tt) + 3 < NT) { WAIT_BAR(2); } else if ((tt) + 2 < NT) { WAIT_BAR(1); } else { WAIT_BAR(0); } } while (0)
    for (; t + 1 < NT; t += 2) {
        STEP(pB0, pB1, pA0, pA1, t, (t + 3 < NT), (t + 1 < NT), (t + 1 < NT));       ENDW(t);     ROT();
        STEP(pA0, pA1, pB0, pB1, t + 1, (t + 4 < NT), (t + 2 < NT), (t + 2 < NT));   ENDW(t + 1); ROT();
    }
    STEP(pB0, pB1, pA0, pA1, NT - 1, false, false, false);
    { float sacc = pB0[0] + pB0[1]; _Pragma("unroll") for (int r = 2; r < 16; ++r) sacc += pB0[r]; _Pragma("unroll") for (int r = 0; r < 16; ++r) sacc += pB1[r]; l_reg += sacc;
      pw0 = (u32x4){PKW(pB0, 0), PKW(pB0, 2), PKW(pB0, 4), PKW(pB0, 6)}; pw1 = (u32x4){PKW(pB0, 8), PKW(pB0, 10), PKW(pB0, 12), PKW(pB0, 14)}; pw2 = (u32x4){PKW(pB1, 0), PKW(pB1, 2), PKW(pB1, 4), PKW(pB1, 6)}; pw3 = (u32x4){PKW(pB1, 8), PKW(pB1, 10), PKW(pB1, 12), PKW(pB1, 14)};
      SBAR(); pv(o, vb0 + sl_cur, PAF(0), PAF(1), PAF(2), PAF(3)); }
#undef PKW
#undef PAF
#undef VFR
#undef PIN
#undef GAPA
#undef GAPB3
#undef GAPB4
#undef GAPB2
#undef EX
#undef VRD
#undef KRD
#undef PVM
#undef LSM
#undef STEP
#undef ENDW
    { auto rr = __builtin_amdgcn_permlane32_swap(__float_as_uint(l_reg), __float_as_uint(l_reg), false, false); l_reg = __uint_as_float(rr[0]) + __uint_as_float(rr[1]); }
    if (hi == 0) wsf[32 + r32] = l_reg; asm volatile("s_waitcnt lgkmcnt(0)" ::: "memory");
    float rli[16];
#pragma unroll
    for (int r = 0; r < 16; ++r) rli[r] = __builtin_amdgcn_rcpf(wsf[32 + crow(r, hi)]);
    bf16* Ow = Op + (long)(q0 + wid * QBLK) * OPITCH;
    { bf16* stg = (bf16*)(shm + LDS_OST) + wid * 2048;
#pragma unroll
      for (int r = 0; r < 16; ++r) { const int orow = crow(r, hi);
#pragma unroll
          for (int d0 = 0; d0 < 2; ++d0) stg[orow * 64 + d0 * 32 + r32] = __float2bfloat16(o[d0][r] * rli[r]); }
      asm volatile("s_waitcnt lgkmcnt(0)" ::: "memory");
#pragma unroll
      for (int i = 0; i < 4; ++i) { const int row = i * 8 + (lane >> 3), ch = lane & 7; const u32x4 v = *(const u32x4*)(stg + row * 64 + ch * 8); *(u32x4*)(Ow + (long)row * OPITCH + ch * 8) = v; } }
    asm volatile("s_waitcnt lgkmcnt(0)\n\ts_barrier" ::: "memory");
#undef DMA_K
#undef DMA_V
#undef ROT
}

__device__ __forceinline__ void attn_unit_a8(const unsigned char* Q8p, const unsigned char* __restrict__ K8p, const unsigned char* __restrict__ VT8p, bf16* Op, int q0, float negR, char* shm, int wv) {
    constexpr int A8_K = 0, A8_V = 16384, A8_OST = 32768, A8_SLOT = 4096;
    int tid_ = ltid(wv);
    const int tid = tid_, lane = tid & 63, r32 = lane & 31, hi = lane >> 5; const int wid = __builtin_amdgcn_readfirstlane(tid >> 6);
    const unsigned lds0 = (unsigned)(uintptr_t)shm;
    const bool kwave = wid < 4;
    const unsigned char* dsrc = kwave ? K8p + (long)lane * 128 + wid * 16 : VT8p + (long)lane * SEQ + (wid - 4) * 16;
    const long dstep = kwave ? 64 * 128 : 64;
    const unsigned ddst = lds0 + (kwave ? A8_K + wid * 1024 : A8_V + (wid - 4) * 1024);
#define DMA8(t, slot) glds16(dsrc + (long)(t) * dstep, (unsigned)__builtin_amdgcn_readfirstlane(ddst + (slot)))
    const lds_cptr shm3 = (lds_cptr)shm; const lds_cptr kp0 = shm3 + A8_K + hi * 2048 + r32 * 16, vp0 = shm3 + A8_V + hi * 2048 + r32 * 16;
#define LD8(p) ({ const u32x4 l_ = *(const LAS u32x4*)(p), h_ = *(const LAS u32x4*)((p) + 1024); (v8i32){(int)l_.x, (int)l_.y, (int)l_.z, (int)l_.w, (int)h_.x, (int)h_.y, (int)h_.z, (int)h_.w}; })
    if (kwave) { DMA8(0, 0); DMA8(1, A8_SLOT); DMA8(2, 2 * A8_SLOT); DMA8(3, 3 * A8_SLOT); } else { DMA8(0, 0); DMA8(1, A8_SLOT); }
    v8i32 qf; { const u32x4* qp = (const u32x4*)(Q8p + (long)(q0 + wid * QBLK + r32) * 512 + hi * 32); const u32x4 a = qp[0], b = qp[1]; qf = (v8i32){(int)a.x, (int)a.y, (int)a.z, (int)a.w, (int)b.x, (int)b.y, (int)b.z, (int)b.w}; }
    f32x16 o[2]; o[0] = f32x16{}; o[1] = f32x16{};
    f32x16 cinit;
    { float nr = negR; asm volatile("" : "+v"(nr));
      _Pragma("unroll") for (int r = 0; r < 16; ++r) cinit[r] = nr; }
    asm volatile("" : "+v"(cinit));
    int scK = 0x7F7F7F7F, scQ = 0x7B7B7B7B, scP = 0x7F7F7F7F, scV = 0x7D7D7D7D; asm volatile("" : "+v"(scK), "+v"(scQ), "+v"(scP), "+v"(scV));
#define QK8(D, KF) asm volatile("v_mfma_scale_f32_32x32x64_f8f6f4 %0, %1, %2, %3, %4, %5 op_sel_hi:[0,0,0]" : "=&v"(D) : "v"(KF), "v"(qf), "v"(cinit), "v"(scK), "v"(scQ))
#define PV8(D, PW, VF) asm volatile("s_nop 3\n\tv_mfma_scale_f32_32x32x64_f8f6f4 %0, %1, %2, %0, %3, %4 op_sel_hi:[0,0,0]" : "+v"(D) : "v"(PW), "v"(VF), "v"(scP), "v"(scV))
#define NOPS2(A, B) asm volatile("s_nop 15\n\ts_nop 7" : "+v"(A), "+v"(B))
    f32x16 pA0, pA1, pB0, pB1; v8i32 kfA[2], kfB[2], vf[2], pw = {};
    v8i32 ones; { int o1 = 0x38383838; asm volatile("" : "+v"(o1)); ones = (v8i32){o1, o1, o1, o1, o1, o1, o1, o1}; }
    f32x16 lacc = f32x16{};
#define PVL() asm volatile("v_mfma_scale_f32_32x32x64_f8f6f4 %0, %1, %2, %0, %3, %3 op_sel_hi:[0,0,0]" : "+v"(lacc) : "v"(pw), "v"(ones), "v"(scP))
    int sl_prev = 0, sl_cur = 0, sl_next = A8_SLOT, sl_n2 = 2 * A8_SLOT;
#define ROT() do { sl_prev = sl_cur; sl_cur = sl_next; sl_next = sl_n2; sl_n2 = (sl_n2 == 3 * A8_SLOT) ? 0 : sl_n2 + A8_SLOT; } while (0)
    WAIT_BAR(3);
    kfB[0] = LD8(kp0); kfB[1] = LD8(kp0 + 512);
    QK8(pA0, kfB[0]); QK8(pA1, kfB[1]); NOPS2(pA0, pA1);
    _Pragma("unroll") for (int r = 0; r < 16; ++r) { pA0[r] = __builtin_amdgcn_exp2f(pA0[r]); pA1[r] = __builtin_amdgcn_exp2f(pA1[r]); }
    WAIT_BAR(0);
    if (kwave) { DMA8(4, 0); } else { DMA8(2, 2 * A8_SLOT); }
    ROT();
    kfA[0] = LD8(kp0 + sl_cur); kfA[1] = LD8(kp0 + sl_cur + 512);
    WAIT_BAR(1);
#define PK2(W, a, b, c, d) do { W = __builtin_amdgcn_cvt_pk_fp8_f32(a, b, W, false); W = __builtin_amdgcn_cvt_pk_fp8_f32(c, d, W, true); } while (0)
#define PACKH(W0, PP) do { PK2(pw[W0], PP[0], PP[1], PP[2], PP[3]); PK2(pw[W0 + 1], PP[4], PP[5], PP[6], PP[7]); PK2(pw[W0 + 2], PP[8], PP[9], PP[10], PP[11]); PK2(pw[W0 + 3], PP[12], PP[13], PP[14], PP[15]); } while (0)
#define STEP8(C0, C1, P0, P1, t, GK, GV, GL, KC, KN) do { SBAR(); \
    vf[0] = LD8(vp0 + sl_prev); vf[1] = LD8(vp0 + sl_prev + 512); \
    QK8(C0, KC[0]); SBAR(); \
    PACKH(0, P0); asm volatile("" : "+v"(pw)); SBAR(); \
    QK8(C1, KC[1]); \
    if (GL) { KN[0] = LD8(kp0 + sl_next); KN[1] = LD8(kp0 + sl_next + 512); } \
    SBAR(); asm volatile("" :: "v"(KC[0]), "v"(KC[1]));     \
    PACKH(4, P1); asm volatile("" : "+v"(pw)); \
    if (kwave) { if (GK) { DMA8((t) + 4, sl_cur); } } else { if (GV) { DMA8((t) + 2, sl_n2); } } \
    SBAR(); \
    PV8(o[0], pw, vf[0]); SBAR(); \
    asm volatile("s_nop 1" : "+v"(C0));              \
    _Pragma("unroll") for (int r = 0; r < 16; ++r) C0[r] = __builtin_amdgcn_exp2f(C0[r]); \
    asm volatile("" : "+v"(C0)); SBAR(); \
    PV8(o[1], pw, vf[1]); SBAR(); \
    asm volatile("" : "+v"(C1)); \
    _Pragma("unroll") for (int r = 0; r < 8; ++r) C1[r] = __builtin_amdgcn_exp2f(C1[r]); \
    asm volatile("" : "+v"(C1)); SBAR(); \
    PVL(); SBAR(); \
    asm volatile("" : "+v"(C1)); \
    _Pragma("unroll") for (int r = 8; r < 16; ++r) C1[r] = __builtin_amdgcn_exp2f(C1[r]); \
    asm volatile("" : "+v"(C1));                     \
    SBAR(); \
    } while (0)
    int t = 1;
    for (; t + 5 < NT; t += 2) {
        STEP8(pB0, pB1, pA0, pA1, t, true, true, true, kfA, kfB);     WAIT_BAR(2); ROT();
        STEP8(pA0, pA1, pB0, pB1, t + 1, true, true, true, kfB, kfA); WAIT_BAR(2); ROT();
    }
#define ENDW8(tt) do { WAIT_BAR(0); } while (0)
    for (; t + 1 < NT; t += 2) {
        STEP8(pB0, pB1, pA0, pA1, t, (t + 4 < NT), (t + 2 < NT), (t + 1 < NT), kfA, kfB);       ENDW8(t);     ROT();
        STEP8(pA0, pA1, pB0, pB1, t + 1, (t + 5 < NT), (t + 3 < NT), (t + 2 < NT), kfB, kfA);   ENDW8(t + 1); ROT();
    }
    STEP8(pB0, pB1, pA0, pA1, NT - 1, false, false, false, kfA, kfB);
    { PACKH(0, pB0); PACKH(4, pB1); vf[0] = LD8(vp0 + sl_cur); vf[1] = LD8(vp0 + sl_cur + 512);
      PV8(o[0], pw, vf[0]); PV8(o[1], pw, vf[1]); PVL(); NOPS2(o[0], o[1]); asm volatile("s_nop 15\n\ts_nop 7" : "+v"(lacc)); }
#undef PK2
#undef PACKH
#undef PVL
#undef STEP8
#undef ENDW8
#undef PACK8
#undef NOPS2
#undef PV8
#undef QK8
#undef LD8
#undef ROT
#undef DMA8
    float rli[16];
#pragma unroll
    for (int r = 0; r < 16; ++r) rli[r] = __builtin_amdgcn_rcpf(lacc[r]);
    bf16* Ow = Op + (long)(q0 + wid * QBLK) * OPITCH;
    { bf16* stg = (bf16*)(shm + A8_OST) + wid * 2048;
#pragma unroll
      for (int r = 0; r < 16; ++r) { const int orow = crow(r, hi);
#pragma unroll
          for (int d0 = 0; d0 < 2; ++d0) stg[orow * 64 + d0 * 32 + r32] = __float2bfloat16(o[d0][r] * rli[r]); }
      asm volatile("s_waitcnt lgkmcnt(0)" ::: "memory");
#pragma unroll
      for (int i = 0; i < 4; ++i) { const int row = i * 8 + (lane >> 3), ch = lane & 7; const u32x4 v = *(const u32x4*)(stg + row * 64 + ch * 8); *(u32x4*)(Ow + (long)row * OPITCH + ch * 8) = v; } }
    asm volatile("s_waitcnt lgkmcnt(0)\n\ts_barrier" ::: "memory");
}

__device__ __forceinline__ void b_pair_epilogue(f32x16 (&o)[4], const float (&rli)[16], int m, float lam, const float* subln, bf16* Ow, char* shm, int wid, int lane, int r32, int hi) {
    bf16* st = (bf16*)(shm + LDS_STASH) + wid * 4096;
    if (m == 0) {
#pragma unroll
        for (int r = 0; r < 16; ++r) { const int orow = crow(r, hi);
#pragma unroll
            for (int d0 = 0; d0 < 4; ++d0) st[orow * 128 + d0 * 32 + r32] = __float2bfloat16(o[d0][r] * rli[r]); }
    } else {
        float sg[4];
#pragma unroll
        for (int d0 = 0; d0 < 4; ++d0) sg[d0] = subln[d0 * 32 + r32] * (1.f - LAM_INIT);
        bf16* stg = (bf16*)shm + wid * 4096;
#pragma unroll
        for (int r = 0; r < 16; ++r) { const int orow = crow(r, hi); float ss = 0.f;
#pragma unroll
            for (int d0 = 0; d0 < 4; ++d0) { const float df = __bfloat162float(st[orow * 128 + d0 * 32 + r32]) - lam * (o[d0][r] * rli[r]); o[d0][r] = df; ss += df * df; }
            ss += swz_xor<1>(ss); ss += swz_xor<2>(ss); ss += swz_xor<4>(ss); ss += swz_xor<8>(ss); ss += swz_xor<16>(ss);
            const float rinv = 1.0f / sqrtf(ss * (1.f / 128.f) + LN_EPS);
#pragma unroll
            for (int d0 = 0; d0 < 4; ++d0) stg[orow * 128 + d0 * 32 + r32] = __float2bfloat16(o[d0][r] * rinv * sg[d0]); }
        asm volatile("s_waitcnt lgkmcnt(0)" ::: "memory");
#pragma unroll
        for (int i = 0; i < 8; ++i) { const int row = i * 4 + (lane >> 4), ch = lane & 15; const u32x4 v = *(const u32x4*)(stg + row * 128 + ch * 8); *(u32x4*)(Ow + (long)row * OPITCH + ch * 8) = v; }
    }
    asm volatile("s_waitcnt lgkmcnt(0)\n\ts_barrier" ::: "memory");
}
constexpr int V2_SLOTV = 16384, V2_LDS_V = NSLOT * SLOTB, V2_LDS_WS = V2_LDS_V + NSLOT * V2_SLOTV;
template <int THRL> __device__ __forceinline__ void attn_unit_v128(const bf16* Qp, const bf16* __restrict__ Kp, const bf16* __restrict__ Vp, bf16* Op, int q0, float cL, float cR, int tabofs, int m, float lam, const float* subln, char* shm, int wv) {
    int tid_ = ltid(wv);
    const int tid = tid_, lane = tid & 63, r32 = lane & 31, hi = lane >> 5; const int wid = __builtin_amdgcn_readfirstlane(tid >> 6);
    const bf16* Qw = Qp + (long)(q0 + wid * QBLK) * PITCH;
    const unsigned lds0 = (unsigned)(uintptr_t)shm;
    float* wsf = (float*)(shm + V2_LDS_WS) + wid * 64;
    const bf16* ksrc = Kp + (long)lane * PITCH + wid * 8;
    const bf16* vsrc = Vp + (long)(16 * (wid & 3) + (lane >> 2)) * PITCH + (wid >> 2) * 32 + (lane & 3) * 8;
    const unsigned kdst = lds0 + LDS_K + wid * 1024, vdst = lds0 + V2_LDS_V + wid * 1024;
#define DMA_K(t, slot) glds16(ksrc + (long)(t) * KVBLK * PITCH, (unsigned)__builtin_amdgcn_readfirstlane(kdst + (slot)))
#define DMA_V(t, slot) do { glds16(vsrc + (long)(t) * KVBLK * PITCH, (unsigned)__builtin_amdgcn_readfirstlane(vdst + 2 * (slot))); \
                            glds16(vsrc + (long)(t) * KVBLK * PITCH + 64, (unsigned)__builtin_amdgcn_readfirstlane(vdst + 2 * (slot) + 8192)); } while (0)
    const int vb0 = (int)(lds0 + V2_LDS_V) + ((lane >> 4) & 1) * 32 + (lane & 3) * 8 + (4 * hi + ((lane & 15) >> 2)) * 64;
    const char* Kbase = shm + LDS_K; bf16x8 kf[8];
    const lds_cptr shm3 = (lds_cptr)shm; const lds_cptr kp0 = shm3 + LDS_K + hi * 1024 + r32 * 16; const lds_cptr vp0 = shm3 + V2_LDS_V + ((lane >> 4) & 1) * 32 + (lane & 3) * 8 + (4 * hi + ((lane & 15) >> 2)) * 64;
    const int q0w = q0 + wid * QBLK;
    const LAS float* tabl = (const LAS float*)(shm3 + tabofs) + (256 - r32 + 4 * hi);
#define BCONST_T(t) ((64 * (t) - q0w <= -160) ? cL : ((64 * (t) - q0w >= 128) ? cR : 0.f))
#define BIASADD(C0, C1, t) do { const int dk_ = 64 * (t) - q0w; if (dk_ >= -128 && dk_ <= 96) { const LAS float* tb_ = tabl + dk_; \
      _Pragma("unroll") for (int r = 0; r < 16; ++r) { C0[r] += tb_[(r & 3) + 8 * (r >> 2)]; C1[r] += tb_[(r & 3) + 8 * (r >> 2) + 32]; } } } while (0)
    DMA_K(0, 0); DMA_V(0, 0); DMA_K(1, SLOTB);
    bf16x8 qr[4];
#pragma unroll
    for (int d0 = 0; d0 < 4; ++d0) qr[d0] = *reinterpret_cast<const bf16x8*>(&Qw[(long)r32 * PITCH + d0 * 16 + hi * 8]);
    float mhat = 0.f, moff = 0.f, l_reg = 0.f; f32x16 o[4]; o[0] = f32x16{}; o[1] = f32x16{}; o[2] = f32x16{}; o[3] = f32x16{};
    const f32x16 zero16 = f32x16{};
    bool resc = false;
#define RESC() do { if (resc) { asm volatile("s_waitcnt lgkmcnt(0)" ::: "memory"); \
      _Pragma("unroll") for (int d_ = 0; d_ < 4; ++d_) _Pragma("unroll") for (int r = 0; r < 16; ++r) o[d_][r] *= wsf[crow(r, hi)]; } } while (0)
    f32x16 pA0, pA1, pB0, pB1;
    int sl_prev = 0, sl_cur = 0, sl_next = SLOTB;
#define ROT() do { sl_prev = sl_cur; sl_cur = sl_next; sl_next = (sl_next == (NSLOT - 1) * SLOTB) ? 0 : sl_next + SLOTB; } while (0)
    DMA_K(2, 2 * SLOTB);
    WAIT_BAR(4);
    qkt(pA0, pA1, Kbase, qr, zero16, r32, hi); asm volatile("s_nop 15\n\ts_nop 7" : "+v"(pA0), "+v"(pA1)); BIASADD(pA0, pA1, 0);
    { const float rm = rowmax(pA0, pA1); mhat = rm + BCONST_T(0); moff = rm;
      _Pragma("unroll") for (int r = 0; r < 16; ++r) { pA0[r] = __builtin_amdgcn_exp2f(pA0[r] - moff); pA1[r] = __builtin_amdgcn_exp2f(pA1[r] - moff); } }
    WAIT_BAR(0);
    DMA_K(3, 0); DMA_V(1, SLOTB);
    ROT();
    kload8(kf, kp0 + sl_cur);
    WAIT_BAR(3);
    s16x4 vlo[16], vhi[16]; u32x4 pw0, pw1, pw2, pw3;
#define PKW(P, B) cvtpk(P[B], P[B + 1])
#define PAF(k) __builtin_bit_cast(bf16x8, pw##k)
#define VFR(i) (bf16x8){vlo[i][0], vlo[i][1], vlo[i][2], vlo[i][3], vhi[i][0], vhi[i][1], vhi[i][2], vhi[i][3]}
#define PIN(x) asm volatile("" : "+v"(x))
#define MX3(a, b, c) __builtin_fmaxf(__builtin_fmaxf((a), (b)), (c))
#define GAPA(MF, A0, A1, A2, A3, W0, W1, PW) do { MF; sacc += A0; sacc += A1; sacc += A2; sacc += A3; PIN(sacc); W0; W1; PIN(PW); SBAR(); } while (0)
#define EX(v) __builtin_amdgcn_exp2f((v) - moff)
#define GAPB(MF, X, B) do { MF; X[B] = EX(X[B]); X[B + 1] = EX(X[B + 1]); PIN(X); SBAR(); } while (0)
#define VRD(i) do { vlo[i] = vtr(vp_ + (((i) >> 2) * 4096 + ((i) & 3) * 1024)); vhi[i] = vtr(vp_ + (((i) >> 2) * 4096 + ((i) & 3) * 1024 + 512)); } while (0)
#define KRD(G, j) do { if (G) { kload2(kf, kp0 + sl_next, j); SBAR(); } } while (0)
#define PVM(d, k, i) o[d] = __builtin_amdgcn_mfma_f32_32x32x16_bf16(PAF(k), VFR(i), o[d], 0, 0, 0)
#define STEP(C0, C1, P0, P1, t, GK, GV, GL) do { SBAR(); \
    const lds_cptr vp_ = vp0 + 2 * sl_prev; \
    VRD(0); SBAR(); float sacc = (P0[0] + P0[1]); \
    GAPA(C0 = __builtin_amdgcn_mfma_f32_32x32x16_bf16(kf[0], qr[0], zero16, 0, 0, 0), P0[2], P0[3], P0[4], P0[5],     pw0[0] = PKW(P0, 0), pw0[1] = PKW(P0, 2), pw0); \
    VRD(4); SBAR(); GAPA(C1 = __builtin_amdgcn_mfma_f32_32x32x16_bf16(kf[1], qr[0], zero16, 0, 0, 0), P0[6], P0[7], P0[8], P0[9],     pw0[2] = PKW(P0, 4), pw0[3] = PKW(P0, 6), pw0); \
    VRD(1); SBAR(); GAPA(C0 = __builtin_amdgcn_mfma_f32_32x32x16_bf16(kf[2], qr[1], C0, 0, 0, 0),   P0[10], P0[11], P0[12], P0[13], pw1[0] = PKW(P0, 8), pw1[1] = PKW(P0, 10), pw1); \
    VRD(5); SBAR(); GAPA(C1 = __builtin_amdgcn_mfma_f32_32x32x16_bf16(kf[3], qr[1], C1, 0, 0, 0),   P0[14], P0[15], P1[0], P1[1],   pw1[2] = PKW(P0, 12), pw1[3] = PKW(P0, 14), pw1); \
    VRD(2); SBAR(); GAPA(C0 = __builtin_amdgcn_mfma_f32_32x32x16_bf16(kf[4], qr[2], C0, 0, 0, 0),   P1[2], P1[3], P1[4], P1[5],     pw2[0] = PKW(P1, 0), pw2[1] = PKW(P1, 2), pw2); \
    VRD(6); SBAR(); GAPA(C1 = __builtin_amdgcn_mfma_f32_32x32x16_bf16(kf[5], qr[2], C1, 0, 0, 0),   P1[6], P1[7], P1[8], P1[9],     pw2[2] = PKW(P1, 4), pw2[3] = PKW(P1, 6), pw2); \
    VRD(3); SBAR(); GAPA(C0 = __builtin_amdgcn_mfma_f32_32x32x16_bf16(kf[6], qr[3], C0, 0, 0, 0),   P1[10], P1[11], P1[12], P1[13], pw3[0] = PKW(P1, 8), pw3[1] = PKW(P1, 10), pw3); \
    VRD(7); SBAR(); GAPA(C1 = __builtin_amdgcn_mfma_f32_32x32x16_bf16(kf[7], qr[3], C1, 0, 0, 0),   P1[14], P1[15], 0.f, 0.f,       pw3[2] = PKW(P1, 12), pw3[3] = PKW(P1, 14), pw3); \
    l_reg += sacc; \
    if (GK) { DMA_K((t) + 3, sl_cur); } if (GV) { DMA_V((t) + 1, sl_next); } \
    BIASADD(C0, C1, t); \
    { float a = MX3(C0[0], C0[1], C1[0]), b = MX3(C0[2], C0[3], C1[1]); a = MX3(a, C1[2], C1[3]); \
      _Pragma("unroll") for (int r = 4; r < 16; r += 4) { a = MX3(a, C0[r], C0[r + 1]); b = MX3(b, C0[r + 2], C0[r + 3]); a = MX3(a, C1[r], C1[r + 1]); b = MX3(b, C1[r + 2], C1[r + 3]); } \
      float rm = __builtin_fmaxf(a, b); { auto rr = __builtin_amdgcn_permlane32_swap(__float_as_uint(rm), __float_as_uint(rm), false, false); rm = __builtin_fmaxf(__uint_as_float(rr[0]), __uint_as_float(rr[1])); } \
      const float cbt_ = BCONST_T(t); rm = rm + cbt_ - mhat; \
      resc = false; \
      if (__builtin_expect(__any(rm > (float)THRL), 0)) { const float dl = __builtin_fmaxf(rm, 0.f); mhat += dl; \
        const float f = __builtin_amdgcn_exp2f(-dl); l_reg *= f; if (hi == 0) wsf[r32] = f; resc = true; } \
      moff = mhat - cbt_; } \
    SBAR(); \
    GAPB(PVM(0, 0, 0), C0, 0);  VRD(8);  SBAR(); \
    GAPB(PVM(1, 0, 4), C0, 2);  VRD(12); SBAR(); \
    GAPB(PVM(0, 1, 1), C0, 4);  VRD(9);  SBAR(); \
    GAPB(PVM(1, 1, 5), C0, 6);  VRD(13); SBAR(); \
    KRD(GL, 0); GAPB(PVM(0, 2, 2), C0, 8);  VRD(10); SBAR(); \
    GAPB(PVM(1, 2, 6), C0, 10); VRD(14); SBAR(); \
    KRD(GL, 1); GAPB(PVM(0, 3, 3), C0, 12); VRD(11); SBAR(); \
    GAPB(PVM(1, 3, 7), C0, 14); VRD(15); SBAR(); \
    KRD(GL, 2); GAPB(PVM(2, 0, 8), C1, 0); \
    GAPB(PVM(3, 0, 12), C1, 2); \
    KRD(GL, 3); GAPB(PVM(2, 1, 9), C1, 4); \
    GAPB(PVM(3, 1, 13), C1, 6); \
    GAPB(PVM(2, 2, 10), C1, 8); \
    GAPB(PVM(3, 2, 14), C1, 10); \
    GAPB(PVM(2, 3, 11), C1, 12); \
    GAPB(PVM(3, 3, 15), C1, 14); \
    } while (0)
    int t = 1;
    for (; t + 5 < NT; t += 2) {
        STEP(pB0, pB1, pA0, pA1, t, true, true, true);     WAIT_BAR(3); RESC(); ROT();
        STEP(pA0, pA1, pB0, pB1, t + 1, true, true, true); WAIT_BAR(3); RESC(); ROT();
    }
#define ENDW(tt) do { if ((tt) + 3 < NT) { WAIT_BAR(3); } else if ((tt) + 2 < NT) { WAIT_BAR(2); } else { WAIT_BAR(0); } } while (0)
    for (; t + 1 < NT; t += 2) {
        STEP(pB0, pB1, pA0, pA1, t, (t + 3 < NT), (t + 1 < NT), (t + 1 < NT));       ENDW(t);     RESC(); ROT();
        STEP(pA0, pA1, pB0, pB1, t + 1, (t + 4 < NT), (t + 2 < NT), (t + 2 < NT));   ENDW(t + 1); RESC(); ROT();
    }
    STEP(pB0, pB1, pA0, pA1, NT - 1, false, false, false); RESC();
    { float sacc = pB0[0] + pB0[1]; _Pragma("unroll") for (int r = 2; r < 16; ++r) sacc += pB0[r]; _Pragma("unroll") for (int r = 0; r < 16; ++r) sacc += pB1[r]; l_reg += sacc;
      pw0 = (u32x4){PKW(pB0, 0), PKW(pB0, 2), PKW(pB0, 4), PKW(pB0, 6)}; pw1 = (u32x4){PKW(pB0, 8), PKW(pB0, 10), PKW(pB0, 12), PKW(pB0, 14)}; pw2 = (u32x4){PKW(pB1, 0), PKW(pB1, 2), PKW(pB1, 4), PKW(pB1, 6)}; pw3 = (u32x4){PKW(pB1, 8), PKW(pB1, 10), PKW(pB1, 12), PKW(pB1, 14)};
      SBAR(); pv(o, vb0 + 2 * sl_cur, PAF(0), PAF(1), PAF(2), PAF(3)); pv(o + 2, vb0 + 2 * sl_cur + 8192, PAF(0), PAF(1), PAF(2), PAF(3)); }
#undef PKW
#undef PAF
#undef VFR
#undef PIN
#undef MX3
#undef GAPA
#undef GAPB
#undef EX
#undef VRD
#undef KRD
#undef PVM
#undef STEP
#undef ENDW
    { auto rr = __builtin_amdgcn_permlane32_swap(__float_as_uint(l_reg), __float_as_uint(l_reg), false, false); l_reg = __uint_as_float(rr[0]) + __uint_as_float(rr[1]); }
    if (hi == 0) wsf[32 + r32] = l_reg;
    asm volatile("s_waitcnt lgkmcnt(0)\n\ts_barrier" ::: "memory");
    float rli[16];
#pragma unroll
    for (int r = 0; r < 16; ++r) rli[r] = __builtin_amdgcn_rcpf(wsf[32 + crow(r, hi)]);
    b_pair_epilogue(o, rli, m, lam, subln, Op + (long)(q0 + wid * QBLK) * OPITCH, shm, wid, lane, r32, hi);
#undef DMA_K
#undef DMA_V
#undef BCONST_T
#undef BIASADD
#undef RESC
#undef ROT
}
__device__ __forceinline__ void attn_unit_v128nm(const bf16* Qp, const bf16* __restrict__ Kp, const bf16* __restrict__ Vp, bf16* Op, int q0, float cL, float cR, int tabofs, int m, float lam, const float* subln, char* shm, int wv) {
    int tid_ = ltid(wv);
    const int tid = tid_, lane = tid & 63, r32 = lane & 31, hi = lane >> 5; const int wid = __builtin_amdgcn_readfirstlane(tid >> 6);
    const bf16* Qw = Qp + (long)(q0 + wid * QBLK) * PITCH;
    const unsigned lds0 = (unsigned)(uintptr_t)shm;
    float* wsf = (float*)(shm + V2_LDS_WS) + wid * 64;
    const bf16* ksrc = Kp + (long)lane * PITCH + wid * 8;
    const bf16* vsrc = Vp + (long)(16 * (wid & 3) + (lane >> 2)) * PITCH + (wid >> 2) * 32 + (lane & 3) * 8;
    const unsigned kdst = lds0 + LDS_K + wid * 1024, vdst = lds0 + V2_LDS_V + wid * 1024;
#define DMA_K(t, slot) glds16(ksrc + (long)(t) * KVBLK * PITCH, (unsigned)__builtin_amdgcn_readfirstlane(kdst + (slot)))
#define DMA_V(t, slot) do { glds16(vsrc + (long)(t) * KVBLK * PITCH, (unsigned)__builtin_amdgcn_readfirstlane(vdst + 2 * (slot))); \
                            glds16(vsrc + (long)(t) * KVBLK * PITCH + 64, (unsigned)__builtin_amdgcn_readfirstlane(vdst + 2 * (slot) + 8192)); } while (0)
    const int vb0 = (int)(lds0 + V2_LDS_V) + ((lane >> 4) & 1) * 32 + (lane & 3) * 8 + (4 * hi + ((lane & 15) >> 2)) * 64;
    const char* Kbase = shm + LDS_K; bf16x8 kf[8];
    const lds_cptr shm3 = (lds_cptr)shm; const lds_cptr kp0 = shm3 + LDS_K + hi * 1024 + r32 * 16; const lds_cptr vp0 = shm3 + V2_LDS_V + ((lane >> 4) & 1) * 32 + (lane & 3) * 8 + (4 * hi + ((lane & 15) >> 2)) * 64;
    const int q0w = q0 + wid * QBLK;
    const LAS float* tabl = (const LAS float*)(shm3 + tabofs) + (256 - r32 + 4 * hi);
#define BCONST_T(t) ((64 * (t) - q0w <= -160) ? cL : ((64 * (t) - q0w >= 128) ? cR : 0.f))
#define BIASADD(C0, C1, t) do { const int dk_ = 64 * (t) - q0w; if (dk_ >= -128 && dk_ <= 96) { const LAS float* tb_ = tabl + dk_; \
      _Pragma("unroll") for (int r = 0; r < 16; ++r) { C0[r] += tb_[(r & 3) + 8 * (r >> 2)]; C1[r] += tb_[(r & 3) + 8 * (r >> 2) + 32]; } } } while (0)
    DMA_K(0, 0); DMA_V(0, 0); DMA_K(1, SLOTB);
    bf16x8 qr[4];
#pragma unroll
    for (int d0 = 0; d0 < 4; ++d0) qr[d0] = *reinterpret_cast<const bf16x8*>(&Qw[(long)r32 * PITCH + d0 * 16 + hi * 8]);
    float l_reg = 0.f; f32x16 o[4]; o[0] = f32x16{}; o[1] = f32x16{}; o[2] = f32x16{}; o[3] = f32x16{};
    int bmode = (64 * 0 - q0w <= -160) ? 1 : ((64 * 0 - q0w >= 128) ? 2 : 0); f32x16 cbt;
    { const float c0_ = BCONST_T(0); _Pragma("unroll") for (int r = 0; r < 16; ++r) cbt[r] = c0_; } asm volatile("" : "+v"(cbt));
#define CB_UPD(tn) do { const int nm_ = (64 * (tn) - q0w <= -160) ? 1 : ((64 * (tn) - q0w >= 128) ? 2 : 0); if (nm_ != bmode) { bmode = nm_; const float c_ = BCONST_T(tn); \
      _Pragma("unroll") for (int r = 0; r < 16; ++r) cbt[r] = c_; asm volatile("" : "+v"(cbt)); } } while (0)
    f32x16 pA0, pA1, pB0, pB1;
    int sl_prev = 0, sl_cur = 0, sl_next = SLOTB;
#define ROT() do { sl_prev = sl_cur; sl_cur = sl_next; sl_next = (sl_next == (NSLOT - 1) * SLOTB) ? 0 : sl_next + SLOTB; } while (0)
    DMA_K(2, 2 * SLOTB);
    WAIT_BAR(4);
    qkt(pA0, pA1, Kbase, qr, cbt, r32, hi); asm volatile("s_nop 15\n\ts_nop 7" : "+v"(pA0), "+v"(pA1)); BIASADD(pA0, pA1, 0);
    _Pragma("unroll") for (int r = 0; r < 16; ++r) { pA0[r] = __builtin_amdgcn_exp2f(pA0[r]); pA1[r] = __builtin_amdgcn_exp2f(pA1[r]); }
    _Pragma("unroll") for (int r = 0; r < 16; ++r) { l_reg += pA0[r]; l_reg += pA1[r]; }
    WAIT_BAR(0);
    DMA_K(3, 0); DMA_V(1, SLOTB);
    ROT();
    kload8(kf, kp0 + sl_cur);
    CB_UPD(1);
    WAIT_BAR(3);
    s16x4 vlo[16], vhi[16]; u32x4 pw0, pw1, pw2, pw3;
#define PKW(P, B) cvtpk(P[B], P[B + 1])
#define PAF(k) __builtin_bit_cast(bf16x8, pw##k)
#define VFR(i) (bf16x8){vlo[i][0], vlo[i][1], vlo[i][2], vlo[i][3], vhi[i][0], vhi[i][1], vhi[i][2], vhi[i][3]}
#define PIN(x) asm volatile("" : "+v"(x))
#define MX3(a, b, c) __builtin_fmaxf(__builtin_fmaxf((a), (b)), (c))
#define GAPA(MF, W0, W1, PW) do { MF; W0; W1; PIN(PW); SBAR(); } while (0)
#define EX(v) __builtin_amdgcn_exp2f(v)
#define GAPB(MF, X, B, Y, BB) do { MF; X[B] = EX(X[B]); X[B + 1] = EX(X[B + 1]); sacc += Y[BB]; sacc += Y[BB + 1]; PIN(sacc); PIN(X); SBAR(); } while (0)
#define GAPB0(MF, X, B) do { MF; X[B] = EX(X[B]); X[B + 1] = EX(X[B + 1]); PIN(X); SBAR(); } while (0)
#define VRD(i) do { vlo[i] = vtr(vp_ + (((i) >> 2) * 4096 + ((i) & 3) * 1024)); vhi[i] = vtr(vp_ + (((i) >> 2) * 4096 + ((i) & 3) * 1024 + 512)); } while (0)
#define KRD(G, j) do { if (G) { kload2(kf, kp0 + sl_next, j); SBAR(); } } while (0)
#define PVM(d, k, i) o[d] = __builtin_amdgcn_mfma_f32_32x32x16_bf16(PAF(k), VFR(i), o[d], 0, 0, 0)
#define STEP(C0, C1, P0, P1, t, GK, GV, GL) do { SBAR(); \
    const lds_cptr vp_ = vp0 + 2 * sl_prev; \
    VRD(0); SBAR(); float sacc = 0.f; \
    GAPA(C0 = __builtin_amdgcn_mfma_f32_32x32x16_bf16(kf[0], qr[0], cbt, 0, 0, 0), pw0[0] = PKW(P0, 0), pw0[1] = PKW(P0, 2), pw0); \
    VRD(4); SBAR(); GAPA(C1 = __builtin_amdgcn_mfma_f32_32x32x16_bf16(kf[1], qr[0], cbt, 0, 0, 0), pw0[2] = PKW(P0, 4), pw0[3] = PKW(P0, 6), pw0); \
    VRD(1); SBAR(); GAPA(C0 = __builtin_amdgcn_mfma_f32_32x32x16_bf16(kf[2], qr[1], C0, 0, 0, 0),   pw1[0] = PKW(P0, 8), pw1[1] = PKW(P0, 10), pw1); \
    VRD(5); SBAR(); GAPA(C1 = __builtin_amdgcn_mfma_f32_32x32x16_bf16(kf[3], qr[1], C1, 0, 0, 0),   pw1[2] = PKW(P0, 12), pw1[3] = PKW(P0, 14), pw1); \
    VRD(2); SBAR(); GAPA(C0 = __builtin_amdgcn_mfma_f32_32x32x16_bf16(kf[4], qr[2], C0, 0, 0, 0),   pw2[0] = PKW(P1, 0), pw2[1] = PKW(P1, 2), pw2); \
    VRD(6); SBAR(); GAPA(C1 = __builtin_amdgcn_mfma_f32_32x32x16_bf16(kf[5], qr[2], C1, 0, 0, 0),   pw2[2] = PKW(P1, 4), pw2[3] = PKW(P1, 6), pw2); \
    VRD(3); SBAR(); GAPA(C0 = __builtin_amdgcn_mfma_f32_32x32x16_bf16(kf[6], qr[3], C0, 0, 0, 0),   pw3[0] = PKW(P1, 8), pw3[1] = PKW(P1, 10), pw3); \
    VRD(7); SBAR(); GAPA(C1 = __builtin_amdgcn_mfma_f32_32x32x16_bf16(kf[7], qr[3], C1, 0, 0, 0),   pw3[2] = PKW(P1, 12), pw3[3] = PKW(P1, 14), pw3); \
    if (GK) { DMA_K((t) + 3, sl_cur); } if (GV) { DMA_V((t) + 1, sl_next); } \
    BIASADD(C0, C1, t); \
    SBAR(); \
    GAPB0(PVM(0, 0, 0), C0, 0);  VRD(8);  SBAR(); \
    GAPB(PVM(1, 0, 4), C0, 2, C0, 0);  VRD(12); SBAR(); \
    GAPB(PVM(0, 1, 1), C0, 4, C0, 2);  VRD(9);  SBAR(); \
    GAPB(PVM(1, 1, 5), C0, 6, C0, 4);  VRD(13); SBAR(); \
    KRD(GL, 0); GAPB(PVM(0, 2, 2), C0, 8, C0, 6);  VRD(10); SBAR(); \
    GAPB(PVM(1, 2, 6), C0, 10, C0, 8); VRD(14); SBAR(); \
    KRD(GL, 1); GAPB(PVM(0, 3, 3), C0, 12, C0, 10); VRD(11); SBAR(); \
    GAPB(PVM(1, 3, 7), C0, 14, C0, 12); VRD(15); SBAR(); \
    KRD(GL, 2); GAPB(PVM(2, 0, 8), C1, 0, C0, 14); \
    GAPB(PVM(3, 0, 12), C1, 2, C1, 0); \
    KRD(GL, 3); GAPB(PVM(2, 1, 9), C1, 4, C1, 2); \
    GAPB(PVM(3, 1, 13), C1, 6, C1, 4); \
    GAPB(PVM(2, 2, 10), C1, 8, C1, 6); \
    GAPB(PVM(3, 2, 14), C1, 10, C1, 8); \
    GAPB(PVM(2, 3, 11), C1, 12, C1, 10); \
    GAPB(PVM(3, 3, 15), C1, 14, C1, 12); \
    sacc += C1[14]; sacc += C1[15]; l_reg += sacc; \
    } while (0)
    int t = 1;
    for (; t + 5 < NT; t += 2) {
        STEP(pB0, pB1, pA0, pA1, t, true, true, true);     WAIT_BAR(3); ROT(); CB_UPD(t + 1);
        STEP(pA0, pA1, pB0, pB1, t + 1, true, true, true); WAIT_BAR(3); ROT(); CB_UPD(t + 2);
    }
#define ENDW(tt) do { if ((tt) + 3 < NT) { WAIT_BAR(3); } else if ((tt) + 2 < NT) { WAIT_BAR(2); } else { WAIT_BAR(0); } } while (0)
    for (; t + 1 < NT; t += 2) {
        STEP(pB0, pB1, pA0, pA1, t, (t + 3 < NT), (t + 1 < NT), (t + 1 < NT));       ENDW(t);     ROT(); CB_UPD(t + 1);
        STEP(pA0, pA1, pB0, pB1, t + 1, (t + 4 < NT), (t + 2 < NT), (t + 2 < NT));   ENDW(t + 1); ROT(); CB_UPD(t + 2);
    }
    STEP(pB0, pB1, pA0, pA1, NT - 1, false, false, false);
    { pw0 = (u32x4){PKW(pB0, 0), PKW(pB0, 2), PKW(pB0, 4), PKW(pB0, 6)}; pw1 = (u32x4){PKW(pB0, 8), PKW(pB0, 10), PKW(pB0, 12), PKW(pB0, 14)}; pw2 = (u32x4){PKW(pB1, 0), PKW(pB1, 2), PKW(pB1, 4), PKW(pB1, 6)}; pw3 = (u32x4){PKW(pB1, 8), PKW(pB1, 10), PKW(pB1, 12), PKW(pB1, 14)};
      SBAR(); pv(o, vb0 + 2 * sl_cur, PAF(0), PAF(1), PAF(2), PAF(3)); pv(o + 2, vb0 + 2 * sl_cur + 8192, PAF(0), PAF(1), PAF(2), PAF(3)); }
#undef PKW
#undef PAF
#undef VFR
#undef PIN
#undef MX3
#undef GAPA
#undef GAPB
#undef GAPB0
#undef EX
#undef VRD
#undef KRD
#undef PVM
#undef STEP
#undef ENDW
    { auto rr = __builtin_amdgcn_permlane32_swap(__float_as_uint(l_reg), __float_as_uint(l_reg), false, false); l_reg = __uint_as_float(rr[0]) + __uint_as_float(rr[1]); }
    if (hi == 0) wsf[32 + r32] = l_reg;
    asm volatile("s_waitcnt lgkmcnt(0)\n\ts_barrier" ::: "memory");
    float rli[16];
#pragma unroll
    for (int r = 0; r < 16; ++r) rli[r] = __builtin_amdgcn_rcpf(wsf[32 + crow(r, hi)]);
    b_pair_epilogue(o, rli, m, lam, subln, Op + (long)(q0 + wid * QBLK) * OPITCH, shm, wid, lane, r32, hi);
#undef DMA_K
#undef DMA_V
#undef BCONST_T
#undef BIASADD
#undef CB_UPD
#undef ROT
}
#undef SBAR
#undef WAIT_BAR
}

__device__ __forceinline__ void p0_transpose_item(const float* W, int K, int N, bf16_t* WT, int k0, int n0, int rowbase, LAS float* scr, int lane) {
#pragma unroll 8
    for (int i = 0; i < 32; ++i) { const int kk = 2 * i + (lane >> 5); scr[kk * 33 + (lane & 31)] = __builtin_nontemporal_load(W + (size_t)(k0 + kk) * N + n0 + (lane & 31)); }
    LDS_WAIT(); asm volatile("" ::: "memory");
    const int c = lane & 7;
#pragma unroll
    for (int j = 0; j < 4; ++j) { const int n = (lane >> 3) + 8 * j; const LAS float* s = scr + (8 * c) * 33 + n;
        u32x4 o; o.x = cvtpk(s[0 * 33], s[1 * 33]); o.y = cvtpk(s[2 * 33], s[3 * 33]); o.z = cvtpk(s[4 * 33], s[5 * 33]); o.w = cvtpk(s[6 * 33], s[7 * 33]);
        *(u32x4*)(WT + (size_t)(rowbase + n) * K + k0 + 8 * c) = o; }
    LDS_WAIT(); asm volatile("" ::: "memory");
}
__device__ __forceinline__ void p0_transpose_item_q(const float* W, int K, int N, unsigned char* WT, int k0, int n0, int rowbase, LAS float* scr, int lane, float sc) {
#pragma unroll 8
    for (int i = 0; i < 32; ++i) { const int kk = 2 * i + (lane >> 5); scr[kk * 33 + (lane & 31)] = __builtin_nontemporal_load(W + (size_t)(k0 + kk) * N + n0 + (lane & 31)); }
    LDS_WAIT(); asm volatile("" ::: "memory");
    const int c = lane & 7;
#pragma unroll
    for (int j = 0; j < 4; ++j) { const int n = (lane >> 3) + 8 * j; const LAS float* s = scr + (8 * c) * 33 + n;
        u32x2 o; o.x = pk_fp8x4(s[0 * 33] * sc, s[1 * 33] * sc, s[2 * 33] * sc, s[3 * 33] * sc); o.y = pk_fp8x4(s[4 * 33] * sc, s[5 * 33] * sc, s[6 * 33] * sc, s[7 * 33] * sc);
        *(u32x2*)(WT + (size_t)(rowbase + n) * K + k0 + 8 * c) = o; }
    LDS_WAIT(); asm volatile("" ::: "memory");
}
constexpr int I_GU = 16 * 64, I_DN = 32 * 32, N_EXPERT_ITEMS = 16 * (2 * I_GU + I_DN);
struct XItem { const float* src; unsigned char* dst; int N, K; float sc; };
__device__ __forceinline__ XItem xitem(const Params& P, int r) {
    unsigned char* ws = P.ws; XItem x;
    if (r < 16 * I_GU) { const int e = r / I_GU, q = r % I_GU, kb = q / 64, n0 = (q % 64) * 32;
        x.src = P.w_gate + (size_t)e * 1024 * 2048 + (size_t)kb * 64 * 2048 + n0; x.dst = ws + WS_WGU + (size_t)e * 4096 * 1024 + (size_t)((n0 >> 7) * 256 + (n0 & 127)) * 1024 + kb * 64; x.N = 2048; x.K = 1024; x.sc = 32.f; return x; }
    r -= 16 * I_GU;
    if (r < 16 * I_GU) { const int e = r / I_GU, q = r % I_GU, kb = q / 64, n0 = (q % 64) * 32;
        x.src = P.w_up + (size_t)e * 1024 * 2048 + (size_t)kb * 64 * 2048 + n0; x.dst = ws + WS_WGU + (size_t)e * 4096 * 1024 + (size_t)((n0 >> 7) * 256 + 128 + (n0 & 127)) * 1024 + kb * 64; x.N = 2048; x.K = 1024; x.sc = 32.f; return x; }
    r -= 16 * I_GU;
    { const int e = r / I_DN, q = r % I_DN, kb = q / 32, n0 = (q % 32) * 32;
        x.src = P.w_down + (size_t)e * 2048 * 1024 + (size_t)kb * 64 * 1024 + n0; x.dst = ws + WS_WD + (size_t)e * 1024 * WDP + (size_t)n0 * WDP + kb * 64; x.N = 1024; x.K = WDP; x.sc = 64.f; return x; }
}
__device__ __forceinline__ void xitem_load(const XItem& x, f32x4 (&v)[8], int lane) {
    const float* p = x.src + (size_t)(lane >> 3) * x.N + (lane & 7) * 4;
#pragma unroll
    for (int i = 0; i < 8; ++i) v[i] = __builtin_nontemporal_load((const f32x4*)(p + (size_t)(8 * i) * x.N));
}
__device__ __forceinline__ void xitem_store(const XItem& x, const f32x4 (&v)[8], LAS float* scr, int lane) {
    LAS float* w = scr + (lane >> 3) * 33 + (lane & 7) * 4;
#pragma unroll
    for (int i = 0; i < 8; ++i) { w[(8 * i) * 33 + 0] = v[i][0]; w[(8 * i) * 33 + 1] = v[i][1]; w[(8 * i) * 33 + 2] = v[i][2]; w[(8 * i) * 33 + 3] = v[i][3]; }
    LDS_WAIT(); asm volatile("" ::: "memory");
    const int c = lane & 7; const float sc = x.sc;
#pragma unroll
    for (int j = 0; j < 4; ++j) { const int n = (lane >> 3) + 8 * j; const LAS float* s = scr + (8 * c) * 33 + n;
        u32x2 o; o.x = pk_fp8x4(s[0 * 33] * sc, s[1 * 33] * sc, s[2 * 33] * sc, s[3 * 33] * sc); o.y = pk_fp8x4(s[4 * 33] * sc, s[5 * 33] * sc, s[6 * 33] * sc, s[7 * 33] * sc);
        *(u32x2*)(x.dst + (size_t)n * x.K + 8 * c) = o; }
    LDS_WAIT(); asm volatile("" ::: "memory");
}
__device__ __forceinline__ void convert_expert_chunk(const Params& P, int first, int stride, int count, LAS float* scr, int lane) {
    f32x4 va[8], vb[8], vc[8];
    XItem xa = xitem(P, first), xb = xitem(P, first + stride), xc = xitem(P, first + 2 * stride);
    xitem_load(xa, va, lane); xitem_load(xb, vb, lane); xitem_load(xc, vc, lane);
#pragma unroll 1
    for (int j = 0; j < count; j += 3) {
        xitem_store(xa, va, scr, lane);
        if (j + 3 < count) { xa = xitem(P, first + (j + 3) * stride); xitem_load(xa, va, lane); }
        xitem_store(xb, vb, scr, lane);
        if (j + 4 < count) { xb = xitem(P, first + (j + 4) * stride); xitem_load(xb, vb, lane); }
        xitem_store(xc, vc, scr, lane);
        if (j + 5 < count) { xc = xitem(P, first + (j + 5) * stride); xitem_load(xc, vc, lane); }
    }
}
__device__ __forceinline__ void phase_prologue(const Params& P, LAS unsigned char* lds, int vcu, int G, int wv) {
    const int tid = ltid(wv), lane = tid & 63, wave = __builtin_amdgcn_readfirstlane(tid >> 6);
    unsigned char* ws = P.ws;
    LAS float* scr = (LAS float*)(lds + wave * 16384);
    const int gw = vcu * NWAVES + wave, NGW = G * NWAVES;
    constexpr int I_IN = 16 * 72, I_SQ = 16 * 32, I_PP = 4 * 32;
    const int NITEMS = I_IN + 2 * I_SQ + I_PP + (G == 256 ? 0 : N_EXPERT_ITEMS);
    for (int it = gw; it < NITEMS; it += NGW) {
        int r = it;
        if (r < I_IN) { const int nb = 72, kb = r / nb, n0 = (r % nb) * 32; p0_transpose_item(P.w_in, 1024, INW, (bf16_t*)(ws + WS_WIN), kb * 64, n0, n0, scr, lane); continue; } r -= I_IN;
        if (r < I_SQ) { const int kb = r / 32, n0 = (r % 32) * 32; p0_transpose_item(P.w_out, 1024, 1024, (bf16_t*)(ws + WS_WO), kb * 64, n0, n0, scr, lane); continue; } r -= I_SQ;
        if (r < I_SQ) { const int kb = r / 32, n0 = (r % 32) * 32; p0_transpose_item(P.w_pg, 1024, 1024, (bf16_t*)(ws + WS_WPG), kb * 64, n0, n0, scr, lane); continue; } r -= I_SQ;
        if (r < I_PP) { const int kb = r / 32, n0 = (r % 32) * 32; p0_transpose_item(P.w_pp, 256, 1024, (bf16_t*)(ws + WS_WPP), kb * 64, n0, n0, scr, lane); continue; } r -= I_PP;
        if (r < 16 * I_GU) { const int e = r / I_GU, q = r % I_GU, kb = q / 64, n0 = (q % 64) * 32;
            p0_transpose_item_q(P.w_gate + (size_t)e * 1024 * 2048, 1024, 2048, ws + WS_WGU + (size_t)e * 4096 * 1024, kb * 64, n0, (n0 >> 7) * 256 + (n0 & 127), scr, lane, 32.f); continue; } r -= 16 * I_GU;
        if (r < 16 * I_GU) { const int e = r / I_GU, q = r % I_GU, kb = q / 64, n0 = (q % 64) * 32;
            p0_transpose_item_q(P.w_up + (size_t)e * 1024 * 2048, 1024, 2048, ws + WS_WGU + (size_t)e * 4096 * 1024, kb * 64, n0, (n0 >> 7) * 256 + 128 + (n0 & 127), scr, lane, 32.f); continue; } r -= 16 * I_GU;
        { const int e = r / I_DN, q = r % I_DN, kb = q / 32, n0 = (q % 32) * 32;
            p0_transpose_item_q(P.w_down + (size_t)e * 2048 * 1024, WDP, 1024, ws + WS_WD + (size_t)e * 1024 * WDP, kb * 64, n0, n0, scr, lane, 64.f); }
    }
    const long gt = (long)vcu * 512 + tid, NTH = (long)G * 512;
    { const f32x4* src = (const f32x4*)P.x; u32x4* dst = (u32x4*)(ws + WS_RH);
      for (long i = gt; i < (long)MROWS * DMODEL / 8; i += NTH) { const f32x4 a = __builtin_nontemporal_load(src + 2 * i), b = __builtin_nontemporal_load(src + 2 * i + 1); u32x4 o; o.x = cvtpk(a[0], a[1]); o.y = cvtpk(a[2], a[3]); o.z = cvtpk(b[0], b[1]); o.w = cvtpk(b[2], b[3]); dst[i] = o; } }
    if (G != 256) { const f32x4* src = (const f32x4*)P.p; u32x4* dst = (u32x4*)(ws + WS_PB);
      for (long i = gt; i < (long)MROWS * PLE / 8; i += NTH) { const f32x4 a = __builtin_nontemporal_load(src + 2 * i), b = __builtin_nontemporal_load(src + 2 * i + 1); u32x4 o; o.x = cvtpk(a[0], a[1]); o.y = cvtpk(a[2], a[3]); o.z = cvtpk(b[0], b[1]); o.w = cvtpk(b[2], b[3]); dst[i] = o; } }
}

__device__ __forceinline__ void phase_qknorm_rope(const Params& P, LAS unsigned char* lds, int vcu, int G, int wv) {
    const int tid = ltid(wv);
    LAS f32x2* cs = (LAS f32x2*)lds;
    LAS float* gq = (LAS float*)(lds + 16384); LAS float* gk = gq + 64;
    for (int idx = tid; idx < 2048; idx += 512) { const int pos = idx >> 4, i = idx & 15; const float inv = powf(10000.f, -(float)(2 * i) / 32.f); const float ang = (float)pos * inv; cs[idx] = (f32x2){cosf(ang), sinf(ang)}; }
    if (tid < 64) { gq[tid] = P.a_q_norm[tid]; gk[tid] = P.a_k_norm[tid]; }
    __syncthreads();
    bf16_t* cols = (bf16_t*)(P.ws + WS_RH + 64 * MiB);
    const long NTH = (long)G * 512;
    for (long item = (long)vcu * 512 + tid; item < (long)MROWS * 10; item += NTH) {
        const int row = (int)(item / 10), head = (int)(item % 10);
        u32x4* ptr = (u32x4*)(cols + (size_t)row * INW + head * 64);
        float x[64]; float ss = 0.f;
#pragma unroll
        for (int c = 0; c < 8; ++c) { const u32x4 w = ptr[c];
            x[8 * c + 0] = bf_lo(w.x); x[8 * c + 1] = bf_hi(w.x); x[8 * c + 2] = bf_lo(w.y); x[8 * c + 3] = bf_hi(w.y);
            x[8 * c + 4] = bf_lo(w.z); x[8 * c + 5] = bf_hi(w.z); x[8 * c + 6] = bf_lo(w.w); x[8 * c + 7] = bf_hi(w.w); }
#pragma unroll
        for (int d = 0; d < 64; ++d) ss += x[d] * x[d];
        const float rinv = 1.0f / sqrtf(ss * (1.f / 64.f) + QK_EPS);
        const LAS float* g = head < 8 ? gq : gk;
#pragma unroll
        for (int d = 0; d < 64; ++d) x[d] = x[d] * rinv * g[d];
        const int t = row & (SEQ - 1), rp = t >> 6, cp = t & 63;
        const float sc = head < 8 ? C2 : 1.f;
#pragma unroll
        for (int i = 0; i < 16; ++i) {
            const f32x2 a = cs[rp * 16 + i], b = cs[cp * 16 + i];
            const float x1 = x[i], x2 = x[i + 16], y1 = x[32 + i], y2 = x[48 + i];
            x[i] = (x1 * a.x - x2 * a.y) * sc; x[i + 16] = (x2 * a.x + x1 * a.y) * sc;
            x[32 + i] = (y1 * b.x - y2 * b.y) * sc; x[48 + i] = (y2 * b.x + y1 * b.y) * sc;
        }
        const float s8 = head < 8 ? 16.f : 1.f;
        u32x2* q8 = head < 8 ? (u32x2*)((unsigned char*)P.out + OUT_Q8 + (size_t)row * 512 + head * 64) : (u32x2*)((unsigned char*)P.out + OUT_K8 + (size_t)row * 128 + (head - 8) * 64);
#pragma unroll
        for (int c = 0; c < 8; ++c) { u32x4 w; w.x = cvtpk(x[8 * c], x[8 * c + 1]); w.y = cvtpk(x[8 * c + 2], x[8 * c + 3]); w.z = cvtpk(x[8 * c + 4], x[8 * c + 5]); w.w = cvtpk(x[8 * c + 6], x[8 * c + 7]); ptr[c] = w;
            u32x2 e; e.x = pk_fp8x4(x[8 * c] * s8, x[8 * c + 1] * s8, x[8 * c + 2] * s8, x[8 * c + 3] * s8); e.y = pk_fp8x4(x[8 * c + 4] * s8, x[8 * c + 5] * s8, x[8 * c + 6] * s8, x[8 * c + 7] * s8); q8[c] = e;
            asm volatile("" ::: "memory"); }
    }
    __syncthreads();
    {
        const int tid2 = ltid(wv), lane = tid2 & 63, wave = wv;
        LAS unsigned char* tl = lds + wave * 4096;
        const int k5 = lane & 31, pk = 32 * ((k5 >> 2) & 1) + 16 * (lane >> 5) + (k5 & 3) + 4 * (k5 >> 3);
        for (int tile = vcu * NWAVES + wave; tile < BATCH * 2 * (SEQ / 64); tile += G * NWAVES) {
            const int b = tile >> 8, g = (tile >> 7) & 1, tt = tile & 127;
            const u32x4* vr = (const u32x4*)(cols + (size_t)(b * SEQ + tt * 64 + lane) * INW + COL_VA + g * 64);
#pragma unroll
            for (int c = 0; c < 8; ++c) { const u32x4 w = vr[c];
                const unsigned q0 = pk_fp8x4(bf_lo(w.x) * 4.f, bf_hi(w.x) * 4.f, bf_lo(w.y) * 4.f, bf_hi(w.y) * 4.f), q1 = pk_fp8x4(bf_lo(w.z) * 4.f, bf_hi(w.z) * 4.f, bf_lo(w.w) * 4.f, bf_hi(w.w) * 4.f);
#pragma unroll
                for (int j = 0; j < 4; ++j) { tl[(8 * c + j) * 64 + pk] = (unsigned char)(q0 >> (8 * j)); tl[(8 * c + 4 + j) * 64 + pk] = (unsigned char)(q1 >> (8 * j)); } }
            LDS_WAIT(); asm volatile("" ::: "memory");
            u32x4* dst = (u32x4*)((unsigned char*)P.out + OUT_VT8 + ((size_t)((b * 2 + g) * 64 + lane)) * SEQ + tt * 64);
#pragma unroll
            for (int c = 0; c < 4; ++c) dst[c] = *(const LAS u32x4*)(tl + lane * 64 + c * 16);
            LDS_WAIT(); asm volatile("" ::: "memory");
        }
    }
}

__device__ __forceinline__ void phase_attention(const Params& P, unsigned char* ldsg, int vcu, int G, int wv) {
    const int tid = ltid(wv);
    char* shm = (char*)ldsg;
    const attn_body::bf16* cols = (const attn_body::bf16*)(P.ws + WS_RH + 64 * MiB);
    attn_body::bf16* mix = (attn_body::bf16*)(P.ws + WS_R3);
    const float a_bound = 8.f * LOG2E * wave_max(fabsf(P.a_q_norm[tid & 63])) * wave_max(fabsf(P.a_k_norm[tid & 63])) * 1.02f;
    const bool a_bounded = a_bound < 64.f;
    const float a_negR = -fmaxf(a_bound - 8.f, 0.f);
    bool b_bounded;
    { const unsigned* bnd = (const unsigned*)P.ws + 3520;
      const float mq = __uint_as_float(__hip_atomic_load(bnd, __ATOMIC_RELAXED, __HIP_MEMORY_SCOPE_AGENT)), mk = __uint_as_float(__hip_atomic_load(bnd + 64, __ATOMIC_RELAXED, __HIP_MEMORY_SCOPE_AGENT));
      const float bmax = wave_max(fabsf(P.rel_bias[(tid & 63) * 2]) > fabsf(P.rel_bias[(tid & 63) * 2 + 1]) ? fabsf(P.rel_bias[(tid & 63) * 2]) : fabsf(P.rel_bias[(tid & 63) * 2 + 1])) * LOG2E;
      b_bounded = (2.f * sqrtf(mq * mk) + bmax) < 90.f; }
    const float lam = expf(wave_sum(P.lq1[tid & 63] * P.lk1[tid & 63])) - expf(wave_sum(P.lq2[tid & 63] * P.lk2[tid & 63])) + LAM_INIT;
    int ri = 0;
    for (int u = vcu; u < 1536; u += G, ++ri) {
        if (G == 256 && ri == (vcu & 3)) {
            const int lane_ = ltid(wv) & 63;
            LAS float* scr = (LAS float*)((LAS unsigned char*)(uintptr_t)(unsigned)(uintptr_t)shm + 65536 + wv * 8448);
            convert_expert_chunk(P, (vcu & 3) * (N_EXPERT_ITEMS / 4) + (vcu >> 2) * NWAVES + wv, 512, N_EXPERT_ITEMS / 4 / 512, scr, lane_);
            {
                const f32x4* src = (const f32x4*)P.p + 2 * ((long)vcu * 4096); u32x4* dst = (u32x4*)(P.ws + WS_PB) + (long)vcu * 4096; const int t_ = ltid(wv);
                f32x4 a[8], b2[8];
#pragma unroll
                for (int j = 0; j < 8; ++j) { a[j] = __builtin_nontemporal_load(src + 2 * (t_ + 512 * j)); b2[j] = __builtin_nontemporal_load(src + 2 * (t_ + 512 * j) + 1); }
#pragma unroll
                for (int j = 0; j < 8; ++j) { u32x4 o; o.x = cvtpk(a[j][0], a[j][1]); o.y = cvtpk(a[j][2], a[j][3]); o.z = cvtpk(b2[j][0], b2[j][1]); o.w = cvtpk(b2[j][2], b2[j][3]); dst[t_ + 512 * j] = o; }
            }
            __syncthreads();
        }
        const int i = u >> 8, v = u & 255, x = v >> 5, qb = v & 31, b = x >> 1;
        const attn_body::bf16* base = cols + (size_t)b * SEQ * INW;
        if (i < 4) { const int g = x & 1, h = g * 4 + i;
            if (a_bounded) attn_body::attn_unit_a8((const unsigned char*)P.out + OUT_Q8 + (size_t)b * SEQ * 512 + h * 64, (const unsigned char*)P.out + OUT_K8 + (size_t)b * SEQ * 128 + g * 64,
                                                   (const unsigned char*)P.out + OUT_VT8 + (size_t)((b * 2 + g) * 64) * SEQ, mix + (size_t)b * SEQ * DMODEL + h * 64, qb * 256, a_negR, shm, wv);
            else attn_body::attn_unit<8>(base + COL_QA + h * 64, base + COL_KA + g * 64, base + COL_VA + g * 64, mix + (size_t)b * SEQ * DMODEL + h * 64, qb * 256, shm, wv); }
        else { const int h = (x & 1) * 2 + (i - 4);
            {
                float* tab = (float*)(shm + attn_body::LDS_TAB);
                const int idx = tid, rel = idx - 256, n = rel < 0 ? -rel : rel;
                int bk = (n < 8) ? n : (2 + (31 - __builtin_clz((unsigned)(n * n)))); if (bk > 15) bk = 15;
                bk += (rel > 0) ? 16 : 0;
                tab[idx] = P.rel_bias[bk * 4 + h] * LOG2E;
                __syncthreads();
            }
            const float cL = P.rel_bias[15 * 4 + h] * LOG2E, cR = P.rel_bias[31 * 4 + h] * LOG2E;
            attn_body::bf16* Ob = mix + (size_t)b * SEQ * DMODEL + 512 + h * 128;
#pragma unroll 1
            for (int m = 0; m < 2; ++m) {
                if (b_bounded) attn_body::attn_unit_v128nm(base + COL_QB + (h * 2 + m) * 64, base + COL_KB + (h * 2 + m) * 64, base + COL_VB + h * 128, Ob, qb * 256, cL, cR, attn_body::LDS_TAB, m, lam, P.subln, shm, wv);
                else attn_body::attn_unit_v128<8>(base + COL_QB + (h * 2 + m) * 64, base + COL_KB + (h * 2 + m) * 64, base + COL_VB + h * 128, Ob, qb * 256, cL, cR, attn_body::LDS_TAB, m, lam, P.subln, shm, wv);
            }
        }
    }
}

__device__ __forceinline__ void ln_row(f32x4 (&v)[4], const float* g, const float* bta, int lane) {
    float s = 0.f;
#pragma unroll
    for (int j = 0; j < 4; ++j) s += (v[j][0] + v[j][1]) + (v[j][2] + v[j][3]);
    const float mean = wave_sum(s) * (1.f / DMODEL); float s2 = 0.f;
#pragma unroll
    for (int j = 0; j < 4; ++j) { v[j] = v[j] - mean; s2 += (v[j][0] * v[j][0] + v[j][1] * v[j][1]) + (v[j][2] * v[j][2] + v[j][3] * v[j][3]); }
    const float rstd = 1.0f / sqrtf(wave_sum(s2) * (1.f / DMODEL) + LN_EPS);
#pragma unroll
    for (int j = 0; j < 4; ++j) { const f32x4 gg = *(const f32x4*)(g + 256 * j + 4 * lane), bb = *(const f32x4*)(bta + 256 * j + 4 * lane); v[j] = v[j] * rstd * gg + bb; }
}
__device__ __forceinline__ void load_row_raw(const bf16_t* irow, u32x2 (&w)[4], int lane) {
#pragma unroll
    for (int j = 0; j < 4; ++j) w[j] = *(const u32x2*)(irow + 256 * j + 4 * lane);
}
__device__ __forceinline__ void cvt_row_raw(const u32x2 (&w)[4], f32x4 (&v)[4]) {
#pragma unroll
    for (int j = 0; j < 4; ++j) v[j] = (f32x4){bf_lo(w[j].x), bf_hi(w[j].x), bf_lo(w[j].y), bf_hi(w[j].y)};
}
__device__ __forceinline__ void load_row_bf16(const bf16_t* irow, f32x4 (&v)[4], int lane) {
#pragma unroll
    for (int j = 0; j < 4; ++j) { const u32x2 w = *(const u32x2*)(irow + 256 * j + 4 * lane); v[j] = (f32x4){bf_lo(w.x), bf_hi(w.x), bf_lo(w.y), bf_hi(w.y)}; }
}
__device__ __forceinline__ void store_row_bf16(bf16_t* orow, const f32x4 (&v)[4], int lane) {
#pragma unroll
    for (int j = 0; j < 4; ++j) { u32x2 w; w.x = cvtpk(v[j][0], v[j][1]); w.y = cvtpk(v[j][2], v[j][3]); *(u32x2*)(orow + 256 * j + 4 * lane) = w; }
}

__device__ __forceinline__ float router_reduce16(const f32x4 (&lgv)[4], int lane) {
    float b[8], c[4], d[2];
#pragma unroll
    for (int e = 0; e < 8; ++e) { auto rr = __builtin_amdgcn_permlane32_swap(__float_as_uint(lgv[e >> 2][e & 3]), __float_as_uint(lgv[2 + (e >> 2)][e & 3]), false, false); b[e] = __uint_as_float(rr[0]) + __uint_as_float(rr[1]); }
    const bool b4 = (lane & 16) != 0, b3 = (lane & 8) != 0, b2 = (lane & 4) != 0;
#pragma unroll
    for (int e = 0; e < 4; ++e) { const float keep = b4 ? b[e + 4] : b[e], send = b4 ? b[e] : b[e + 4]; c[e] = keep + swz_xor<16>(send); }
#pragma unroll
    for (int e = 0; e < 2; ++e) { const float keep = b3 ? c[e + 2] : c[e], send = b3 ? c[e] : c[e + 2]; d[e] = keep + swz_xor<8>(send); }
    float f; { const float keep = b2 ? d[1] : d[0], send = b2 ? d[0] : d[1]; f = keep + swz_xor<4>(send); }
    f += swz_xor<2>(f); f += swz_xor<1>(f);
    return f;
}
__device__ __forceinline__ void phase_ln1_router(const Params& P, LAS unsigned char* lds, int vcu, int G, int wv) {
    const int tid = ltid(wv), lane = tid & 63, wave = tid >> 6, r = lane & 15, g = lane >> 4;
    LAS u32x4* whi = (LAS u32x4*)lds; LAS u32x4* wlo = (LAS u32x4*)(lds + 32768);
    for (int i = tid; i < 2048; i += 512) { const int ks = i >> 6, ln = i & 63, e = ln & 15, gg = ln >> 4; float w[8]; unsigned hb[8], lb[8];
#pragma unroll
        for (int j = 0; j < 8; ++j) { w[j] = P.w_router[(size_t)(32 * ks + 8 * gg + j) * 16 + e]; }
#pragma unroll
        for (int j = 0; j < 8; j += 2) { const unsigned h2 = cvtpk(w[j], w[j + 1]); hb[j / 2] = h2; lb[j / 2] = cvtpk(w[j] - bf_lo(h2), w[j + 1] - bf_hi(h2)); }
        whi[i] = (u32x4){hb[0], hb[1], hb[2], hb[3]}; wlo[i] = (u32x4){lb[0], lb[1], lb[2], lb[3]}; }
    __syncthreads();
    float* aff = (float*)(P.ws + WS_AFF); bf16_t* x1b = (bf16_t*)(P.ws + WS_R3); unsigned char* x1q = (unsigned char*)P.out + 64 * MiB;
    const bf16_t* xb = (const bf16_t*)(P.ws + WS_RH); const bf16_t* mixo = (const bf16_t*)P.out;
    const int gw = vcu * NWAVES + wave, NGW = G * NWAVES;
    for (int tile = gw; tile < MROWS / 16; tile += NGW) {
        const size_t rowoff = (size_t)(tile * 16 + r) * DMODEL + 8 * g;
        float s1 = 0.f, s2 = 0.f;
#pragma unroll 8
        for (int ks = 0; ks < 32; ++ks) { const u32x4 a = *(const u32x4*)(xb + rowoff + 32 * ks), m = *(const u32x4*)(mixo + rowoff + 32 * ks);
            float y[8] = {bf_lo(a.x) * ALPHA + bf_lo(m.x), bf_hi(a.x) * ALPHA + bf_hi(m.x), bf_lo(a.y) * ALPHA + bf_lo(m.y), bf_hi(a.y) * ALPHA + bf_hi(m.y),
                          bf_lo(a.z) * ALPHA + bf_lo(m.z), bf_hi(a.z) * ALPHA + bf_hi(m.z), bf_lo(a.w) * ALPHA + bf_lo(m.w), bf_hi(a.w) * ALPHA + bf_hi(m.w)};
#pragma unroll
            for (int j = 0; j < 8; ++j) { s1 += y[j]; s2 += y[j] * y[j]; } }
        s1 += swz_xor<16>(s1); s2 += swz_xor<16>(s2);
        { auto rr = __builtin_amdgcn_permlane32_swap(__float_as_uint(s1), __float_as_uint(s1), false, false); s1 = __uint_as_float(rr[0]) + __uint_as_float(rr[1]); }
        { auto rr = __builtin_amdgcn_permlane32_swap(__float_as_uint(s2), __float_as_uint(s2), false, false); s2 = __uint_as_float(rr[0]) + __uint_as_float(rr[1]); }
        const float mean = s1 * (1.f / DMODEL); const float var = fmaxf(s2 * (1.f / DMODEL) - mean * mean, 0.f); const float rstd = 1.0f / sqrtf(var + LN_EPS);
        f32x4 acc = {0.f, 0.f, 0.f, 0.f};
#pragma unroll 4
        for (int ks = 0; ks < 32; ++ks) { const u32x4 a = *(const u32x4*)(xb + rowoff + 32 * ks), m = *(const u32x4*)(mixo + rowoff + 32 * ks);
            const f32x4 g0 = *(const f32x4*)(P.ln1_g + 32 * ks + 8 * g), g1 = *(const f32x4*)(P.ln1_g + 32 * ks + 8 * g + 4), b0 = *(const f32x4*)(P.ln1_b + 32 * ks + 8 * g), b1 = *(const f32x4*)(P.ln1_b + 32 * ks + 8 * g + 4);
            float x[8] = {bf_lo(a.x) * ALPHA + bf_lo(m.x), bf_hi(a.x) * ALPHA + bf_hi(m.x), bf_lo(a.y) * ALPHA + bf_lo(m.y), bf_hi(a.y) * ALPHA + bf_hi(m.y),
                          bf_lo(a.z) * ALPHA + bf_lo(m.z), bf_hi(a.z) * ALPHA + bf_hi(m.z), bf_lo(a.w) * ALPHA + bf_lo(m.w), bf_hi(a.w) * ALPHA + bf_hi(m.w)};
#pragma unroll
            for (int j = 0; j < 4; ++j) { x[j] = (x[j] - mean) * rstd * g0[j] + b0[j]; x[4 + j] = (x[4 + j] - mean) * rstd * g1[j] + b1[j]; }
            u32x4 hi, lo;
            hi.x = cvtpk(x[0], x[1]); hi.y = cvtpk(x[2], x[3]); hi.z = cvtpk(x[4], x[5]); hi.w = cvtpk(x[6], x[7]);
            lo.x = cvtpk(x[0] - bf_lo(hi.x), x[1] - bf_hi(hi.x)); lo.y = cvtpk(x[2] - bf_lo(hi.y), x[3] - bf_hi(hi.y)); lo.z = cvtpk(x[4] - bf_lo(hi.z), x[5] - bf_hi(hi.z)); lo.w = cvtpk(x[6] - bf_lo(hi.w), x[7] - bf_hi(hi.w));
            *(u32x4*)(x1b + rowoff + 32 * ks) = hi;
            { u32x2 qv; qv.x = pk_fp8x4(x[0], x[1], x[2], x[3]); qv.y = pk_fp8x4(x[4], x[5], x[6], x[7]); *(u32x2*)(x1q + rowoff + 32 * ks) = qv; }
            const bf16x8 ah = __builtin_bit_cast(bf16x8, hi), al = __builtin_bit_cast(bf16x8, lo);
            const bf16x8 wh = __builtin_bit_cast(bf16x8, whi[ks * 64 + lane]), wl = __builtin_bit_cast(bf16x8, wlo[ks * 64 + lane]);
            acc = __builtin_amdgcn_mfma_f32_16x16x32_bf16(ah, wh, acc, 0, 0, 0);
            acc = __builtin_amdgcn_mfma_f32_16x16x32_bf16(al, wh, acc, 0, 0, 0);
            acc = __builtin_amdgcn_mfma_f32_16x16x32_bf16(ah, wl, acc, 0, 0, 0); }
#pragma unroll
        for (int q = 0; q < 4; ++q) { float f = acc[q], mx = f;
            mx = fmaxf(mx, swz_xor<1>(mx)); mx = fmaxf(mx, swz_xor<2>(mx)); mx = fmaxf(mx, swz_xor<4>(mx)); mx = fmaxf(mx, swz_xor<8>(mx));
            const float pe = expf(f - mx); float sm = pe; sm += swz_xor<1>(sm); sm += swz_xor<2>(sm); sm += swz_xor<4>(sm); sm += swz_xor<8>(sm);
            aff[(size_t)(tile * 16 + 4 * g + q) * 16 + r] = pe / sm; }
    }
}

__device__ __forceinline__ void phase_topk(const Params& P, LAS unsigned char* lds, int blk, int G, int wv) {
    const int tid = ltid(wv), lane = tid & 63, wid = tid >> 6;
    LAS unsigned* cntb = (LAS unsigned*)lds;
    LAS unsigned* wtot = (LAS unsigned*)(lds + 256);
    const float* affp = (const float*)(P.ws + WS_AFF); int* slotmap = (int*)(P.ws + WS_SLOT); int* tok = (int*)(P.ws + WS_TOK); float* gate = (float*)(P.ws + WS_GATE);
    for (int item = blk; item < BATCH * NEXP; item += G) {
        const int b = item >> 4, e = item & 15;
        unsigned ku[16];
#pragma unroll
        for (int j = 0; j < 16; ++j) ku[j] = __float_as_uint(affp[((size_t)b * SEQ + tid + 512 * j) * 16 + e]);
        unsigned T = 0;
        {
            const unsigned cand = 1u << 30; unsigned c = 0;
#pragma unroll
            for (int j = 0; j < 16; ++j) c += (ku[j] >= cand) ? 1u : 0u;
            c = wave_sum_u(c);
            if (lane == 0) cntb[wid] = c;
            __syncthreads();
            unsigned tot = 0;
#pragma unroll
            for (int w = 0; w < 8; ++w) tot += cntb[w];
            if (tot >= (unsigned)CAP) T = cand;
        }
        for (int b0 = 28, it = 1; b0 >= 0; b0 -= 2, ++it) {
            const unsigned c1 = T | (1u << b0), c2 = T | (2u << b0), c3 = T | (3u << b0);
            unsigned n32 = 0, n1 = 0;
#pragma unroll
            for (int j = 0; j < 16; ++j) { n32 += ((ku[j] >= c3) ? 1u : 0u) + ((ku[j] >= c2) ? 0x10000u : 0u); n1 += (ku[j] >= c1) ? 1u : 0u; }
            n32 = wave_sum_u(n32); n1 = wave_sum_u(n1);
            const int par = it & 1;
            if (lane == 0) { cntb[par * 16 + wid] = n32; cntb[par * 16 + 8 + wid] = n1; }
            __syncthreads();
            unsigned t32 = 0, t1 = 0;
#pragma unroll
            for (int w = 0; w < 8; ++w) { t32 += cntb[par * 16 + w]; t1 += cntb[par * 16 + 8 + w]; }
            const unsigned t3 = t32 & 0xffffu, t2 = t32 >> 16;
            if (t3 >= (unsigned)CAP) T = c3; else if (t2 >= (unsigned)CAP) T = c2; else if (t1 >= (unsigned)CAP) T = c1;
        }
        __syncthreads();
        unsigned cg_ = 0;
#pragma unroll
        for (int j = 0; j < 16; ++j) cg_ += (ku[j] > T) ? 1u : 0u;
        cg_ = wave_sum_u(cg_);
        if (lane == 0) cntb[wid] = cg_;
        __syncthreads();
        unsigned ngt = 0;
#pragma unroll
        for (int w = 0; w < 8; ++w) ngt += cntb[w];
        const unsigned need_eq = (unsigned)CAP - ngt;
        unsigned selmask = 0;
        {
            unsigned below[16];
#pragma unroll
            for (int j = 0; j < 16; ++j) { const unsigned long long bal = __ballot(ku[j] == T); below[j] = __builtin_amdgcn_mbcnt_hi((unsigned)(bal >> 32), __builtin_amdgcn_mbcnt_lo((unsigned)bal, 0u)); if (lane == 0) wtot[j * 8 + wid] = (unsigned)__popcll(bal); }
            __syncthreads();
            unsigned run = 0;
#pragma unroll
            for (int j = 0; j < 16; ++j) { unsigned before = run;
#pragma unroll
                for (int w = 0; w < 8; ++w) { const unsigned c = wtot[j * 8 + w]; before += (w < wid) ? c : 0u; run += c; }
                const bool sel = (ku[j] > T) || ((ku[j] == T) && (before + below[j] < need_eq));
                selmask |= sel ? (1u << j) : 0u; }
            __syncthreads();
        }
        {
            unsigned below[16];
#pragma unroll
            for (int j = 0; j < 16; ++j) { const unsigned long long bal = __ballot((selmask >> j) & 1u); below[j] = __builtin_amdgcn_mbcnt_hi((unsigned)(bal >> 32), __builtin_amdgcn_mbcnt_lo((unsigned)bal, 0u)); if (lane == 0) wtot[j * 8 + wid] = (unsigned)__popcll(bal); }
            __syncthreads();
            unsigned run = 0;
#pragma unroll
            for (int j = 0; j < 16; ++j) { unsigned before = run;
#pragma unroll
                for (int w = 0; w < 8; ++w) { const unsigned c = wtot[j * 8 + w]; before += (w < wid) ? c : 0u; run += c; }
                const int t = tid + 512 * j; const bool sel = (selmask >> j) & 1u; const int slot = (int)(before + below[j]);
                slotmap[((size_t)b * SEQ + t) * 16 + e] = sel ? slot : -1;
                if (sel) { const int vr = (e * 4 + b) * CAP + slot; tok[vr] = b * SEQ + t; gate[vr] = __uint_as_float(ku[j]); } }
            __syncthreads();
        }
    }
}

__device__ __forceinline__ void phase_combine_ln2(const Params& P, int vcu, int G, int wv) {
    const int tid = ltid(wv), lane = tid & 63, wave = tid >> 6;
    const int* slotmap = (const int*)(P.ws + WS_SLOT); const bf16_t* ye = (const bf16_t*)(P.ws + WS_WGU); bf16_t* x2b = (bf16_t*)(P.ws + WS_R3);
    const int gw = vcu * NWAVES + wave, NGW = G * NWAVES;
    for (int row = gw; row < MROWS; row += NGW) {
        bf16_t* xr = x2b + (size_t)row * DMODEL; const int b = row >> 13;
        f32x4 v[4];
        load_row_bf16(xr, v, lane);
#pragma unroll
        for (int j = 0; j < 4; ++j) v[j] = v[j] * ALPHA;
        const int sl = slotmap[(size_t)row * 16 + (lane & 15)];
        unsigned long long m = __ballot(sl >= 0) & 0xffffull;
        while (m) { const int e = __builtin_ctzll(m); m &= m - 1; const int s = __builtin_amdgcn_readlane(sl, e);
            const bf16_t* yr = ye + (size_t)((e * 4 + b) * CAP + s) * DMODEL;
#pragma unroll
            for (int j = 0; j < 4; ++j) { const u32x2 w = *(const u32x2*)(yr + 256 * j + 4 * lane); v[j][0] += bf_lo(w.x); v[j][1] += bf_hi(w.x); v[j][2] += bf_lo(w.y); v[j][3] += bf_hi(w.y); } }
        ln_row(v, P.ln2_g, P.ln2_b, lane);
        store_row_bf16(xr, v, lane);
    }
}
__device__ __forceinline__ void phase_ln3(const Params& P, int vcu, int G, int wv) {
    const int tid = ltid(wv), lane = tid & 63, wave = tid >> 6;
    const bf16_t* y3 = (const bf16_t*)(P.ws + WS_RH + 64 * MiB);
    const int gw = vcu * NWAVES + wave, NGW = G * NWAVES;
    for (int row = gw; row < MROWS; row += NGW) {
        float* xr = P.out + (size_t)row * DMODEL; f32x4 v[4];
        load_row_bf16(y3 + (size_t)row * DMODEL, v, lane);
        ln_row(v, P.ln3_g, P.ln3_b, lane);
#pragma unroll
        for (int j = 0; j < 4; ++j) __builtin_nontemporal_store(v[j], (f32x4*)(xr + 256 * j + 4 * lane));
    }
}

#define XB_TMO      128
#define XB_XCNT(j)  (256  + 64 * (j))
#define XB_XSUB(j)  (1280 + 64 * (j))
#define XB_XGEN(j)  (2304 + 64 * (j))
#define XB_TOP      3328
#define XB_TOPGEN   3392
#define XCD_BAR_WORDS 3456
#define XB_SPIN_CAP (1u << 22)
__device__ __forceinline__ unsigned xb_ld(unsigned* p)              { return __hip_atomic_load(p, __ATOMIC_RELAXED, __HIP_MEMORY_SCOPE_AGENT); }
__device__ __forceinline__ unsigned xb_add(unsigned* p, unsigned v) { return __hip_atomic_fetch_add(p, v, __ATOMIC_RELAXED, __HIP_MEMORY_SCOPE_AGENT); }
__device__ __forceinline__ unsigned xb_xcc_id() { return (unsigned)__builtin_amdgcn_s_getreg((3 << 11) | 20) & 0xFu; }
#define XB_SPIN(cond, bar) do { unsigned _sp = 0; while (cond) { __builtin_amdgcn_s_sleep(1); \
    if ((++_sp & 255u) == 0u) { if (xb_ld(&(bar)[XB_TMO])) break; if (_sp > XB_SPIN_CAP) { atomicAdd(&(bar)[XB_TMO], 1u); break; } } } } while (0)
struct XcdBarrier { unsigned* bar; unsigned x; volatile LAS unsigned* st; };
__device__ __forceinline__ XcdBarrier xcd_barrier_post(unsigned* bar, volatile LAS unsigned* st, int wv) {
    XcdBarrier b; b.bar = bar; b.x = xb_xcc_id(); b.st = st;
    if (ltid(wv) == 0) (void)xb_add(&bar[XB_XCNT(b.x)], 1u);
    return b;
}
__device__ __forceinline__ void xcd_barrier_complete(unsigned* bar, unsigned x, unsigned& nloc, unsigned& nx) {
    const unsigned G = gridDim.x * gridDim.y * gridDim.z;
    unsigned sum, cnt, mine, sp = 0u;
    for (;;) {
        sum = 0u; cnt = 0u; mine = 0u;
#pragma unroll
        for (unsigned j = 0; j < 16; ++j) { const unsigned c = xb_ld(&bar[XB_XCNT(j)]); sum += c; cnt += (c > 0u) ? 1u : 0u; mine = (j == x) ? c : mine; }
        if (sum == G) break;
        __builtin_amdgcn_s_sleep(1);
        if ((++sp & 255u) == 0u) { if (xb_ld(&bar[XB_TMO])) break; if (sp > XB_SPIN_CAP) { atomicAdd(&bar[XB_TMO], 1u); break; } }
    }
    nloc = mine > 0u ? mine : 1u; nx = cnt > 0u ? cnt : 1u;
}
__device__ __forceinline__ void xcd_barrier(const XcdBarrier& b, int wv) {
    asm volatile("s_waitcnt vmcnt(0)" ::: "memory");
    __syncthreads();
    if (ltid(wv) == 0) {
        unsigned* bar = b.bar;
        __builtin_amdgcn_s_waitcnt(0);
        unsigned nloc = b.st[0], nx = b.st[1];
        if (nloc == 0u) { xcd_barrier_complete(bar, b.x, nloc, nx); b.st[0] = nloc; b.st[1] = nx; }
        const unsigned old = xb_add(&bar[XB_XSUB(b.x)], 1u);
        const unsigned gen = old / nloc;
        if (old + 1u == (gen + 1u) * nloc) {
            __builtin_amdgcn_fence(__ATOMIC_RELEASE, "agent");
            asm volatile("s_waitcnt vmcnt(0)" ::: "memory");
            const unsigned og = xb_add(&bar[XB_TOP], 1u);
            const unsigned tg = og / nx;
            if (og + 1u == (tg + 1u) * nx) xb_add(&bar[XB_TOPGEN], 1u);
            else XB_SPIN(xb_ld(&bar[XB_TOPGEN]) == tg, bar);
            __builtin_amdgcn_fence(__ATOMIC_ACQUIRE, "agent");
            xb_add(&bar[XB_XGEN(b.x)], 1u);
            asm volatile("s_waitcnt vmcnt(0)" ::: "memory");
        } else {
            XB_SPIN(xb_ld(&bar[XB_XGEN(b.x)]) == gen, bar);
            __builtin_amdgcn_fence(__ATOMIC_ACQUIRE, "agent");
            asm volatile("s_waitcnt vmcnt(0)" ::: "memory");
        }
    }
    __syncthreads();
}

#ifndef MK_PH_LO
#define MK_PH_LO 0
#endif
#ifndef MK_PH_HI
#define MK_PH_HI 13
#endif
__global__ void __launch_bounds__(NWAVES * 64, 2) fwd_megakernel(Params P) {
    extern __shared__ __attribute__((aligned(16))) unsigned char lds[];
    LAS unsigned char* ldsl = (LAS unsigned char*)lds;
    const int G = gridDim.x, bx = blockIdx.x;
    const int wv = __builtin_amdgcn_readfirstlane((int)(threadIdx.x >> 6));
    const int vcu = (G % 8 == 0) ? (bx % 8) * (G / 8) + bx / 8 : bx;
    unsigned char* ws = P.ws;
    bf16_t* XB = (bf16_t*)(ws + WS_RH); bf16_t* COLS = (bf16_t*)(ws + WS_RH + 64 * MiB); bf16_t* HB = (bf16_t*)(ws + WS_RH); bf16_t* PJ = (bf16_t*)P.out;
    bf16_t* R3 = (bf16_t*)(ws + WS_R3); bf16_t* YE = (bf16_t*)(ws + WS_WGU);
#define PH(k) ((k) >= MK_PH_LO && (k) < MK_PH_HI)
    unsigned* barw = (unsigned*)ws;
    volatile LAS unsigned* bst = (volatile LAS unsigned*)(ldsl + 143360);
    if (ltid(wv) < 2) bst[ltid(wv)] = 0u;
    __syncthreads();
    const XcdBarrier xbar = xcd_barrier_post(barw, bst, wv);
    if (PH(0)) { phase_prologue(P, ldsl, vcu, G, wv); }
    xcd_barrier(xbar, wv);
#define GRID_BAR() xcd_barrier(xbar, wv)
    const bool split_qkv = (G >= 256);
    if (PH(1)) { pg8::ProbPlain S; S.K = 1024; S.ord.init(MROWS / 256, split_qkv ? 8 : INW / 256, G, bx); S.A = (const char*)XB; S.Bt = (const char*)(ws + WS_WIN);
        pg8::EpiQKV E{COLS, (unsigned*)ws + 3520}; pg8::gemm_phase<pg8::ProbPlain, pg8::EpiQKV, true>(ldsl, S, E, wv); }
    GRID_BAR();
    if (PH(2)) {
        if (split_qkv) {
            if (bx < 128) { pg8::ProbPlain S; S.K = 1024; S.ord.init(MROWS / 256, 1, 128, bx, 8); S.A = (const char*)XB; S.Bt = (const char*)(ws + WS_WIN);
                pg8::EpiQKV E{COLS, (unsigned*)ws + 3520}; pg8::gemm_phase<pg8::ProbPlain, pg8::EpiQKV, true>(ldsl, S, E, wv); }
            else phase_qknorm_rope(P, ldsl, bx - 128, G - 128, wv);
        } else phase_qknorm_rope(P, ldsl, vcu, G, wv);
    }
    GRID_BAR();
    if (PH(3)) { phase_attention(P, lds, vcu, G, wv); }
    GRID_BAR();
    if (PH(5)) { pg8::ProbPlain S; S.K = 1024; S.ord.init(MROWS / 256, DMODEL / 256, G, bx); S.A = (const char*)R3; S.Bt = (const char*)(ws + WS_WO);
        pg8::EpiBf16Plain E{(bf16_t*)P.out, DMODEL}; pg8::gemm_phase<pg8::ProbPlain, pg8::EpiBf16Plain, true>(ldsl, S, E, wv); }
    GRID_BAR();
    if (PH(6)) { phase_ln1_router(P, ldsl, vcu, G, wv); }
    GRID_BAR();
    if (PH(7)) {
        if (G >= 128) {
            if (bx < 64) phase_topk(P, ldsl, bx, 64, wv);
            else { pg8::ProbPlain S; S.K = PLE; S.ord.init(MROWS / 256, DMODEL / 256, G - 64, bx - 64); S.A = (const char*)(ws + WS_PB); S.Bt = (const char*)(ws + WS_WPP);
                pg8::EpiBf16Plain E{PJ, DMODEL}; pg8::gemm_phase<pg8::ProbPlain, pg8::EpiBf16Plain, true>(ldsl, S, E, wv); }
        } else {
            phase_topk(P, ldsl, bx, G, wv); __syncthreads();
            pg8::ProbPlain S; S.K = PLE; S.ord.init(MROWS / 256, DMODEL / 256, G, bx); S.A = (const char*)(ws + WS_PB); S.Bt = (const char*)(ws + WS_WPP);
            pg8::EpiBf16Plain E{PJ, DMODEL}; pg8::gemm_phase<pg8::ProbPlain, pg8::EpiBf16Plain, true>(ldsl, S, E, wv);
        }
    }
    GRID_BAR();
    if (PH(8)) { pg8::ProbExpertGatherQ S; S.K = 512; S.scale_a = 0x7F7F7F7F; S.scale_b = 0x7A7A7A7A; S.ord.init(VROWS / 256, 16, G, bx); S.A = (const char*)((unsigned char*)P.out + 64 * MiB); S.Bt = (const char*)(ws + WS_WGU); S.tok = (const int*)(ws + WS_TOK);
        pg8::EpiSwiGLU E{(unsigned char*)HB}; pg8::gemm_phase_q<pg8::ProbExpertGatherQ, pg8::EpiSwiGLU, true>(ldsl, S, E, wv); }
    GRID_BAR();
    if (PH(9)) { pg8::ProbExpertDownQ S; S.K = 1024; S.scale_a = 0x7B7B7B7B; S.scale_b = 0x79797979; S.ord.init(VROWS / 256, 4, G, bx); S.A = (const char*)HB; S.Bt = (const char*)(ws + WS_WD);
        pg8::EpiDown E{YE, (const float*)(ws + WS_GATE)}; pg8::gemm_phase_q<pg8::ProbExpertDownQ, pg8::EpiDown, true>(ldsl, S, E, wv); }
    GRID_BAR();
    if (PH(10)) { phase_combine_ln2(P, vcu, G, wv); }
    GRID_BAR();
    if (PH(11)) { pg8::ProbPlain S; S.K = 1024; S.ord.init(MROWS / 256, DMODEL / 256, G, bx); S.A = (const char*)R3; S.Bt = (const char*)(ws + WS_WPG);
        pg8::EpiPLE E{R3, PJ, (bf16_t*)(ws + WS_RH + 64 * MiB)}; pg8::gemm_phase<pg8::ProbPlain, pg8::EpiPLE, true>(ldsl, S, E, wv); }
    GRID_BAR();
    if (PH(12)) { phase_ln3(P, vcu, G, wv); }
#undef PH
}

extern "C" void kernel_launch(void* const* d_in, const int* in_sizes, int n_in, void* d_out, int out_size, void* d_ws, size_t ws_size, hipStream_t stream) {
    static int grid = 0;
    if (grid == 0) {
        if (n_in != 24 || out_size != MROWS * DMODEL || ws_size < WS_END) { fprintf(stderr, "kernel_launch: unexpected shapes (n_in %d, out %d, ws %zu < %zu); nothing launched\n", n_in, out_size, ws_size, (size_t)WS_END); grid = -1; return; }
        int dev = 0, cus = 0, per_cu = 0;
        hipGetDevice(&dev); hipDeviceGetAttribute(&cus, hipDeviceAttributeMultiprocessorCount, dev);
        hipFuncSetAttribute((const void*)fwd_megakernel, hipFuncAttributeMaxDynamicSharedMemorySize, LDS_BYTES);
        hipOccupancyMaxActiveBlocksPerMultiprocessor(&per_cu, (const void*)fwd_megakernel, NWAVES * 64, LDS_BYTES);
        (void)hipGetLastError();
        if (per_cu < 1) { fprintf(stderr, "kernel_launch: occupancy query reports %d blocks per CU\n", per_cu); grid = -1; return; }
        grid = cus;
    }
    if (grid < 0) return;
    if (hipMemsetAsync(d_ws, 0, 16384, stream) != hipSuccess) { fprintf(stderr, "kernel_launch: memset of the barrier words failed\n"); return; }
    Params p{};
    const float** f = (const float**)&p;
    for (int i = 0; i < 24; ++i) f[i] = (const float*)d_in[i];
    p.out = (float*)d_out; p.ws = (unsigned char*)d_ws;
    void* args[] = {&p};
    hipError_t e = hipLaunchCooperativeKernel((const void*)fwd_megakernel, dim3(grid), dim3(NWAVES * 64), args, LDS_BYTES, stream);
    if (e != hipSuccess) fprintf(stderr, "kernel_launch: cooperative launch failed: %s (grid %d)\n", hipGetErrorString(e), grid);
}
```

```cpp
#include <hip/hip_runtime.h>
#include <hip/hip_cooperative_groups.h>
#include <hip/hip_bf16.h>
#include <cstdio>
#include <cstdint>
#include <cmath>
namespace cg = cooperative_groups;

#define LAS __attribute__((address_space(3)))
typedef unsigned short bf16_t;
typedef short bf16x8 __attribute__((ext_vector_type(8)));
typedef float f32x4 __attribute__((ext_vector_type(4)));
typedef float f32x2 __attribute__((ext_vector_type(2)));
typedef unsigned u32x4 __attribute__((ext_vector_type(4)));
typedef unsigned u32x2 __attribute__((ext_vector_type(2)));
typedef __bf16 bf16x2_t __attribute__((ext_vector_type(2)));
typedef int v8i32 __attribute__((ext_vector_type(8)));

constexpr int BATCH = 4, SEQ = 8192, DMODEL = 1024, MROWS = BATCH * SEQ;
constexpr int INW = 2304, NEXP = 16, CAP = 1024, DEXP = 2048, PLE = 256;
constexpr int XBP = 1024 + 64;
constexpr int HP = DEXP + 128, WDP = DEXP + 128;
constexpr int VROWS = BATCH * NEXP * CAP;
constexpr float ALPHA = 1.189207115002721f, LN_EPS = 1e-5f, QK_EPS = 1e-6f;
constexpr float LOG2E = 1.4426950408889634f, C2 = 0.125f * LOG2E;
constexpr float LAM_INIT = 0.2f;
constexpr int COL_QA = 0, COL_KA = 512, COL_VA = 640, COL_QB = 768, COL_KB = 1280, COL_VB = 1792;

constexpr size_t MiB = 1u << 20;
constexpr size_t WS_AFF = 1 * MiB, WS_SLOT = 3 * MiB, WS_TOK = 5 * MiB, WS_GATE = 5 * MiB + 512 * 1024;
constexpr size_t WS_WIN = 8 * MiB, WS_WO = 13 * MiB, WS_WPG = 15 * MiB, WS_WPP = 17 * MiB;
constexpr size_t WS_WGU = 18 * MiB;
constexpr size_t WS_WD = 146 * MiB;
constexpr size_t WS_RH = 210 * MiB;
constexpr size_t WS_R3 = 466 * MiB;
constexpr size_t WS_PB = 530 * MiB;
constexpr size_t WS_END = 546 * MiB;
constexpr size_t COLS_OFF = 72 * MiB;

constexpr size_t OUT_Q8 = 0, OUT_K8 = 16 * MiB, OUT_VT8 = 20 * MiB;
constexpr int LDS_BYTES = 147456;
constexpr int NWAVES = 8;

struct Params {
    const float *x, *p, *w_in, *w_out, *a_q_norm, *a_k_norm, *lq1, *lk1, *lq2, *lk2, *subln, *rel_bias, *ln1_g, *ln1_b, *w_router,
                *w_gate, *w_up, *w_down, *ln2_g, *ln2_b, *w_pg, *w_pp, *ln3_g, *ln3_b;
    float* out; unsigned char* ws;
};

__device__ __forceinline__ unsigned cvtpk(float lo, float hi) { f32x2 v = {lo, hi}; bf16x2_t b = __builtin_convertvector(v, bf16x2_t); return __builtin_bit_cast(unsigned, b); }
__device__ __forceinline__ float bf_lo(unsigned w) { return __uint_as_float(w << 16); }
__device__ __forceinline__ float bf_hi(unsigned w) { return __uint_as_float(w & 0xffff0000u); }
template <int O> __device__ __forceinline__ float swz_xor(float v) { return __int_as_float(__builtin_amdgcn_ds_swizzle(__float_as_int(v), (O << 10) | 0x1f)); }
template <int O> __device__ __forceinline__ unsigned swz_xor_u(unsigned v) { return (unsigned)__builtin_amdgcn_ds_swizzle((int)v, (O << 10) | 0x1f); }
__device__ __forceinline__ float wave_sum(float v) {
    v += swz_xor<1>(v); v += swz_xor<2>(v); v += swz_xor<4>(v); v += swz_xor<8>(v); v += swz_xor<16>(v);
    auto rr = __builtin_amdgcn_permlane32_swap(__float_as_uint(v), __float_as_uint(v), false, false);
    return __uint_as_float(rr[0]) + __uint_as_float(rr[1]);
}
__device__ __forceinline__ float wave_max(float v) {
    v = fmaxf(v, swz_xor<1>(v)); v = fmaxf(v, swz_xor<2>(v)); v = fmaxf(v, swz_xor<4>(v)); v = fmaxf(v, swz_xor<8>(v)); v = fmaxf(v, swz_xor<16>(v));
    auto rr = __builtin_amdgcn_permlane32_swap(__float_as_uint(v), __float_as_uint(v), false, false);
    return fmaxf(__uint_as_float(rr[0]), __uint_as_float(rr[1]));
}
__device__ __forceinline__ unsigned wave_sum_u(unsigned v) {
    v += swz_xor_u<1>(v); v += swz_xor_u<2>(v); v += swz_xor_u<4>(v); v += swz_xor_u<8>(v); v += swz_xor_u<16>(v);
    auto rr = __builtin_amdgcn_permlane32_swap(v, v, false, false);
    return rr[0] + rr[1];
}
__device__ __forceinline__ unsigned pk_fp8x4(float a, float b, float c, float d) { int p = __builtin_amdgcn_cvt_pk_fp8_f32(a, b, 0, false); p = __builtin_amdgcn_cvt_pk_fp8_f32(c, d, p, true); return (unsigned)p; }
#define LDS_WAIT() asm volatile("s_waitcnt lgkmcnt(0)" ::: "memory")
__device__ __forceinline__ int ltid(int wv) { int l; asm volatile("v_mbcnt_lo_u32_b32 %0, -1, 0\n\tv_mbcnt_hi_u32_b32 %0, -1, %0" : "=v"(l)); return (wv << 6) | l; }

namespace pg8 {
constexpr int BM = 256, BK = 64, HALF = 128, HTB = HALF * BK * 2, STAGE_BYTES = 8 * HTB, NXCD = 8, WGM = 8;
__host__ __device__ __forceinline__ int lds_byte(int r, int c) { const int st = (r >> 4) * 2 + (c >> 5), rr = r & 15, cc = c & 31, ob = rr * 64 + cc * 2; return st * 1024 + (ob ^ (((ob >> 9) & 1) << 5)); }
__host__ __device__ __forceinline__ void stage_rc(int b, int& R, int& C) { const int st = b / 1024, sb = b % 1024, swz = sb ^ (((sb >> 9) & 1) << 5); R = (st >> 1) * 16 + swz / 64; C = (st & 1) * 32 + (swz % 64) / 2; }
__host__ __device__ __forceinline__ int perm32(int rho) { const int n = rho >> 4, i = rho & 15; return 8 * (i >> 2) + 4 * n + (i & 3); }
struct Unit { int pm, pn; };
struct Order {
    int nM, nN, nwg, G, c, pn0;
    __device__ __forceinline__ void init(int nM_, int nN_, int G_, int c_, int pn0_ = 0) { nM = nM_; nN = nN_; nwg = nM * nN; G = G_; c = c_; pn0 = pn0_; }
    __device__ __forceinline__ bool next(int i, Unit& u) const {
        const long L = (long)i * G + c; if (L >= nwg) return false;
        int wgid = (int)L; { const int q = nwg / NXCD, r = nwg % NXCD, xcd = wgid % NXCD, off = wgid / NXCD; wgid = (xcd < r ? xcd * (q + 1) : r * (q + 1) + (xcd - r) * q) + off; }
        const int nig = WGM * nN, gid = wgid / nig, fm = gid * WGM, gsz = (nM - fm) < WGM ? (nM - fm) : WGM;
        u.pm = fm + ((wgid % nig) % gsz); u.pn = pn0 + (wgid % nig) / gsz; return true;
    }
};
template <class Prob, class Epi, bool ALIGN_EPI>
__device__ __forceinline__ void gemm_phase(LAS unsigned char* lds, const Prob& S, const Epi& E, int wv) {
    int tid_ = ltid(wv);
    const int tid = tid_, wid = __builtin_amdgcn_readfirstlane(tid >> 6), lane = tid & 63, wr = wid >> 2, wc = wid & 3, fr = lane & 15, fq = lane >> 4;
    const int K = S.K, nt = K / BK;
    int Rr[2], Cc[2]; unsigned voffB[2];
#pragma unroll
    for (int i = 0; i < 2; ++i) { int R, C; stage_rc(tid * 16 + i * 8192, R, C); Rr[i] = R; Cc[i] = C; const int Rb = Epi::PERM ? ((R & ~31) + perm32(R & 31)) : R; voffB[i] = (unsigned)(Rb * K + C) * 2u; }
    const size_t kstep = (size_t)(BK * 2);
    const size_t hstepB = (size_t)HALF * K * 2;
    const unsigned ldsw = (unsigned)wid * 1024u;
    const int aoff = lds_byte(wr * 64 + fr, fq * 8), boff = lds_byte(wc * 32 + fr, fq * 8);
#define PG8_SA(b, h) (((b) * 2 + (h)) * HTB)
#define PG8_SB(b, h) ((4 + (b) * 2 + (h)) * HTB)
#define PG8_STAGEB(bufoff, gbase, voff) do { _Pragma("unroll") for (int _i = 0; _i < 2; ++_i) \
        __builtin_amdgcn_global_load_lds((const unsigned*)((const char*)(gbase) + (voff)[_i]), (LAS unsigned*)(lds + (bufoff) + ldsw + _i * 8192), 16, 0, 0); } while (0)
#define PG8_STAGEA(bufoff, kb, OFFh) do { _Pragma("unroll") for (int _i = 0; _i < 2; ++_i) \
        __builtin_amdgcn_global_load_lds((const unsigned*)(Ab + (kb) + (OFFh)[_i]), (LAS unsigned*)(lds + (bufoff) + ldsw + _i * 8192), 16, 0, 0); } while (0)
#define PG8_LDA(dst, b, h) do { _Pragma("unroll") for (int m = 0; m < 4; ++m) _Pragma("unroll") for (int k = 0; k < 2; ++k) dst[m][k] = *(const LAS bf16x8*)(lds + PG8_SA(b, h) + aoff + m * 2048 + k * 1024); } while (0)
#define PG8_LDB(dst, b, h) do { _Pragma("unroll") for (int n = 0; n < 2; ++n) _Pragma("unroll") for (int k = 0; k < 2; ++k) dst[n][k] = *(const LAS bf16x8*)(lds + PG8_SB(b, h) + boff + n * 2048 + k * 1024); } while (0)
#define PG8_MMA(ai, bj, At, Bt) do { __builtin_amdgcn_s_setprio(1); _Pragma("unroll") for (int m = 0; m < 4; ++m) _Pragma("unroll") for (int n = 0; n < 2; ++n) _Pragma("unroll") for (int k = 0; k < 2; ++k) \
        acc[ai][bj][m][n] = __builtin_amdgcn_mfma_f32_16x16x32_bf16(Bt[n][k], At[m][k], acc[ai][bj][m][n], 0, 0, 0); __builtin_amdgcn_s_setprio(0); } while (0)
#define PG8_WAIT_V(n) asm volatile("s_waitcnt vmcnt(" #n ")" ::: "memory")
#define PG8_WAIT_L(n) asm volatile("s_waitcnt lgkmcnt(" #n ")" ::: "memory")
#define PG8_BAR __builtin_amdgcn_s_barrier()
#define PG8_SCHED __builtin_amdgcn_sched_barrier(0)
    Unit cur, nxt; int ui = 0;
    if (!S.ord.next(0, cur)) return;
    f32x4 acc[2][2][4][2];
#pragma unroll
    for (int a = 0; a < 2; ++a)
#pragma unroll
        for (int b = 0; b < 2; ++b)
#pragma unroll
            for (int m = 0; m < 4; ++m)
#pragma unroll
                for (int n = 0; n < 2; ++n) acc[a][b][m][n] = (f32x4){0.f, 0.f, 0.f, 0.f};
    bf16x8 At[4][2], B0[2][2], B1[2][2];
    unsigned curA[2][2], nxtA[2][2];
    S.a_off(cur, Rr, Cc, curA);
    const char* Ab = S.A;
    const char* cB = S.b_base(cur);
    PG8_STAGEB(PG8_SB(0, 0), cB, voffB); PG8_STAGEB(PG8_SB(0, 1), cB + hstepB, voffB); PG8_STAGEA(PG8_SA(0, 0), 0, curA[0]); PG8_STAGEA(PG8_SA(0, 1), 0, curA[1]);
    if (wr == 1) PG8_BAR;
    PG8_WAIT_V(2); PG8_BAR;
    PG8_STAGEB(PG8_SB(1, 0), cB + kstep, voffB); PG8_STAGEA(PG8_SA(1, 0), kstep, curA[0]); PG8_STAGEB(PG8_SB(1, 1), cB + hstepB + kstep, voffB);
    PG8_WAIT_V(6); PG8_BAR;
    for (;;) {
        const bool has_next = S.ord.next(ui + 1, nxt);
        if (has_next) S.a_off(nxt, Rr, Cc, nxtA);
        else {
#pragma unroll
            for (int h = 0; h < 2; ++h)
#pragma unroll
                for (int i = 0; i < 2; ++i) nxtA[h][i] = curA[h][i];
        }
        const char* nB = has_next ? S.b_base(nxt) : cB;
        for (int t = 0; t < nt; t += 2) {
            const bool last = (t == nt - 2);
            const size_t k1 = (size_t)(t + 1) * kstep;
            const size_t k2 = last ? 0 : (size_t)(t + 2) * kstep; const char* b2 = last ? nB : cB + (size_t)(t + 2) * kstep;
            const size_t k3 = k2 + kstep; const char* b3 = b2 + kstep;
            unsigned a2o[2][2];
#pragma unroll
            for (int h = 0; h < 2; ++h)
#pragma unroll
                for (int i = 0; i < 2; ++i) a2o[h][i] = last ? nxtA[h][i] : curA[h][i];
            PG8_LDB(B0, 0, 0); PG8_LDB(B1, 0, 1); PG8_SCHED; PG8_LDA(At, 0, 0); PG8_STAGEA(PG8_SA(1, 1), k1, curA[1]);
            PG8_WAIT_V(8); PG8_WAIT_L(0); PG8_BAR; PG8_MMA(0, 0, At, B0); PG8_MMA(0, 1, At, B1); PG8_BAR; PG8_SCHED;
            PG8_LDA(At, 0, 1); PG8_STAGEB(PG8_SB(0, 0), b2, voffB); PG8_STAGEB(PG8_SB(0, 1), b2 + hstepB, voffB); PG8_STAGEA(PG8_SA(0, 0), k2, a2o[0]);
            PG8_WAIT_V(8); PG8_WAIT_L(0); PG8_BAR; PG8_MMA(1, 0, At, B0); PG8_MMA(1, 1, At, B1); PG8_BAR; PG8_SCHED;
            PG8_LDB(B0, 1, 0); PG8_LDB(B1, 1, 1); PG8_SCHED; PG8_LDA(At, 1, 0); PG8_STAGEA(PG8_SA(0, 1), k2, a2o[1]);
            PG8_WAIT_V(8); PG8_WAIT_L(0); PG8_BAR; PG8_MMA(0, 0, At, B0); PG8_MMA(0, 1, At, B1); PG8_BAR; PG8_SCHED;
            PG8_LDA(At, 1, 1); PG8_STAGEB(PG8_SB(1, 0), b3, voffB); PG8_STAGEB(PG8_SB(1, 1), b3 + hstepB, voffB); PG8_STAGEA(PG8_SA(1, 0), k3, a2o[0]);
            PG8_WAIT_V(8); PG8_WAIT_L(0); PG8_BAR; PG8_MMA(1, 0, At, B0); PG8_MMA(1, 1, At, B1); PG8_BAR; PG8_SCHED;
        }
        if constexpr (ALIGN_EPI) { if (wr == 0) PG8_BAR; }
        E(acc, cur, wr, wc, fr, fq);
        if (!has_next) break;
#pragma unroll
        for (int a = 0; a < 2; ++a)
#pragma unroll
            for (int b = 0; b < 2; ++b)
#pragma unroll
                for (int m = 0; m < 4; ++m)
#pragma unroll
                    for (int n = 0; n < 2; ++n) acc[a][b][m][n] = (f32x4){0.f, 0.f, 0.f, 0.f};
        cur = nxt; cB = nB; ++ui;
#pragma unroll
        for (int h = 0; h < 2; ++h)
#pragma unroll
            for (int i = 0; i < 2; ++i) curA[h][i] = nxtA[h][i];
        if constexpr (ALIGN_EPI) { if (wr == 1) PG8_BAR; }
    }
    PG8_WAIT_V(0);
    if constexpr (!ALIGN_EPI) { if (wr == 0) PG8_BAR; }
    PG8_BAR;
#undef PG8_SA
#undef PG8_SB
#undef PG8_STAGEA
#undef PG8_STAGEB
#undef PG8_LDA
#undef PG8_LDB
#undef PG8_MMA
#undef PG8_WAIT_V
#undef PG8_WAIT_L
#undef PG8_BAR
#undef PG8_SCHED
}
template <class Prob, class Epi, bool ALIGN_EPI>
__device__ __forceinline__ void gemm_phase_q(LAS unsigned char* lds, const Prob& S, const Epi& E, int wv) {
    int tid_ = ltid(wv);
    const int tid = tid_, wid = __builtin_amdgcn_readfirstlane(tid >> 6), lane = tid & 63, wr = wid >> 2, wc = wid & 3, fr = lane & 15, fq = lane >> 4;
    const int K = S.K, nt = K / BK;
    int Rr[2], Cc[2]; unsigned voffB[2];
    const int KPB = S.bpitch();
#pragma unroll
    for (int i = 0; i < 2; ++i) { int R, C; stage_rc(tid * 16 + i * 8192, R, C); Rr[i] = R; Cc[i] = C; const int Rb = Epi::PERM ? ((R & ~31) + perm32(R & 31)) : R; voffB[i] = (unsigned)(Rb * KPB + C) * 2u; }
    const size_t kstep = (size_t)(BK * 2);
    const size_t hstepB = (size_t)HALF * KPB * 2;
    const unsigned ldsw = (unsigned)wid * 1024u;
    const int aq0 = lds_byte(wr * 64 + fr, fq * 8), aq1 = aq0 + 1024, bq0 = lds_byte(wc * 32 + fr, fq * 8), bq1 = bq0 + 1024;
    int sc_w = S.scale_b, sc_a = S.scale_a; asm volatile("" : "+v"(sc_w), "+v"(sc_a));
#define PG8_SA(b, h) (((b) * 2 + (h)) * HTB)
#define PG8_SB(b, h) ((4 + (b) * 2 + (h)) * HTB)
#define PG8_STAGEB(bufoff, gbase, voff) do { _Pragma("unroll") for (int _i = 0; _i < 2; ++_i) \
        __builtin_amdgcn_global_load_lds((const unsigned*)((const char*)(gbase) + (voff)[_i]), (LAS unsigned*)(lds + (bufoff) + ldsw + _i * 8192), 16, 0, 0); } while (0)
#define PG8_STAGEA(bufoff, kb, OFFh) do { _Pragma("unroll") for (int _i = 0; _i < 2; ++_i) \
        __builtin_amdgcn_global_load_lds((const unsigned*)(Ab + (kb) + (OFFh)[_i]), (LAS unsigned*)(lds + (bufoff) + ldsw + _i * 8192), 16, 0, 0); } while (0)
#define PG8_LDA(dst, b, h) do { _Pragma("unroll") for (int m = 0; m < 4; ++m) { const u32x4 l_ = *(const LAS u32x4*)(lds + PG8_SA(b, h) + aq0 + m * 2048), h_ = *(const LAS u32x4*)(lds + PG8_SA(b, h) + aq1 + m * 2048); \
        dst[m] = (v8i32){(int)l_.x, (int)l_.y, (int)l_.z, (int)l_.w, (int)h_.x, (int)h_.y, (int)h_.z, (int)h_.w}; } } while (0)
#define PG8_LDB(dst, b, h) do { _Pragma("unroll") for (int n = 0; n < 2; ++n) { const u32x4 l_ = *(const LAS u32x4*)(lds + PG8_SB(b, h) + bq0 + n * 2048), h_ = *(const LAS u32x4*)(lds + PG8_SB(b, h) + bq1 + n * 2048); \
        dst[n] = (v8i32){(int)l_.x, (int)l_.y, (int)l_.z, (int)l_.w, (int)h_.x, (int)h_.y, (int)h_.z, (int)h_.w}; } } while (0)
#define PG8_MMA(ai, bj, At, Bt) do { __builtin_amdgcn_s_setprio(1); _Pragma("unroll") for (int m = 0; m < 4; ++m) _Pragma("unroll") for (int n = 0; n < 2; ++n) \
        asm volatile("v_mfma_scale_f32_16x16x128_f8f6f4 %0, %1, %2, %0, %3, %4 op_sel_hi:[0,0,0]" : "+v"(acc[ai][bj][m][n]) : "v"(Bt[n]), "v"(At[m]), "v"(sc_w), "v"(sc_a)); __builtin_amdgcn_s_setprio(0); } while (0)
#define PG8_WAIT_V(n) asm volatile("s_waitcnt vmcnt(" #n ")" ::: "memory")
#define PG8_WAIT_L(n) asm volatile("s_waitcnt lgkmcnt(" #n ")" ::: "memory")
#define PG8_BAR __builtin_amdgcn_s_barrier()
#define PG8_SCHED __builtin_amdgcn_sched_barrier(0)
    Unit cur, nxt; int ui = 0;
    if (!S.ord.next(0, cur)) return;
    f32x4 acc[2][2][4][2];
#pragma unroll
    for (int a = 0; a < 2; ++a)
#pragma unroll
        for (int b = 0; b < 2; ++b)
#pragma unroll
            for (int m = 0; m < 4; ++m)
#pragma unroll
                for (int n = 0; n < 2; ++n) acc[a][b][m][n] = (f32x4){0.f, 0.f, 0.f, 0.f};
    v8i32 At[4], B0[2], B1[2];
    unsigned curA[2][2], nxtA[2][2];
    S.a_off(cur, Rr, Cc, curA);
    const char* Ab = S.A;
    const char* cB = S.b_base(cur);
    PG8_STAGEB(PG8_SB(0, 0), cB, voffB); PG8_STAGEB(PG8_SB(0, 1), cB + hstepB, voffB); PG8_STAGEA(PG8_SA(0, 0), 0, curA[0]); PG8_STAGEA(PG8_SA(0, 1), 0, curA[1]);
    if (wr == 1) PG8_BAR;
    PG8_WAIT_V(2); PG8_BAR;
    PG8_STAGEB(PG8_SB(1, 0), cB + kstep, voffB); PG8_STAGEA(PG8_SA(1, 0), kstep, curA[0]); PG8_STAGEB(PG8_SB(1, 1), cB + hstepB + kstep, voffB);
    PG8_WAIT_V(6); PG8_BAR;
    for (;;) {
        const bool has_next = S.ord.next(ui + 1, nxt);
        if (has_next) S.a_off(nxt, Rr, Cc, nxtA);
        else {
#pragma unroll
            for (int h = 0; h < 2; ++h)
#pragma unroll
                for (int i = 0; i < 2; ++i) nxtA[h][i] = curA[h][i];
        }
        const char* nB = has_next ? S.b_base(nxt) : cB;
        for (int t = 0; t < nt; t += 2) {
            const bool last = (t == nt - 2);
            const size_t k1 = (size_t)(t + 1) * kstep;
            const size_t k2 = last ? 0 : (size_t)(t + 2) * kstep; const char* b2 = last ? nB : cB + (size_t)(t + 2) * kstep;
            const size_t k3 = k2 + kstep; const char* b3 = b2 + kstep;
            unsigned a2o[2][2];
#pragma unroll
            for (int h = 0; h < 2; ++h)
#pragma unroll
                for (int i = 0; i < 2; ++i) a2o[h][i] = last ? nxtA[h][i] : curA[h][i];
            PG8_LDB(B0, 0, 0); PG8_LDB(B1, 0, 1); PG8_SCHED; PG8_LDA(At, 0, 0); PG8_STAGEA(PG8_SA(1, 1), k1, curA[1]);
            PG8_WAIT_V(8); PG8_WAIT_L(0); PG8_BAR; PG8_MMA(0, 0, At, B0); PG8_MMA(0, 1, At, B1); PG8_BAR; PG8_SCHED;
            PG8_LDA(At, 0, 1); PG8_STAGEB(PG8_SB(0, 0), b2, voffB); PG8_STAGEB(PG8_SB(0, 1), b2 + hstepB, voffB); PG8_STAGEA(PG8_SA(0, 0), k2, a2o[0]);
            PG8_WAIT_V(8); PG8_WAIT_L(0); PG8_BAR; PG8_MMA(1, 0, At, B0); PG8_MMA(1, 1, At, B1); PG8_BAR; PG8_SCHED;
            PG8_LDB(B0, 1, 0); PG8_LDB(B1, 1, 1); PG8_SCHED; PG8_LDA(At, 1, 0); PG8_STAGEA(PG8_SA(0, 1), k2, a2o[1]);
            PG8_WAIT_V(8); PG8_WAIT_L(0); PG8_BAR; PG8_MMA(0, 0, At, B0); PG8_MMA(0, 1, At, B1); PG8_BAR; PG8_SCHED;
            PG8_LDA(At, 1, 1); PG8_STAGEB(PG8_SB(1, 0), b3, voffB); PG8_STAGEB(PG8_SB(1, 1), b3 + hstepB, voffB); PG8_STAGEA(PG8_SA(1, 0), k3, a2o[0]);
            PG8_WAIT_V(8); PG8_WAIT_L(0); PG8_BAR; PG8_MMA(1, 0, At, B0); PG8_MMA(1, 1, At, B1); PG8_BAR; PG8_SCHED;
        }
        if constexpr (ALIGN_EPI) { if (wr == 0) PG8_BAR; }
#pragma unroll
        for (int a = 0; a < 2; ++a)
#pragma unroll
            for (int b = 0; b < 2; ++b) asm volatile("s_nop 15\n\ts_nop 15" : "+v"(acc[a][b][0][0]), "+v"(acc[a][b][0][1]), "+v"(acc[a][b][1][0]), "+v"(acc[a][b][1][1]), "+v"(acc[a][b][2][0]), "+v"(acc[a][b][2][1]), "+v"(acc[a][b][3][0]), "+v"(acc[a][b][3][1]));
        E(acc, cur, wr, wc, fr, fq);
        if (!has_next) break;
#pragma unroll
        for (int a = 0; a < 2; ++a)
#pragma unroll
            for (int b = 0; b < 2; ++b)
#pragma unroll
                for (int m = 0; m < 4; ++m)
#pragma unroll
                    for (int n = 0; n < 2; ++n) acc[a][b][m][n] = (f32x4){0.f, 0.f, 0.f, 0.f};
        cur = nxt; cB = nB; ++ui;
#pragma unroll
        for (int h = 0; h < 2; ++h)
#pragma unroll
            for (int i = 0; i < 2; ++i) curA[h][i] = nxtA[h][i];
        if constexpr (ALIGN_EPI) { if (wr == 1) PG8_BAR; }
    }
    PG8_WAIT_V(0);
    if constexpr (!ALIGN_EPI) { if (wr == 0) PG8_BAR; }
    PG8_BAR;
#undef PG8_SA
#undef PG8_SB
#undef PG8_STAGEA
#undef PG8_STAGEB
#undef PG8_LDA
#undef PG8_LDB
#undef PG8_MMA
#undef PG8_WAIT_V
#undef PG8_WAIT_L
#undef PG8_BAR
#undef PG8_SCHED
}
struct ProbPlain {
    int K, KA; Order ord; const char* A; const char* Bt;
    __device__ __forceinline__ const char* b_base(const Unit& u) const { return Bt + (size_t)u.pn * 256 * K * 2; }
    __device__ __forceinline__ void a_off(const Unit& u, const int (&R)[2], const int (&C)[2], unsigned (&off)[2][2]) const {
#pragma unroll
        for (int h = 0; h < 2; ++h)
#pragma unroll
            for (int i = 0; i < 2; ++i) off[h][i] = (unsigned)((u.pm * 256 + h * 128 + R[i]) * KA + C[i]) * 2u;
    }
};
struct ProbExpertGather {
    int K; Order ord; const char* A; const char* Bt; const int* tok;
    __device__ __forceinline__ const char* b_base(const Unit& u) const { return Bt + ((size_t)(u.pm >> 4) * 4096 + (size_t)u.pn * 256) * 1024 * 2; }
    __device__ __forceinline__ void a_off(const Unit& u, const int (&R)[2], const int (&C)[2], unsigned (&off)[2][2]) const {
#pragma unroll
        for (int h = 0; h < 2; ++h)
#pragma unroll
            for (int i = 0; i < 2; ++i) { const int row = tok[u.pm * 256 + h * 128 + R[i]]; off[h][i] = (unsigned)(row * 1024 + C[i]) * 2u; }
    }
};
struct ProbExpertDown {
    int K; Order ord; const char* A; const char* Bt;
    __device__ __forceinline__ const char* b_base(const Unit& u) const { return Bt + ((size_t)(u.pm >> 4) * 1024 + (size_t)u.pn * 256) * 2048 * 2; }
    __device__ __forceinline__ void a_off(const Unit& u, const int (&R)[2], const int (&C)[2], unsigned (&off)[2][2]) const {
#pragma unroll
        for (int h = 0; h < 2; ++h)
#pragma unroll
            for (int i = 0; i < 2; ++i) off[h][i] = (unsigned)((u.pm * 256 + h * 128 + R[i]) * 2048 + C[i]) * 2u;
    }
};
struct ProbExpertGatherQ {
    int K; int scale_a, scale_b; Order ord; const char* A; const char* Bt; const int* tok;
    __device__ __forceinline__ int bpitch() const { return K; }
    __device__ __forceinline__ const char* b_base(const Unit& u) const { return Bt + ((size_t)(u.pm >> 4) * 4096 + (size_t)u.pn * 256) * 1024; }
    __device__ __forceinline__ void a_off(const Unit& u, const int (&R)[2], const int (&C)[2], unsigned (&off)[2][2]) const {
#pragma unroll
        for (int h = 0; h < 2; ++h)
#pragma unroll
            for (int i = 0; i < 2; ++i) { const int row = tok[u.pm * 256 + h * 128 + R[i]]; off[h][i] = (unsigned)(row * 512 + C[i]) * 2u; }
    }
};
struct ProbExpertDownQ {
    int K; int scale_a, scale_b; Order ord; const char* A; const char* Bt;
    __device__ __forceinline__ int bpitch() const { return WDP / 2; }
    __device__ __forceinline__ const char* b_base(const Unit& u) const { return Bt + ((size_t)(u.pm >> 4) * 1024 + (size_t)u.pn * 256) * WDP; }
    __device__ __forceinline__ void a_off(const Unit& u, const int (&R)[2], const int (&C)[2], unsigned (&off)[2][2]) const {
#pragma unroll
        for (int h = 0; h < 2; ++h)
#pragma unroll
            for (int i = 0; i < 2; ++i) off[h][i] = (unsigned)((u.pm * 256 + h * 128 + R[i]) * (HP / 2) + C[i]) * 2u;
    }
};
struct EpiQKV {
    static constexpr bool PERM = true; bf16_t* O; unsigned* bnd;
    __device__ __forceinline__ void operator()(const f32x4 (&acc)[2][2][4][2], const Unit& u, int wr, int wc, int fr, int fq) const {
        const int row0 = u.pm * 256 + wr * 64 + fr, col0 = u.pn * 256 + wc * 32 + 8 * fq;
        const float sc = (u.pn == 3 || u.pn == 4) ? C2 : 1.f;
        const bool track = (u.pn >= 3 && u.pn <= 6);
        float mx = 0.f;
#pragma unroll
        for (int ai = 0; ai < 2; ++ai)
#pragma unroll
            for (int m = 0; m < 4; ++m) { bf16_t* rowp = O + (size_t)(row0 + ai * 128 + m * 16) * INW + col0;
#pragma unroll
                for (int bj = 0; bj < 2; ++bj) { const f32x4 v0 = acc[ai][bj][m][0] * sc, v1 = acc[ai][bj][m][1] * sc;
                    u32x4 w; w.x = cvtpk(v0[0], v0[1]); w.y = cvtpk(v0[2], v0[3]); w.z = cvtpk(v1[0], v1[1]); w.w = cvtpk(v1[2], v1[3]);
                    *(u32x4*)(rowp + bj * 128) = w;
                    if (track) { float ss = (v0[0] * v0[0] + v0[1] * v0[1]) + (v0[2] * v0[2] + v0[3] * v0[3]) + (v1[0] * v1[0] + v1[1] * v1[1]) + (v1[2] * v1[2] + v1[3] * v1[3]);
                        ss += swz_xor<16>(ss); { auto rr = __builtin_amdgcn_permlane32_swap(__float_as_uint(ss), __float_as_uint(ss), false, false); ss = __uint_as_float(rr[0]) + __uint_as_float(rr[1]); }
                        mx = fmaxf(mx, ss); } } }
        if (track) { mx = wave_max(mx) * 1.02f;
            if (fr == 0 && fq == 0) atomicMax(bnd + (u.pn >= 5 ? 64 : 0), __float_as_uint(mx)); }
    }
};
struct EpiBf16Plain {
    static constexpr bool PERM = true; bf16_t* O; int ldc;
    __device__ __forceinline__ void operator()(const f32x4 (&acc)[2][2][4][2], const Unit& u, int wr, int wc, int fr, int fq) const {
        const int row0 = u.pm * 256 + wr * 64 + fr, col0 = u.pn * 256 + wc * 32 + 8 * fq;
#pragma unroll
        for (int ai = 0; ai < 2; ++ai)
#pragma unroll
            for (int m = 0; m < 4; ++m) { bf16_t* rowp = O + (size_t)(row0 + ai * 128 + m * 16) * ldc + col0;
#pragma unroll
                for (int bj = 0; bj < 2; ++bj) { const f32x4 v0 = acc[ai][bj][m][0], v1 = acc[ai][bj][m][1];
                    u32x4 w; w.x = cvtpk(v0[0], v0[1]); w.y = cvtpk(v0[2], v0[3]); w.z = cvtpk(v1[0], v1[1]); w.w = cvtpk(v1[2], v1[3]);
                    *(u32x4*)(rowp + bj * 128) = w; } }
    }
};
struct EpiResF32 {
    static constexpr bool PERM = false; const bf16_t* xb; float* out;
    __device__ __forceinline__ void operator()(const f32x4 (&acc)[2][2][4][2], const Unit& u, int wr, int wc, int fr, int fq) const {
        const int col0 = u.pn * 256 + wc * 32 + 4 * fq;
#pragma unroll
        for (int ai = 0; ai < 2; ++ai)
#pragma unroll
            for (int m = 0; m < 4; ++m) { const size_t off = (size_t)(u.pm * 256 + ai * 128 + wr * 64 + m * 16 + fr) * DMODEL + col0;
#pragma unroll
                for (int bj = 0; bj < 2; ++bj)
#pragma unroll
                    for (int n = 0; n < 2; ++n) { const u32x2 w = *(const u32x2*)(xb + off + bj * 128 + n * 16); const f32x4 bs = {bf_lo(w.x), bf_hi(w.x), bf_lo(w.y), bf_hi(w.y)};
                        *(f32x4*)(out + off + bj * 128 + n * 16) = bs * ALPHA + acc[ai][bj][m][n]; } }
    }
};
__device__ __forceinline__ float silu_mul(float g, float u) { return g * __builtin_amdgcn_rcpf(1.f + __builtin_amdgcn_exp2f(-g * LOG2E)) * u; }
struct EpiSwiGLU {
    static constexpr bool PERM = true; unsigned char* H;
    __device__ __forceinline__ void operator()(const f32x4 (&acc)[2][2][4][2], const Unit& u, int wr, int wc, int fr, int fq) const {
        const int row0 = u.pm * 256 + wr * 64 + fr, col0 = u.pn * 128 + wc * 32 + 8 * fq;
#pragma unroll
        for (int ai = 0; ai < 2; ++ai)
#pragma unroll
            for (int m = 0; m < 4; ++m) { unsigned char* rowp = H + (size_t)(row0 + ai * 128 + m * 16) * HP + col0;
                const f32x4 g0 = acc[ai][0][m][0], g1 = acc[ai][0][m][1], u0 = acc[ai][1][m][0], u1 = acc[ai][1][m][1];
                u32x2 w; w.x = pk_fp8x4(silu_mul(g0[0], u0[0]) * 16.f, silu_mul(g0[1], u0[1]) * 16.f, silu_mul(g0[2], u0[2]) * 16.f, silu_mul(g0[3], u0[3]) * 16.f);
                w.y = pk_fp8x4(silu_mul(g1[0], u1[0]) * 16.f, silu_mul(g1[1], u1[1]) * 16.f, silu_mul(g1[2], u1[2]) * 16.f, silu_mul(g1[3], u1[3]) * 16.f);
                __builtin_nontemporal_store(w, (u32x2*)rowp); }
    }
};
struct EpiDown {
    static constexpr bool PERM = true; bf16_t* O; const float* gate;
    __device__ __forceinline__ void operator()(const f32x4 (&acc)[2][2][4][2], const Unit& u, int wr, int wc, int fr, int fq) const {
        const int row0 = u.pm * 256 + wr * 64 + fr, col0 = u.pn * 256 + wc * 32 + 8 * fq;
#pragma unroll
        for (int ai = 0; ai < 2; ++ai)
#pragma unroll
            for (int m = 0; m < 4; ++m) { const int r = row0 + ai * 128 + m * 16; const float g = gate[r]; bf16_t* rowp = O + (size_t)r * DMODEL + col0;
#pragma unroll
                for (int bj = 0; bj < 2; ++bj) { const f32x4 v0 = acc[ai][bj][m][0] * g, v1 = acc[ai][bj][m][1] * g;
                    u32x4 w; w.x = cvtpk(v0[0], v0[1]); w.y = cvtpk(v0[2], v0[3]); w.z = cvtpk(v1[0], v1[1]); w.w = cvtpk(v1[2], v1[3]);
                    __builtin_nontemporal_store(w, (u32x4*)(rowp + bj * 128)); } }
    }
};
__device__ __forceinline__ float sigm(float a) { return __builtin_amdgcn_rcpf(1.f + __builtin_amdgcn_exp2f(-a * LOG2E)); }
struct EpiPLE {
    static constexpr bool PERM = true; const bf16_t* x2b; const bf16_t* pj; bf16_t* y3;
    __device__ __forceinline__ void operator()(const f32x4 (&acc)[2][2][4][2], const Unit& u, int wr, int wc, int fr, int fq) const {
        const int row0 = u.pm * 256 + wr * 64 + fr, col0 = u.pn * 256 + wc * 32 + 8 * fq;
#pragma unroll
        for (int ai = 0; ai < 2; ++ai)
#pragma unroll
            for (int m = 0; m < 4; ++m) { const size_t off = (size_t)(row0 + ai * 128 + m * 16) * DMODEL + col0;
#pragma unroll
                for (int bj = 0; bj < 2; ++bj) { const u32x4 xw = *(const u32x4*)(x2b + off + bj * 128), pw = *(const u32x4*)(pj + off + bj * 128);
                    const f32x4 a0 = acc[ai][bj][m][0], a1 = acc[ai][bj][m][1]; u32x4 w;
                    w.x = cvtpk(bf_lo(xw.x) * ALPHA + sigm(a0[0]) * bf_lo(pw.x), bf_hi(xw.x) * ALPHA + sigm(a0[1]) * bf_hi(pw.x));
                    w.y = cvtpk(bf_lo(xw.y) * ALPHA + sigm(a0[2]) * bf_lo(pw.y), bf_hi(xw.y) * ALPHA + sigm(a0[3]) * bf_hi(pw.y));
                    w.z = cvtpk(bf_lo(xw.z) * ALPHA + sigm(a1[0]) * bf_lo(pw.z), bf_hi(xw.z) * ALPHA + sigm(a1[1]) * bf_hi(pw.z));
                    w.w = cvtpk(bf_lo(xw.w) * ALPHA + sigm(a1[2]) * bf_lo(pw.w), bf_hi(xw.w) * ALPHA + sigm(a1[3]) * bf_hi(pw.w));
                    *(u32x4*)(y3 + off + bj * 128) = w; } }
    }
};
}

namespace attn_body {
using bf16 = __hip_bfloat16;
using s16x4 = __attribute__((ext_vector_type(4))) short;
using f32x16 = __attribute__((ext_vector_type(16))) float;
constexpr int D = 64, PITCH = INW, OPITCH = DMODEL;
constexpr int NW = 8, QBLK = 32, QB = QBLK * NW, KVBLK = 64, NT = SEQ / KVBLK;
__device__ __forceinline__ int crow(int r, int hi) { return (r & 3) + 8 * (r >> 2) + 4 * hi; }
#define SBAR() __builtin_amdgcn_sched_barrier(0)
constexpr int NSLOT = 3, SLOTB = 8192;
constexpr int LDS_K = 0, LDS_V = NSLOT * SLOTB, LDS_WS = 2 * NSLOT * SLOTB, LDS_OST = LDS_WS + NW * 64 * 4, ATT_LDS_BYTES = LDS_OST + NW * 4096;
constexpr int LDS_STASH = 75776;
constexpr int LDS_TAB = 141312;
__device__ __forceinline__ void glds16(const void* gsrc, unsigned lds_dst) { unsigned keep;
    asm volatile("s_mov_b32 %0, m0\n\ts_mov_b32 m0, %2\n\ts_nop 0\n\tglobal_load_lds_dwordx4 %1, off\n\ts_mov_b32 m0, %0" : "=&s"(keep) : "v"(gsrc), "s"(lds_dst) : "memory"); }
__device__ __forceinline__ float max3f(float a, float b, float c) { float r; asm("v_max3_f32 %0, %1, %2, %3" : "=v"(r) : "v"(a), "v"(b), "v"(c)); return r; }
__device__ __forceinline__ float max2f(float a, float b) { float r; asm("v_max_f32_e32 %0, %1, %2" : "=v"(r) : "v"(a), "v"(b)); return r; }
__device__ __forceinline__ float fadd_s(float a, float b) { float r; asm("v_add_f32_e32 %0, %1, %2" : "=v"(r) : "v"(a), "v"(b)); return r; }
__device__ __forceinline__ float fsub_s(float a, float b) { float r; asm("v_sub_f32_e32 %0, %1, %2" : "=v"(r) : "v"(a), "v"(b)); return r; }
#define WAIT_BAR(N) asm volatile("s_waitcnt vmcnt(" #N ") lgkmcnt(0)\n\ts_barrier" ::: "memory")
__device__ __forceinline__ void qkt(f32x16& p0, f32x16& p1, const char* Kslot, const bf16x8* qr, const f32x16& negm, int r32, int hi) {
    const char* kb = Kslot + hi * 1024 + r32 * 16;
#pragma unroll
    for (int d0 = 0; d0 < 4; ++d0) {
        const bf16x8 b0 = *reinterpret_cast<const bf16x8*>(kb + d0 * 2048);
        const bf16x8 b1 = *reinterpret_cast<const bf16x8*>(kb + d0 * 2048 + 512);
        if (d0 == 0) { p0 = __builtin_amdgcn_mfma_f32_32x32x16_bf16(b0, qr[0], negm, 0, 0, 0); p1 = __builtin_amdgcn_mfma_f32_32x32x16_bf16(b1, qr[0], negm, 0, 0, 0); }
        else { p0 = __builtin_amdgcn_mfma_f32_32x32x16_bf16(b0, qr[d0], p0, 0, 0, 0); p1 = __builtin_amdgcn_mfma_f32_32x32x16_bf16(b1, qr[d0], p1, 0, 0, 0); } }
}
typedef __attribute__((address_space(3))) const char* lds_cptr;
typedef short v4i16_t __attribute__((ext_vector_type(4)));
__device__ __forceinline__ void kload8(bf16x8* kf, lds_cptr kp) {
    kf[0] = *(const LAS bf16x8*)(kp);        kf[1] = *(const LAS bf16x8*)(kp + 512);
    kf[2] = *(const LAS bf16x8*)(kp + 2048); kf[3] = *(const LAS bf16x8*)(kp + 2560);
    kf[4] = *(const LAS bf16x8*)(kp + 4096); kf[5] = *(const LAS bf16x8*)(kp + 4608);
    kf[6] = *(const LAS bf16x8*)(kp + 6144); kf[7] = *(const LAS bf16x8*)(kp + 6656);
}
__device__ __forceinline__ void kload2(bf16x8* kf, lds_cptr kp, int j) { kf[2 * j] = *(const LAS bf16x8*)(kp + j * 2048); kf[2 * j + 1] = *(const LAS bf16x8*)(kp + j * 2048 + 512); }
__device__ __forceinline__ s16x4 vtr(lds_cptr p) { return __builtin_bit_cast(s16x4, __builtin_amdgcn_ds_read_tr16_b64_v4i16((LAS v4i16_t*)p)); }
__device__ __forceinline__ float rowmax(const f32x16& p0, const f32x16& p1) {
    float a = max3f(p0[0], p0[1], p1[0]), b = max3f(p0[2], p0[3], p1[1]); a = max3f(a, p1[2], p1[3]);
#pragma unroll
    for (int r = 4; r < 16; r += 4) { a = max3f(a, p0[r], p0[r + 1]); b = max3f(b, p0[r + 2], p0[r + 3]); a = max3f(a, p1[r], p1[r + 1]); b = max3f(b, p1[r + 2], p1[r + 3]); }
    const float m = max2f(a, b);
    auto rr = __builtin_amdgcn_permlane32_swap(__float_as_uint(m), __float_as_uint(m), false, false);
    return max2f(__uint_as_float(rr[0]), __uint_as_float(rr[1]));
}
__device__ __forceinline__ void pv(f32x16* o, int vb, bf16x8 pa0, bf16x8 pa1, bf16x8 pa2, bf16x8 pa3) {
#pragma unroll
    for (int d0 = 0; d0 < 2; ++d0) { s16x4 lo[4], hi[4];
#pragma unroll
        for (int ks = 0; ks < 4; ++ks) {
            asm volatile("ds_read_b64_tr_b16 %0,%1 offset:%c2" : "=&v"(lo[ks]) : "v"(vb), "i"(d0 * 4096 + ks * 1024) : "memory");
            asm volatile("ds_read_b64_tr_b16 %0,%1 offset:%c2" : "=&v"(hi[ks]) : "v"(vb), "i"(d0 * 4096 + ks * 1024 + 512) : "memory"); }
        asm volatile("s_waitcnt lgkmcnt(0)" ::: "memory"); SBAR();
#define PK(k) (bf16x8){lo[k][0], lo[k][1], lo[k][2], lo[k][3], hi[k][0], hi[k][1], hi[k][2], hi[k][3]}
        o[d0] = __builtin_amdgcn_mfma_f32_32x32x16_bf16(pa0, PK(0), o[d0], 0, 0, 0);
        o[d0] = __builtin_amdgcn_mfma_f32_32x32x16_bf16(pa1, PK(1), o[d0], 0, 0, 0);
        o[d0] = __builtin_amdgcn_mfma_f32_32x32x16_bf16(pa2, PK(2), o[d0], 0, 0, 0);
        o[d0] = __builtin_amdgcn_mfma_f32_32x32x16_bf16(pa3, PK(3), o[d0], 0, 0, 0);
#undef PK
    }
}
template <int THRL> __device__ __forceinline__ void attn_unit(const bf16* Qp, const bf16* __restrict__ Kp, const bf16* __restrict__ Vp, bf16* Op, int q0, char* shm, int wv) {
    int tid_ = ltid(wv);
    const int tid = tid_, lane = tid & 63, r32 = lane & 31, hi = lane >> 5; const int wid = __builtin_amdgcn_readfirstlane(tid >> 6);
    const bf16* Qw = Qp + (long)(q0 + wid * QBLK) * PITCH;
    const unsigned lds0 = (unsigned)(uintptr_t)shm;
    float* wsf = (float*)(shm + LDS_WS) + wid * 64;
    const bf16* ksrc = Kp + (long)lane * PITCH + wid * 8;
    const bf16* vsrc = Vp + (long)(16 * (wid & 3) + (lane >> 2)) * PITCH + (wid >> 2) * 32 + (lane & 3) * 8;
    const unsigned kdst = lds0 + LDS_K + wid * 1024, vdst = lds0 + LDS_V + wid * 1024;
#define DMA_K(t, slot) glds16(ksrc + (long)(t) * KVBLK * PITCH, (unsigned)__builtin_amdgcn_readfirstlane(kdst + (slot)))
#define DMA_V(t, slot) glds16(vsrc + (long)(t) * KVBLK * PITCH, (unsigned)__builtin_amdgcn_readfirstlane(vdst + (slot)))
    const int vb0 = (int)(lds0 + LDS_V) + ((lane >> 4) & 1) * 32 + (lane & 3) * 8 + (4 * hi + ((lane & 15) >> 2)) * 64;
    const char* Kbase = shm + LDS_K; bf16x8 kf[8];
    const lds_cptr shm3 = (lds_cptr)shm; const lds_cptr kp0 = shm3 + LDS_K + hi * 1024 + r32 * 16; const lds_cptr vp0 = shm3 + LDS_V + ((lane >> 4) & 1) * 32 + (lane & 3) * 8 + (4 * hi + ((lane & 15) >> 2)) * 64;
    DMA_K(0, 0); DMA_V(0, 0); DMA_K(1, SLOTB);
    bf16x8 qr[4];
#pragma unroll
    for (int d0 = 0; d0 < 4; ++d0) qr[d0] = *reinterpret_cast<const bf16x8*>(&Qw[(long)r32 * PITCH + d0 * 16 + hi * 8]);
    const float cb = 0.f;
    float mhat = 0.f, l_reg = 0.f; f32x16 o[2]; o[0] = f32x16{}; o[1] = f32x16{}; f32x16 negm;
#pragma unroll
    for (int r = 0; r < 16; ++r) negm[r] = cb;
    asm volatile("" : "+v"(negm));
#define BIASADD(C0, C1, t) do { } while (0)
#define NEGM_UPD(tn) do { } while (0)
    bool resc = false;
#define START(P0, P1) do { const float rm = rowmax(P0, P1); resc = false; \
    { const float dl = rm; mhat = fadd_s(mhat, dl); \
      _Pragma("unroll") for (int r = 0; r < 16; ++r) { P0[r] = fsub_s(P0[r], dl); P1[r] = fsub_s(P1[r], dl); } \
      _Pragma("unroll") for (int r = 0; r < 16; ++r) negm[r] = cb - mhat; asm volatile("" : "+v"(negm)); } \
    _Pragma("unroll") for (int r = 0; r < 16; ++r) P0[r] = __builtin_amdgcn_exp2f(P0[r]); } while (0)
#define RESC() do { if (resc) { asm volatile("s_waitcnt lgkmcnt(0)" ::: "memory"); \
      _Pragma("unroll") for (int d_ = 0; d_ < 2; ++d_) _Pragma("unroll") for (int r = 0; r < 16; ++r) o[d_][r] *= wsf[crow(r, hi)]; } } while (0)
    f32x16 pA0, pA1, pB0, pB1;
    int sl_prev = 0, sl_cur = 0, sl_next = SLOTB;
#define ROT() do { sl_prev = sl_cur; sl_cur = sl_next; sl_next = (sl_next == (NSLOT - 1) * SLOTB) ? 0 : sl_next + SLOTB; } while (0)
    DMA_K(2, 2 * SLOTB);
    WAIT_BAR(3);
    qkt(pA0, pA1, Kbase, qr, negm, r32, hi); asm volatile("s_nop 15\n\ts_nop 7" : "+v"(pA0), "+v"(pA1)); BIASADD(pA0, pA1, 0);
    START(pA0, pA1);
    _Pragma("unroll") for (int r = 0; r < 16; ++r) pA1[r] = __builtin_amdgcn_exp2f(pA1[r]);
    WAIT_BAR(0);
    DMA_K(3, 0); DMA_V(1, SLOTB);
    ROT();
    kload8(kf, kp0 + sl_cur);
    NEGM_UPD(1);
    WAIT_BAR(2);
    s16x4 vlo[8], vhi[8]; u32x4 pw0, pw1, pw2, pw3;
#define PKW(P, B) cvtpk(P[B], P[B + 1])
#define PAF(k) __builtin_bit_cast(bf16x8, pw##k)
#define VFR(i) (bf16x8){vlo[i][0], vlo[i][1], vlo[i][2], vlo[i][3], vhi[i][0], vhi[i][1], vhi[i][2], vhi[i][3]}
#define PIN(x) asm volatile("" : "+v"(x))
#define MX3(a, b, c) __builtin_fmaxf(__builtin_fmaxf((a), (b)), (c))
#define GAPA(MF, A0, A1, A2, A3, W0, W1, PW) do { MF; sacc += A0; sacc += A1; sacc += A2; sacc += A3; PIN(sacc); W0; W1; PIN(PW); SBAR(); } while (0)
#define EX(v) __builtin_amdgcn_exp2f(v)
#define GAPB(MF, X, B) do { MF; X[B] = EX(X[B]); X[B + 1] = EX(X[B + 1]); X[B + 2] = EX(X[B + 2]); X[B + 3] = EX(X[B + 3]); PIN(X); SBAR(); } while (0)
#define VRD(i) do { vlo[i] = vtr(vp_ + (((i) >> 2) * 4096 + ((i) & 3) * 1024)); vhi[i] = vtr(vp_ + (((i) >> 2) * 4096 + ((i) & 3) * 1024 + 512)); } while (0)
#define KRD(G, j) do { if (G) { kload2(kf, kp0 + sl_next, j); SBAR(); } } while (0)
#define STEP(C0, C1, P0, P1, t, GK, GV, GL) do { SBAR(); \
    const lds_cptr vp_ = vp0 + sl_prev; \
    VRD(0); SBAR(); float sacc = (P0[0] + P0[1]); \
    GAPA(C0 = __builtin_amdgcn_mfma_f32_32x32x16_bf16(kf[0], qr[0], negm, 0, 0, 0), P0[2], P0[3], P0[4], P0[5],     pw0[0] = PKW(P0, 0), pw0[1] = PKW(P0, 2), pw0); \
    VRD(4); SBAR(); GAPA(C1 = __builtin_amdgcn_mfma_f32_32x32x16_bf16(kf[1], qr[0], negm, 0, 0, 0), P0[6], P0[7], P0[8], P0[9],     pw0[2] = PKW(P0, 4), pw0[3] = PKW(P0, 6), pw0); \
    VRD(1); SBAR(); GAPA(C0 = __builtin_amdgcn_mfma_f32_32x32x16_bf16(kf[2], qr[1], C0, 0, 0, 0),   P0[10], P0[11], P0[12], P0[13], pw1[0] = PKW(P0, 8), pw1[1] = PKW(P0, 10), pw1); \
    VRD(5); SBAR(); GAPA(C1 = __builtin_amdgcn_mfma_f32_32x32x16_bf16(kf[3], qr[1], C1, 0, 0, 0),   P0[14], P0[15], P1[0], P1[1],   pw1[2] = PKW(P0, 12), pw1[3] = PKW(P0, 14), pw1); \
    VRD(2); SBAR(); GAPA(C0 = __builtin_amdgcn_mfma_f32_32x32x16_bf16(kf[4], qr[2], C0, 0, 0, 0),   P1[2], P1[3], P1[4], P1[5],     pw2[0] = PKW(P1, 0), pw2[1] = PKW(P1, 2), pw2); \
    VRD(6); SBAR(); GAPA(C1 = __builtin_amdgcn_mfma_f32_32x32x16_bf16(kf[5], qr[2], C1, 0, 0, 0),   P1[6], P1[7], P1[8], P1[9],     pw2[2] = PKW(P1, 4), pw2[3] = PKW(P1, 6), pw2); \
    VRD(3); SBAR(); GAPA(C0 = __builtin_amdgcn_mfma_f32_32x32x16_bf16(kf[6], qr[3], C0, 0, 0, 0),   P1[10], P1[11], P1[12], P1[13], pw3[0] = PKW(P1, 8), pw3[1] = PKW(P1, 10), pw3); \
    VRD(7); SBAR(); GAPA(C1 = __builtin_amdgcn_mfma_f32_32x32x16_bf16(kf[7], qr[3], C1, 0, 0, 0),   P1[14], P1[15], 0.f, 0.f,       pw3[2] = PKW(P1, 12), pw3[3] = PKW(P1, 14), pw3); \
    l_reg += sacc; \
    if (GK) { DMA_K((t) + 3, sl_cur); } if (GV) { DMA_V((t) + 1, sl_next); } \
    BIASADD(C0, C1, t); \
    { float a = MX3(C0[0], C0[1], C1[0]), b = MX3(C0[2], C0[3], C1[1]); a = MX3(a, C1[2], C1[3]); \
      _Pragma("unroll") for (int r = 4; r < 16; r += 4) { a = MX3(a, C0[r], C0[r + 1]); b = MX3(b, C0[r + 2], C0[r + 3]); a = MX3(a, C1[r], C1[r + 1]); b = MX3(b, C1[r + 2], C1[r + 3]); } \
      float rm = __builtin_fmaxf(a, b); { auto rr = __builtin_amdgcn_permlane32_swap(__float_as_uint(rm), __float_as_uint(rm), false, false); rm = __builtin_fmaxf(__uint_as_float(rr[0]), __uint_as_float(rr[1])); } \
      resc = false; \
      if (__builtin_expect(__any(rm > (float)THRL), 0)) { const float dl = __builtin_fmaxf(rm, 0.f); mhat += dl; \
        _Pragma("unroll") for (int r = 0; r < 16; ++r) { C0[r] -= dl; C1[r] -= dl; } \
        _Pragma("unroll") for (int r = 0; r < 16; ++r) negm[r] = cb - mhat; asm volatile("" : "+v"(negm)); \
        const float f = __builtin_amdgcn_exp2f(-dl); l_reg *= f; if (hi == 0) wsf[r32] = f; resc = true; } } \
    SBAR(); \
    GAPB(o[0] = __builtin_amdgcn_mfma_f32_32x32x16_bf16(PAF(0), VFR(0), o[0], 0, 0, 0), C0, 0); \
    GAPB(o[1] = __builtin_amdgcn_mfma_f32_32x32x16_bf16(PAF(0), VFR(4), o[1], 0, 0, 0), C0, 4); \
    KRD(GL, 0); GAPB(o[0] = __builtin_amdgcn_mfma_f32_32x32x16_bf16(PAF(1), VFR(1), o[0], 0, 0, 0), C0, 8); \
    KRD(GL, 1); GAPB(o[1] = __builtin_amdgcn_mfma_f32_32x32x16_bf16(PAF(1), VFR(5), o[1], 0, 0, 0), C0, 12); \
    KRD(GL, 2); GAPB(o[0] = __builtin_amdgcn_mfma_f32_32x32x16_bf16(PAF(2), VFR(2), o[0], 0, 0, 0), C1, 0); \
    KRD(GL, 3); GAPB(o[1] = __builtin_amdgcn_mfma_f32_32x32x16_bf16(PAF(2), VFR(6), o[1], 0, 0, 0), C1, 4); \
    GAPB(o[0] = __builtin_amdgcn_mfma_f32_32x32x16_bf16(PAF(3), VFR(3), o[0], 0, 0, 0), C1, 8); \
    GAPB(o[1] = __builtin_amdgcn_mfma_f32_32x32x16_bf16(PAF(3), VFR(7), o[1], 0, 0, 0), C1, 12); \
    } while (0)
    int t = 1;
    for (; t + 5 < NT; t += 2) {
        STEP(pB0, pB1, pA0, pA1, t, true, true, true);     WAIT_BAR(2); RESC(); ROT(); NEGM_UPD(t + 1);
        STEP(pA0, pA1, pB0, pB1, t + 1, true, true, true); WAIT_BAR(2); RESC(); ROT(); NEGM_UPD(t + 2);
    }
#define ENDW(tt) do { if ((tt) + 3 < NT) { WAIT_BAR(2); } else if ((tt) + 2 < NT) { WAIT_BAR(1); } else { WAIT_BAR(0); } } while (0)
    for (; t + 1 < NT; t += 2) {
        STEP(pB0, pB1, pA0, pA1, t, (t + 3 < NT), (t + 1 < NT), (t + 1 < NT));       ENDW(t);     RESC(); ROT(); NEGM_UPD(t + 1);
        STEP(pA0, pA1, pB0, pB1, t + 1, (t + 4 < NT), (t + 2 < NT), (t + 2 < NT));   ENDW(t + 1); RESC(); ROT(); NEGM_UPD(t + 2);
    }
    STEP(pB0, pB1, pA0, pA1, NT - 1, false, false, false); RESC();
    { float sacc = pB0[0] + pB0[1]; _Pragma("unroll") for (int r = 2; r < 16; ++r) sacc += pB0[r]; _Pragma("unroll") for (int r = 0; r < 16; ++r) sacc += pB1[r]; l_reg += sacc;
      pw0 = (u32x4){PKW(pB0, 0), PKW(pB0, 2), PKW(pB0, 4), PKW(pB0, 6)}; pw1 = (u32x4){PKW(pB0, 8), PKW(pB0, 10), PKW(pB0, 12), PKW(pB0, 14)}; pw2 = (u32x4){PKW(pB1, 0), PKW(pB1, 2), PKW(pB1, 4), PKW(pB1, 6)}; pw3 = (u32x4){PKW(pB1, 8), PKW(pB1, 10), PKW(pB1, 12), PKW(pB1, 14)};
      SBAR(); pv(o, vb0 + sl_cur, PAF(0), PAF(1), PAF(2), PAF(3)); }
#undef PKW
#undef PAF
#undef VFR
#undef PIN
#undef MX3
#undef GAPA
#undef GAPB
#undef EX
#undef VRD
#undef KRD
#undef STEP
#undef ENDW
    { auto rr = __builtin_amdgcn_permlane32_swap(__float_as_uint(l_reg), __float_as_uint(l_reg), false, false); l_reg = __uint_as_float(rr[0]) + __uint_as_float(rr[1]); }
    if (hi == 0) wsf[32 + r32] = l_reg; asm volatile("s_waitcnt lgkmcnt(0)" ::: "memory");
    float rli[16];
#pragma unroll
    for (int r = 0; r < 16; ++r) rli[r] = __builtin_amdgcn_rcpf(wsf[32 + crow(r, hi)]);
    bf16* Ow = Op + (long)(q0 + wid * QBLK) * OPITCH;
    { bf16* stg = (bf16*)(shm + LDS_OST) + wid * 2048;
#pragma unroll
      for (int r = 0; r < 16; ++r) { const int orow = crow(r, hi);
#pragma unroll
          for (int d0 = 0; d0 < 2; ++d0) stg[orow * 64 + d0 * 32 + r32] = __float2bfloat16(o[d0][r] * rli[r]); }
      asm volatile("s_waitcnt lgkmcnt(0)" ::: "memory");
#pragma unroll
      for (int i = 0; i < 4; ++i) { const int row = i * 8 + (lane >> 3), ch = lane & 7; const u32x4 v = *(const u32x4*)(stg + row * 64 + ch * 8); *(u32x4*)(Ow + (long)row * OPITCH + ch * 8) = v; } }
    asm volatile("s_waitcnt lgkmcnt(0)\n\ts_barrier" ::: "memory");
#undef DMA_K
#undef DMA_V
#undef BIASADD
#undef NEGM_UPD
#undef START
#undef RESC
#undef ROT
}


__device__ __forceinline__ void attn_unit_nm(const bf16* Qp, const bf16* __restrict__ Kp, const bf16* __restrict__ Vp, bf16* Op, int q0, char* shm, int wv) {
    int tid_ = ltid(wv);
    const int tid = tid_, lane = tid & 63, r32 = lane & 31, hi = lane >> 5; const int wid = __builtin_amdgcn_readfirstlane(tid >> 6);
    const bf16* Qw = Qp + (long)(q0 + wid * QBLK) * PITCH;
    const unsigned lds0 = (unsigned)(uintptr_t)shm;
    const bf16* ksrc = Kp + (long)lane * PITCH + wid * 8;
    const bf16* vsrc = Vp + (long)(16 * (wid & 3) + (lane >> 2)) * PITCH + (wid >> 2) * 32 + (lane & 3) * 8;
    const unsigned kdst = lds0 + LDS_K + wid * 1024, vdst = lds0 + LDS_V + wid * 1024;
#define DMA_K(t, slot) glds16(ksrc + (long)(t) * KVBLK * PITCH, (unsigned)__builtin_amdgcn_readfirstlane(kdst + (slot)))
#define DMA_V(t, slot) glds16(vsrc + (long)(t) * KVBLK * PITCH, (unsigned)__builtin_amdgcn_readfirstlane(vdst + (slot)))
    const int vb0 = (int)(lds0 + LDS_V) + ((lane >> 4) & 1) * 32 + (lane & 3) * 8 + (4 * hi + ((lane & 15) >> 2)) * 64;
    const char* Kbase = shm + LDS_K; bf16x8 kf[8];
    const lds_cptr shm3 = (lds_cptr)shm; const lds_cptr kp0 = shm3 + LDS_K + hi * 1024 + r32 * 16; const lds_cptr vp0 = shm3 + LDS_V + ((lane >> 4) & 1) * 32 + (lane & 3) * 8 + (4 * hi + ((lane & 15) >> 2)) * 64;
    DMA_K(0, 0); DMA_V(0, 0); DMA_K(1, SLOTB);
    bf16x8 qr[4];
#pragma unroll
    for (int d0 = 0; d0 < 4; ++d0) qr[d0] = *reinterpret_cast<const bf16x8*>(&Qw[(long)r32 * PITCH + d0 * 16 + hi * 8]);
    f32x16 o[2]; o[0] = f32x16{}; o[1] = f32x16{}; float l_reg = 0.f;
    float* wsf = (float*)(shm + LDS_WS) + wid * 64;
    const f32x16 zero16 = f32x16{};
    f32x16 pA0, pA1, pB0, pB1;
    int sl_prev = 0, sl_cur = 0, sl_next = SLOTB;
#define ROT() do { sl_prev = sl_cur; sl_cur = sl_next; sl_next = (sl_next == (NSLOT - 1) * SLOTB) ? 0 : sl_next + SLOTB; } while (0)
    DMA_K(2, 2 * SLOTB);
    WAIT_BAR(3);
    qkt(pA0, pA1, Kbase, qr, zero16, r32, hi); asm volatile("s_nop 15\n\ts_nop 7" : "+v"(pA0), "+v"(pA1));
    _Pragma("unroll") for (int r = 0; r < 16; ++r) { pA0[r] = __builtin_amdgcn_exp2f(pA0[r]); pA1[r] = __builtin_amdgcn_exp2f(pA1[r]); }
    WAIT_BAR(0);
    DMA_K(3, 0); DMA_V(1, SLOTB);
    ROT();
    kload8(kf, kp0 + sl_cur);
    WAIT_BAR(2);
    s16x4 vlo[8], vhi[8]; u32x4 pw0, pw1, pw2, pw3;
#define PKW(P, B) cvtpk(P[B], P[B + 1])
#define PAF(k) __builtin_bit_cast(bf16x8, pw##k)
#define VFR(i) (bf16x8){vlo[i][0], vlo[i][1], vlo[i][2], vlo[i][3], vhi[i][0], vhi[i][1], vhi[i][2], vhi[i][3]}
#define PIN(x) asm volatile("" : "+v"(x))
#define GAPA(MF, A0, A1, A2, A3, W0, W1, PW) do { MF; sacc += A0; sacc += A1; sacc += A2; sacc += A3; PIN(sacc); W0; W1; PIN(PW); SBAR(); } while (0)
#define EX(v) __builtin_amdgcn_exp2f(v)
#define GAPB4(MF, X, B) do { MF; X[B] = EX(X[B]); X[B + 1] = EX(X[B + 1]); X[B + 2] = EX(X[B + 2]); X[B + 3] = EX(X[B + 3]); PIN(X); SBAR(); } while (0)
#define GAPB3(MF, E0, E1, E2, XA, XB) do { MF; E0 = EX(E0); E1 = EX(E1); E2 = EX(E2); PIN(XA); PIN(XB); SBAR(); } while (0)
#define GAPB2(MF, E0, E1, XA) do { MF; E0 = EX(E0); E1 = EX(E1); PIN(XA); SBAR(); } while (0)
#define VRD(i) do { vlo[i] = vtr(vp_ + (((i) >> 2) * 4096 + ((i) & 3) * 1024)); vhi[i] = vtr(vp_ + (((i) >> 2) * 4096 + ((i) & 3) * 1024 + 512)); } while (0)
#define KRD(G, j) do { if (G) { kload2(kf, kp0 + sl_next, j); SBAR(); } } while (0)
#define PVM(d, k, i) o[d] = __builtin_amdgcn_mfma_f32_32x32x16_bf16(PAF(k), VFR(i), o[d], 0, 0, 0)
#define LSM(k) lsum = __builtin_amdgcn_mfma_f32_32x32x16_bf16(PAF(k), ones, lsum, 0, 0, 0)
#define STEP(C0, C1, P0, P1, t, GK, GV, GL) do { SBAR(); \
    const lds_cptr vp_ = vp0 + sl_prev; \
    VRD(0); SBAR(); float sacc = (P0[0] + P0[1]); \
    GAPA(C0 = __builtin_amdgcn_mfma_f32_32x32x16_bf16(kf[0], qr[0], zero16, 0, 0, 0), P0[2], P0[3], P0[4], P0[5],     pw0[0] = PKW(P0, 0), pw0[1] = PKW(P0, 2), pw0); \
    VRD(4); SBAR(); GAPA(C1 = __builtin_amdgcn_mfma_f32_32x32x16_bf16(kf[1], qr[0], zero16, 0, 0, 0), P0[6], P0[7], P0[8], P0[9],     pw0[2] = PKW(P0, 4), pw0[3] = PKW(P0, 6), pw0); \
    VRD(1); SBAR(); GAPA(C0 = __builtin_amdgcn_mfma_f32_32x32x16_bf16(kf[2], qr[1], C0, 0, 0, 0),   P0[10], P0[11], P0[12], P0[13], pw1[0] = PKW(P0, 8), pw1[1] = PKW(P0, 10), pw1); \
    VRD(5); SBAR(); GAPA(C1 = __builtin_amdgcn_mfma_f32_32x32x16_bf16(kf[3], qr[1], C1, 0, 0, 0),   P0[14], P0[15], P1[0], P1[1],   pw1[2] = PKW(P0, 12), pw1[3] = PKW(P0, 14), pw1); \
    VRD(2); SBAR(); GAPA(C0 = __builtin_amdgcn_mfma_f32_32x32x16_bf16(kf[4], qr[2], C0, 0, 0, 0),   P1[2], P1[3], P1[4], P1[5],     pw2[0] = PKW(P1, 0), pw2[1] = PKW(P1, 2), pw2); \
    VRD(6); SBAR(); GAPA(C1 = __builtin_amdgcn_mfma_f32_32x32x16_bf16(kf[5], qr[2], C1, 0, 0, 0),   P1[6], P1[7], P1[8], P1[9],     pw2[2] = PKW(P1, 4), pw2[3] = PKW(P1, 6), pw2); \
    VRD(3); SBAR(); GAPA(C0 = __builtin_amdgcn_mfma_f32_32x32x16_bf16(kf[6], qr[3], C0, 0, 0, 0),   P1[10], P1[11], P1[12], P1[13], pw3[0] = PKW(P1, 8), pw3[1] = PKW(P1, 10), pw3); \
    VRD(7); SBAR(); GAPA(C1 = __builtin_amdgcn_mfma_f32_32x32x16_bf16(kf[7], qr[3], C1, 0, 0, 0),   P1[14], P1[15], 0.f, 0.f,       pw3[2] = PKW(P1, 12), pw3[3] = PKW(P1, 14), pw3); \
    l_reg += sacc; \
    if (GK) { DMA_K((t) + 3, sl_cur); } if (GV) { DMA_V((t) + 1, sl_next); } \
    SBAR(); \
    GAPB4(PVM(0, 0, 0), C0, 0); \
    GAPB4(PVM(1, 0, 4), C0, 4); \
    KRD(GL, 0); GAPB4(PVM(0, 1, 1), C0, 8); \
    KRD(GL, 1); GAPB4(PVM(1, 1, 5), C0, 12); \
    KRD(GL, 2); GAPB4(PVM(0, 2, 2), C1, 0); \
    KRD(GL, 3); GAPB4(PVM(1, 2, 6), C1, 4); \
    GAPB4(PVM(0, 3, 3), C1, 8); \
    GAPB4(PVM(1, 3, 7), C1, 12); \
    } while (0)
    int t = 1;
    for (; t + 5 < NT; t += 2) {
        STEP(pB0, pB1, pA0, pA1, t, true, true, true);     WAIT_BAR(2); ROT();
        STEP(pA0, pA1, pB0, pB1, t + 1, true, true, true); WAIT_BAR(2); ROT();
    }
#define ENDW(tt) do { if ((tt) + 3 < NT) { WAIT_BAR(2); } else if ((tt) + 2 < NT) { WAIT_BAR(1); } else { WAIT_BAR(0); } } while (0)
    for (; t + 1 < NT; t += 2) {
        STEP(pB0, pB1, pA0, pA1, t, (t + 3 < NT), (t + 1 < NT), (t + 1 < NT));       ENDW(t);     ROT();
        STEP(pA0, pA1, pB0, pB1, t + 1, (t + 4 < NT), (t + 2 < NT), (t + 2 < NT));   ENDW(t + 1); ROT();
    }
    STEP(pB0, pB1, pA0, pA1, NT - 1, false, false, false);
    { float sacc = pB0[0] + pB0[1]; _Pragma("unroll") for (int r = 2; r < 16; ++r) sacc += pB0[r]; _Pragma("unroll") for (int r = 0; r < 16; ++r) sacc += pB1[r]; l_reg += sacc;
      pw0 = (u32x4){PKW(pB0, 0), PKW(pB0, 2), PKW(pB0, 4), PKW(pB0, 6)}; pw1 = (u32x4){PKW(pB0, 8), PKW(pB0, 10), PKW(pB0, 12), PKW(pB0, 14)}; pw2 = (u32x4){PKW(pB1, 0), PKW(pB1, 2), PKW(pB1, 4), PKW(pB1, 6)}; pw3 = (u32x4){PKW(pB1, 8), PKW(pB1, 10), PKW(pB1, 12), PKW(pB1, 14)};
      SBAR(); pv(o, vb0 + sl_cur, PAF(0), PAF(1), PAF(2), PAF(3)); }
#undef PKW
#undef PAF
#undef VFR
#undef PIN
#undef GAPA
#undef GAPB3
#undef GAPB4
#undef GAPB2
#undef EX
#undef VRD
#undef KRD
#undef PVM
#undef LSM
#undef STEP
#undef ENDW
    { auto rr = __builtin_amdgcn_permlane32_swap(__float_as_uint(l_reg), __float_as_uint(l_reg), false, false); l_reg = __uint_as_float(rr[0]) + __uint_as_float(rr[1]); }
    if (hi == 0) wsf[32 + r32] = l_reg; asm volatile("s_waitcnt lgkmcnt(0)" ::: "memory");
    float rli[16];
#pragma unroll
    for (int r = 0; r < 16; ++r) rli[r] = __builtin_amdgcn_rcpf(wsf[32 + crow(r, hi)]);
    bf16* Ow = Op + (long)(q0 + wid * QBLK) * OPITCH;
    { bf16* stg = (bf16*)(shm + LDS_OST) + wid * 2048;
#pragma unroll
      for (int r = 0; r < 16; ++r) { const int orow = crow(r, hi);
#pragma unroll
          for (int d0 = 0; d0 < 2; ++d0) stg[orow * 64 + d0 * 32 + r32] = __float2bfloat16(o[d0][r] * rli[r]); }
      asm volatile("s_waitcnt lgkmcnt(0)" ::: "memory");
#pragma unroll
      for (int i = 0; i < 4; ++i) { const int row = i * 8 + (lane >> 3), ch = lane & 7; const u32x4 v = *(const u32x4*)(stg + row * 64 + ch * 8); *(u32x4*)(Ow + (long)row * OPITCH + ch * 8) = v; } }
    asm volatile("s_waitcnt lgkmcnt(0)\n\ts_barrier" ::: "memory");
#undef DMA_K
#undef DMA_V
#undef ROT
}

__device__ __forceinline__ void attn_unit_a8(const unsigned char* Q8p, const unsigned char* __restrict__ K8p, const unsigned char* __restrict__ VT8p, bf16* Op, int q0, float negR, char* shm, int wv) {
    constexpr int A8_K = 0, A8_V = 16384, A8_OST = 32768, A8_SLOT = 4096;
    int tid_ = ltid(wv);
    const int tid = tid_, lane = tid & 63, r32 = lane & 31, hi = lane >> 5; const int wid = __builtin_amdgcn_readfirstlane(tid >> 6);
    const unsigned lds0 = (unsigned)(uintptr_t)shm;
    const bool kwave = wid < 4;
    const unsigned char* dsrc = kwave ? K8p + (long)lane * 128 + wid * 16 : VT8p + (long)lane * SEQ + (wid - 4) * 16;
    const long dstep = kwave ? 64 * 128 : 64;
    const unsigned ddst = lds0 + (kwave ? A8_K + wid * 1024 : A8_V + (wid - 4) * 1024);
#define DMA8(t, slot) glds16(dsrc + (long)(t) * dstep, (unsigned)__builtin_amdgcn_readfirstlane(ddst + (slot)))
    const lds_cptr shm3 = (lds_cptr)shm; const lds_cptr kp0 = shm3 + A8_K + hi * 2048 + r32 * 16, vp0 = shm3 + A8_V + hi * 2048 + r32 * 16;
#define LD8(p) ({ const u32x4 l_ = *(const LAS u32x4*)(p), h_ = *(const LAS u32x4*)((p) + 1024); (v8i32){(int)l_.x, (int)l_.y, (int)l_.z, (int)l_.w, (int)h_.x, (int)h_.y, (int)h_.z, (int)h_.w}; })
    if (kwave) { DMA8(0, 0); DMA8(1, A8_SLOT); DMA8(2, 2 * A8_SLOT); DMA8(3, 3 * A8_SLOT); } else { DMA8(0, 0); DMA8(1, A8_SLOT); }
    v8i32 qf; { const u32x4* qp = (const u32x4*)(Q8p + (long)(q0 + wid * QBLK + r32) * 512 + hi * 32); const u32x4 a = qp[0], b = qp[1]; qf = (v8i32){(int)a.x, (int)a.y, (int)a.z, (int)a.w, (int)b.x, (int)b.y, (int)b.z, (int)b.w}; }
    f32x16 o[2]; o[0] = f32x16{}; o[1] = f32x16{};
    f32x16 cinit;
    { float nr = negR; asm volatile("" : "+v"(nr));
      _Pragma("unroll") for (int r = 0; r < 16; ++r) cinit[r] = nr; }
    asm volatile("" : "+v"(cinit));
    int scK = 0x7F7F7F7F, scQ = 0x7B7B7B7B, scP = 0x7F7F7F7F, scV = 0x7D7D7D7D; asm volatile("" : "+v"(scK), "+v"(scQ), "+v"(scP), "+v"(scV));
#define QK8(D, KF) asm volatile("v_mfma_scale_f32_32x32x64_f8f6f4 %0, %1, %2, %3, %4, %5 op_sel_hi:[0,0,0]" : "=&v"(D) : "v"(KF), "v"(qf), "v"(cinit), "v"(scK), "v"(scQ))
#define PV8(D, PW, VF) asm volatile("s_nop 3\n\tv_mfma_scale_f32_32x32x64_f8f6f4 %0, %1, %2, %0, %3, %4 op_sel_hi:[0,0,0]" : "+v"(D) : "v"(PW), "v"(VF), "v"(scP), "v"(scV))
#define NOPS2(A, B) asm volatile("s_nop 15\n\ts_nop 7" : "+v"(A), "+v"(B))
    f32x16 pA0, pA1, pB0, pB1; v8i32 kfA[2], kfB[2], vf[2], pw = {};
    v8i32 ones; { int o1 = 0x38383838; asm volatile("" : "+v"(o1)); ones = (v8i32){o1, o1, o1, o1, o1, o1, o1, o1}; }
    f32x16 lacc = f32x16{};
#define PVL() asm volatile("v_mfma_scale_f32_32x32x64_f8f6f4 %0, %1, %2, %0, %3, %3 op_sel_hi:[0,0,0]" : "+v"(lacc) : "v"(pw), "v"(ones), "v"(scP))
    int sl_prev = 0, sl_cur = 0, sl_next = A8_SLOT, sl_n2 = 2 * A8_SLOT;
#define ROT() do { sl_prev = sl_cur; sl_cur = sl_next; sl_next = sl_n2; sl_n2 = (sl_n2 == 3 * A8_SLOT) ? 0 : sl_n2 + A8_SLOT; } while (0)
    WAIT_BAR(3);
    kfB[0] = LD8(kp0); kfB[1] = LD8(kp0 + 512);
    QK8(pA0, kfB[0]); QK8(pA1, kfB[1]); NOPS2(pA0, pA1);
    _Pragma("unroll") for (int r = 0; r < 16; ++r) { pA0[r] = __builtin_amdgcn_exp2f(pA0[r]); pA1[r] = __builtin_amdgcn_exp2f(pA1[r]); }
    WAIT_BAR(0);
    if (kwave) { DMA8(4, 0); } else { DMA8(2, 2 * A8_SLOT); }
    ROT();
    kfA[0] = LD8(kp0 + sl_cur); kfA[1] = LD8(kp0 + sl_cur + 512);
    WAIT_BAR(1);
#define PK2(W, a, b, c, d) do { W = __builtin_amdgcn_cvt_pk_fp8_f32(a, b, W, false); W = __builtin_amdgcn_cvt_pk_fp8_f32(c, d, W, true); } while (0)
#define PACKH(W0, PP) do { PK2(pw[W0], PP[0], PP[1], PP[2], PP[3]); PK2(pw[W0 + 1], PP[4], PP[5], PP[6], PP[7]); PK2(pw[W0 + 2], PP[8], PP[9], PP[10], PP[11]); PK2(pw[W0 + 3], PP[12], PP[13], PP[14], PP[15]); } while (0)
#define STEP8(C0, C1, P0, P1, t, GK, GV, GL, KC, KN) do { SBAR(); \
    vf[0] = LD8(vp0 + sl_prev); vf[1] = LD8(vp0 + sl_prev + 512); \
    QK8(C0, KC[0]); SBAR(); \
    PACKH(0, P0); asm volatile("" : "+v"(pw)); SBAR(); \
    QK8(C1, KC[1]); \
    if (GL) { KN[0] = LD8(kp0 + sl_next); KN[1] = LD8(kp0 + sl_next + 512); } \
    SBAR(); asm volatile("" :: "v"(KC[0]), "v"(KC[1]));     \
    PACKH(4, P1); asm volatile("" : "+v"(pw)); \
    if (kwave) { if (GK) { DMA8((t) + 4, sl_cur); } } else { if (GV) { DMA8((t) + 2, sl_n2); } } \
    SBAR(); \
    PV8(o[0], pw, vf[0]); SBAR(); \
    asm volatile("s_nop 1" : "+v"(C0));              \
    _Pragma("unroll") for (int r = 0; r < 16; ++r) C0[r] = __builtin_amdgcn_exp2f(C0[r]); \
    asm volatile("" : "+v"(C0)); SBAR(); \
    PV8(o[1], pw, vf[1]); SBAR(); \
    asm volatile("" : "+v"(C1)); \
    _Pragma("unroll") for (int r = 0; r < 8; ++r) C1[r] = __builtin_amdgcn_exp2f(C1[r]); \
    asm volatile("" : "+v"(C1)); SBAR(); \
    PVL(); SBAR(); \
    asm volatile("" : "+v"(C1)); \
    _Pragma("unroll") for (int r = 8; r < 16; ++r) C1[r] = __builtin_amdgcn_exp2f(C1[r]); \
    asm volatile("" : "+v"(C1));                     \
    SBAR(); \
    } while (0)
    int t = 1;
    for (; t + 5 < NT; t += 2) {
        STEP8(pB0, pB1, pA0, pA1, t, true, true, true, kfA, kfB);     WAIT_BAR(2); ROT();
        STEP8(pA0, pA1, pB0, pB1, t + 1, true, true, true, kfB, kfA); WAIT_BAR(2); ROT();
    }
#define ENDW8(tt) do { WAIT_BAR(0); } while (0)
    for (; t + 1 < NT; t += 2) {
        STEP8(pB0, pB1, pA0, pA1, t, (t + 4 < NT), (t + 2 < NT), (t + 1 < NT), kfA, kfB);       ENDW8(t);     ROT();
        STEP8(pA0, pA1, pB0, pB1, t + 1, (t + 5 < NT), (t + 3 < NT), (t + 2 < NT), kfB, kfA);   ENDW8(t + 1); ROT();
    }
    STEP8(pB0, pB1, pA0, pA1, NT - 1, false, false, false, kfA, kfB);
    { PACKH(0, pB0); PACKH(4, pB1); vf[0] = LD8(vp0 + sl_cur); vf[1] = LD8(vp0 + sl_cur + 512);
      PV8(o[0], pw, vf[0]); PV8(o[1], pw, vf[1]); PVL(); NOPS2(o[0], o[1]); asm volatile("s_nop 15\n\ts_nop 7" : "+v"(lacc)); }
#undef PK2
#undef PACKH
#undef PVL
#undef STEP8
#undef ENDW8
#undef PACK8
#undef NOPS2
#undef PV8
#undef QK8
#undef LD8
#undef ROT
#undef DMA8
    float rli[16];
#pragma unroll
    for (int r = 0; r < 16; ++r) rli[r] = __builtin_amdgcn_rcpf(lacc[r]);
    bf16* Ow = Op + (long)(q0 + wid * QBLK) * OPITCH;
    { bf16* stg = (bf16*)(shm + A8_OST) + wid * 2048;
#pragma unroll
      for (int r = 0; r < 16; ++r) { const int orow = crow(r, hi);
#pragma unroll
          for (int d0 = 0; d0 < 2; ++d0) stg[orow * 64 + d0 * 32 + r32] = __float2bfloat16(o[d0][r] * rli[r]); }
      asm volatile("s_waitcnt lgkmcnt(0)" ::: "memory");
#pragma unroll
      for (int i = 0; i < 4; ++i) { const int row = i * 8 + (lane >> 3), ch = lane & 7; const u32x4 v = *(const u32x4*)(stg + row * 64 + ch * 8); *(u32x4*)(Ow + (long)row * OPITCH + ch * 8) = v; } }
    asm volatile("s_waitcnt lgkmcnt(0)\n\ts_barrier" ::: "memory");
}

__device__ __forceinline__ void b_pair_epilogue(f32x16 (&o)[4], const float (&rli)[16], int m, float lam, const float* subln, bf16* Ow, char* shm, int wid, int lane, int r32, int hi) {
    bf16* st = (bf16*)(shm + LDS_STASH) + wid * 4096;
    if (m == 0) {
#pragma unroll
        for (int r = 0; r < 16; ++r) { const int orow = crow(r, hi);
#pragma unroll
            for (int d0 = 0; d0 < 4; ++d0) st[orow * 128 + d0 * 32 + r32] = __float2bfloat16(o[d0][r] * rli[r]); }
    } else {
        float sg[4];
#pragma unroll
        for (int d0 = 0; d0 < 4; ++d0) sg[d0] = subln[d0 * 32 + r32] * (1.f - LAM_INIT);
        bf16* stg = (bf16*)shm + wid * 4096;
#pragma unroll
        for (int r = 0; r < 16; ++r) { const int orow = crow(r, hi); float ss = 0.f;
#pragma unroll
            for (int d0 = 0; d0 < 4; ++d0) { const float df = __bfloat162float(st[orow * 128 + d0 * 32 + r32]) - lam * (o[d0][r] * rli[r]); o[d0][r] = df; ss += df * df; }
            ss += swz_xor<1>(ss); ss += swz_xor<2>(ss); ss += swz_xor<4>(ss); ss += swz_xor<8>(ss); ss += swz_xor<16>(ss);
            const float rinv = 1.0f / sqrtf(ss * (1.f / 128.f) + LN_EPS);
#pragma unroll
            for (int d0 = 0; d0 < 4; ++d0) stg[orow * 128 + d0 * 32 + r32] = __float2bfloat16(o[d0][r] * rinv * sg[d0]); }
        asm volatile("s_waitcnt lgkmcnt(0)" ::: "memory");
#pragma unroll
        for (int i = 0; i < 8; ++i) { const int row = i * 4 + (lane >> 4), ch = lane & 15; const u32x4 v = *(const u32x4*)(stg + row * 128 + ch * 8); *(u32x4*)(Ow + (long)row * OPITCH + ch * 8) = v; }
    }
    asm volatile("s_waitcnt lgkmcnt(0)\n\ts_barrier" ::: "memory");
}
constexpr int V2_SLOTV = 16384, V2_LDS_V = NSLOT * SLOTB, V2_LDS_WS = V2_LDS_V + NSLOT * V2_SLOTV;
template <int THRL> __device__ __forceinline__ void attn_unit_v128(const bf16* Qp, const bf16* __restrict__ Kp, const bf16* __restrict__ Vp, bf16* Op, int q0, float cL, float cR, int tabofs, int m, float lam, const float* subln, char* shm, int wv) {
    int tid_ = ltid(wv);
    const int tid = tid_, lane = tid & 63, r32 = lane & 31, hi = lane >> 5; const int wid = __builtin_amdgcn_readfirstlane(tid >> 6);
    const bf16* Qw = Qp + (long)(q0 + wid * QBLK) * PITCH;
    const unsigned lds0 = (unsigned)(uintptr_t)shm;
    float* wsf = (float*)(shm + V2_LDS_WS) + wid * 64;
    const bf16* ksrc = Kp + (long)lane * PITCH + wid * 8;
    const bf16* vsrc = Vp + (long)(16 * (wid & 3) + (lane >> 2)) * PITCH + (wid >> 2) * 32 + (lane & 3) * 8;
    const unsigned kdst = lds0 + LDS_K + wid * 1024, vdst = lds0 + V2_LDS_V + wid * 1024;
#define DMA_K(t, slot) glds16(ksrc + (long)(t) * KVBLK * PITCH, (unsigned)__builtin_amdgcn_readfirstlane(kdst + (slot)))
#define DMA_V(t, slot) do { glds16(vsrc + (long)(t) * KVBLK * PITCH, (unsigned)__builtin_amdgcn_readfirstlane(vdst + 2 * (slot))); \
                            glds16(vsrc + (long)(t) * KVBLK * PITCH + 64, (unsigned)__builtin_amdgcn_readfirstlane(vdst + 2 * (slot) + 8192)); } while (0)
    const int vb0 = (int)(lds0 + V2_LDS_V) + ((lane >> 4) & 1) * 32 + (lane & 3) * 8 + (4 * hi + ((lane & 15) >> 2)) * 64;
    const char* Kbase = shm + LDS_K; bf16x8 kf[8];
    const lds_cptr shm3 = (lds_cptr)shm; const lds_cptr kp0 = shm3 + LDS_K + hi * 1024 + r32 * 16; const lds_cptr vp0 = shm3 + V2_LDS_V + ((lane >> 4) & 1) * 32 + (lane & 3) * 8 + (4 * hi + ((lane & 15) >> 2)) * 64;
    const int q0w = q0 + wid * QBLK;
    const LAS float* tabl = (const LAS float*)(shm3 + tabofs) + (256 - r32 + 4 * hi);
#define BCONST_T(t) ((64 * (t) - q0w <= -160) ? cL : ((64 * (t) - q0w >= 128) ? cR : 0.f))
#define BIASADD(C0, C1, t) do { const int dk_ = 64 * (t) - q0w; if (dk_ >= -128 && dk_ <= 96) { const LAS float* tb_ = tabl + dk_; \
      _Pragma("unroll") for (int r = 0; r < 16; ++r) { C0[r] += tb_[(r & 3) + 8 * (r >> 2)]; C1[r] += tb_[(r & 3) + 8 * (r >> 2) + 32]; } } } while (0)
    DMA_K(0, 0); DMA_V(0, 0); DMA_K(1, SLOTB);
    bf16x8 qr[4];
#pragma unroll
    for (int d0 = 0; d0 < 4; ++d0) qr[d0] = *reinterpret_cast<const bf16x8*>(&Qw[(long)r32 * PITCH + d0 * 16 + hi * 8]);
    float mhat = 0.f, moff = 0.f, l_reg = 0.f; f32x16 o[4]; o[0] = f32x16{}; o[1] = f32x16{}; o[2] = f32x16{}; o[3] = f32x16{};
    const f32x16 zero16 = f32x16{};
    bool resc = false;
#define RESC() do { if (resc) { asm volatile("s_waitcnt lgkmcnt(0)" ::: "memory"); \
      _Pragma("unroll") for (int d_ = 0; d_ < 4; ++d_) _Pragma("unroll") for (int r = 0; r < 16; ++r) o[d_][r] *= wsf[crow(r, hi)]; } } while (0)
    f32x16 pA0, pA1, pB0, pB1;
    int sl_prev = 0, sl_cur = 0, sl_next = SLOTB;
#define ROT() do { sl_prev = sl_cur; sl_cur = sl_next; sl_next = (sl_next == (NSLOT - 1) * SLOTB) ? 0 : sl_next + SLOTB; } while (0)
    DMA_K(2, 2 * SLOTB);
    WAIT_BAR(4);
    qkt(pA0, pA1, Kbase, qr, zero16, r32, hi); asm volatile("s_nop 15\n\ts_nop 7" : "+v"(pA0), "+v"(pA1)); BIASADD(pA0, pA1, 0);
    { const float rm = rowmax(pA0, pA1); mhat = rm + BCONST_T(0); moff = rm;
      _Pragma("unroll") for (int r = 0; r < 16; ++r) { pA0[r] = __builtin_amdgcn_exp2f(pA0[r] - moff); pA1[r] = __builtin_amdgcn_exp2f(pA1[r] - moff); } }
    WAIT_BAR(0);
    DMA_K(3, 0); DMA_V(1, SLOTB);
    ROT();
    kload8(kf, kp0 + sl_cur);
    WAIT_BAR(3);
    s16x4 vlo[16], vhi[16]; u32x4 pw0, pw1, pw2, pw3;
#define PKW(P, B) cvtpk(P[B], P[B + 1])
#define PAF(k) __builtin_bit_cast(bf16x8, pw##k)
#define VFR(i) (bf16x8){vlo[i][0], vlo[i][1], vlo[i][2], vlo[i][3], vhi[i][0], vhi[i][1], vhi[i][2], vhi[i][3]}
#define PIN(x) asm volatile("" : "+v"(x))
#define MX3(a, b, c) __builtin_fmaxf(__builtin_fmaxf((a), (b)), (c))
#define GAPA(MF, A0, A1, A2, A3, W0, W1, PW) do { MF; sacc += A0; sacc += A1; sacc += A2; sacc += A3; PIN(sacc); W0; W1; PIN(PW); SBAR(); } while (0)
#define EX(v) __builtin_amdgcn_exp2f((v) - moff)
#define GAPB(MF, X, B) do { MF; X[B] = EX(X[B]); X[B + 1] = EX(X[B + 1]); PIN(X); SBAR(); } while (0)
#define VRD(i) do { vlo[i] = vtr(vp_ + (((i) >> 2) * 4096 + ((i) & 3) * 1024)); vhi[i] = vtr(vp_ + (((i) >> 2) * 4096 + ((i) & 3) * 1024 + 512)); } while (0)
#define KRD(G, j) do { if (G) { kload2(kf, kp0 + sl_next, j); SBAR(); } } while (0)
#define PVM(d, k, i) o[d] = __builtin_amdgcn_mfma_f32_32x32x16_bf16(PAF(k), VFR(i), o[d], 0, 0, 0)
#define STEP(C0, C1, P0, P1, t, GK, GV, GL) do { SBAR(); \
    const lds_cptr vp_ = vp0 + 2 * sl_prev; \
    VRD(0); SBAR(); float sacc = (P0[0] + P0[1]); \
    GAPA(C0 = __builtin_amdgcn_mfma_f32_32x32x16_bf16(kf[0], qr[0], zero16, 0, 0, 0), P0[2], P0[3], P0[4], P0[5],     pw0[0] = PKW(P0, 0), pw0[1] = PKW(P0, 2), pw0); \
    VRD(4); SBAR(); GAPA(C1 = __builtin_amdgcn_mfma_f32_32x32x16_bf16(kf[1], qr[0], zero16, 0, 0, 0), P0[6], P0[7], P0[8], P0[9],     pw0[2] = PKW(P0, 4), pw0[3] = PKW(P0, 6), pw0); \
    VRD(1); SBAR(); GAPA(C0 = __builtin_amdgcn_mfma_f32_32x32x16_bf16(kf[2], qr[1], C0, 0, 0, 0),   P0[10], P0[11], P0[12], P0[13], pw1[0] = PKW(P0, 8), pw1[1] = PKW(P0, 10), pw1); \
    VRD(5); SBAR(); GAPA(C1 = __builtin_amdgcn_mfma_f32_32x32x16_bf16(kf[3], qr[1], C1, 0, 0, 0),   P0[14], P0[15], P1[0], P1[1],   pw1[2] = PKW(P0, 12), pw1[3] = PKW(P0, 14), pw1); \
    VRD(2); SBAR(); GAPA(C0 = __builtin_amdgcn_mfma_f32_32x32x16_bf16(kf[4], qr[2], C0, 0, 0, 0),   P1[2], P1[3], P1[4], P1[5],     pw2[0] = PKW(P1, 0), pw2[1] = PKW(P1, 2), pw2); \
    VRD(6); SBAR(); GAPA(C1 = __builtin_amdgcn_mfma_f32_32x32x16_bf16(kf[5], qr[2], C1, 0, 0, 0),   P1[6], P1[7], P1[8], P1[9],     pw2[2] = PKW(P1, 4), pw2[3] = PKW(P1, 6), pw2); \
    VRD(3); SBAR(); GAPA(C0 = __builtin_amdgcn_mfma_f32_32x32x16_bf16(kf[6], qr[3], C0, 0, 0, 0),   P1[10], P1[11], P1[12], P1[13], pw3[0] = PKW(P1, 8), pw3[1] = PKW(P1, 10), pw3); \
    VRD(7); SBAR(); GAPA(C1 = __builtin_amdgcn_mfma_f32_32x32x16_bf16(kf[7], qr[3], C1, 0, 0, 0),   P1[14], P1[15], 0.f, 0.f,       pw3[2] = PKW(P1, 12), pw3[3] = PKW(P1, 14), pw3); \
    l_reg += sacc; \
    if (GK) { DMA_K((t) + 3, sl_cur); } if (GV) { DMA_V((t) + 1, sl_next); } \
    BIASADD(C0, C1, t); \
    { float a = MX3(C0[0], C0[1], C1[0]), b = MX3(C0[2], C0[3], C1[1]); a = MX3(a, C1[2], C1[3]); \
      _Pragma("unroll") for (int r = 4; r < 16; r += 4) { a = MX3(a, C0[r], C0[r + 1]); b = MX3(b, C0[r + 2], C0[r + 3]); a = MX3(a, C1[r], C1[r + 1]); b = MX3(b, C1[r + 2], C1[r + 3]); } \
      float rm = __builtin_fmaxf(a, b); { auto rr = __builtin_amdgcn_permlane32_swap(__float_as_uint(rm), __float_as_uint(rm), false, false); rm = __builtin_fmaxf(__uint_as_float(rr[0]), __uint_as_float(rr[1])); } \
      const float cbt_ = BCONST_T(t); rm = rm + cbt_ - mhat; \
      resc = false; \
      if (__builtin_expect(__any(rm > (float)THRL), 0)) { const float dl = __builtin_fmaxf(rm, 0.f); mhat += dl; \
        const float f = __builtin_amdgcn_exp2f(-dl); l_reg *= f; if (hi == 0) wsf[r32] = f; resc = true; } \
      moff = mhat - cbt_; } \
    SBAR(); \
    GAPB(PVM(0, 0, 0), C0, 0);  VRD(8);  SBAR(); \
    GAPB(PVM(1, 0, 4), C0, 2);  VRD(12); SBAR(); \
    GAPB(PVM(0, 1, 1), C0, 4);  VRD(9);  SBAR(); \
    GAPB(PVM(1, 1, 5), C0, 6);  VRD(13); SBAR(); \
    KRD(GL, 0); GAPB(PVM(0, 2, 2), C0, 8);  VRD(10); SBAR(); \
    GAPB(PVM(1, 2, 6), C0, 10); VRD(14); SBAR(); \
    KRD(GL, 1); GAPB(PVM(0, 3, 3), C0, 12); VRD(11); SBAR(); \
    GAPB(PVM(1, 3, 7), C0, 14); VRD(15); SBAR(); \
    KRD(GL, 2); GAPB(PVM(2, 0, 8), C1, 0); \
    GAPB(PVM(3, 0, 12), C1, 2); \
    KRD(GL, 3); GAPB(PVM(2, 1, 9), C1, 4); \
    GAPB(PVM(3, 1, 13), C1, 6); \
    GAPB(PVM(2, 2, 10), C1, 8); \
    GAPB(PVM(3, 2, 14), C1, 10); \
    GAPB(PVM(2, 3, 11), C1, 12); \
    GAPB(PVM(3, 3, 15), C1, 14); \
    } while (0)
    int t = 1;
    for (; t + 5 < NT; t += 2) {
        STEP(pB0, pB1, pA0, pA1, t, true, true, true);     WAIT_BAR(3); RESC(); ROT();
        STEP(pA0, pA1, pB0, pB1, t + 1, true, true, true); WAIT_BAR(3); RESC(); ROT();
    }
#define ENDW(tt) do { if ((tt) + 3 < NT) { WAIT_BAR(3); } else if ((tt) + 2 < NT) { WAIT_BAR(2); } else { WAIT_BAR(0); } } while (0)
    for (; t + 1 < NT; t += 2) {
        STEP(pB0, pB1, pA0, pA1, t, (t + 3 < NT), (t + 1 < NT), (t + 1 < NT));       ENDW(t);     RESC(); ROT();
        STEP(pA0, pA1, pB0, pB1, t + 1, (t + 4 < NT), (t + 2 < NT), (t + 2 < NT));   ENDW(t + 1); RESC(); ROT();
    }
    STEP(pB0, pB1, pA0, pA1, NT - 1, false, false, false); RESC();
    { float sacc = pB0[0] + pB0[1]; _Pragma("unroll") for (int r = 2; r < 16; ++r) sacc += pB0[r]; _Pragma("unroll") for (int r = 0; r < 16; ++r) sacc += pB1[r]; l_reg += sacc;
      pw0 = (u32x4){PKW(pB0, 0), PKW(pB0, 2), PKW(pB0, 4), PKW(pB0, 6)}; pw1 = (u32x4){PKW(pB0, 8), PKW(pB0, 10), PKW(pB0, 12), PKW(pB0, 14)}; pw2 = (u32x4){PKW(pB1, 0), PKW(pB1, 2), PKW(pB1, 4), PKW(pB1, 6)}; pw3 = (u32x4){PKW(pB1, 8), PKW(pB1, 10), PKW(pB1, 12), PKW(pB1, 14)};
      SBAR(); pv(o, vb0 + 2 * sl_cur, PAF(0), PAF(1), PAF(2), PAF(3)); pv(o + 2, vb0 + 2 * sl_cur + 8192, PAF(0), PAF(1), PAF(2), PAF(3)); }
#undef PKW
#undef PAF
#undef VFR
#undef PIN
#undef MX3
#undef GAPA
#undef GAPB
#undef EX
#undef VRD
#undef KRD
#undef PVM
#undef STEP
#undef ENDW
    { auto rr = __builtin_amdgcn_permlane32_swap(__float_as_uint(l_reg), __float_as_uint(l_reg), false, false); l_reg = __uint_as_float(rr[0]) + __uint_as_float(rr[1]); }
    if (hi == 0) wsf[32 + r32] = l_reg;
    asm volatile("s_waitcnt lgkmcnt(0)\n\ts_barrier" ::: "memory");
    float rli[16];
#pragma unroll
    for (int r = 0; r < 16; ++r) rli[r] = __builtin_amdgcn_rcpf(wsf[32 + crow(r, hi)]);
    b_pair_epilogue(o, rli, m, lam, subln, Op + (long)(q0 + wid * QBLK) * OPITCH, shm, wid, lane, r32, hi);
#undef DMA_K
#undef DMA_V
#undef BCONST_T
#undef BIASADD
#undef RESC
#undef ROT
}
__device__ __forceinline__ void attn_unit_v128nm(const bf16* Qp, const bf16* __restrict__ Kp, const bf16* __restrict__ Vp, bf16* Op, int q0, float cL, float cR, int tabofs, int m, float lam, const float* subln, char* shm, int wv) {
    int tid_ = ltid(wv);
    const int tid = tid_, lane = tid & 63, r32 = lane & 31, hi = lane >> 5; const int wid = __builtin_amdgcn_readfirstlane(tid >> 6);
    const bf16* Qw = Qp + (long)(q0 + wid * QBLK) * PITCH;
    const unsigned lds0 = (unsigned)(uintptr_t)shm;
    float* wsf = (float*)(shm + V2_LDS_WS) + wid * 64;
    const bf16* ksrc = Kp + (long)lane * PITCH + wid * 8;
    const bf16* vsrc = Vp + (long)(16 * (wid & 3) + (lane >> 2)) * PITCH + (wid >> 2) * 32 + (lane & 3) * 8;
    const unsigned kdst = lds0 + LDS_K + wid * 1024, vdst = lds0 + V2_LDS_V + wid * 1024;
#define DMA_K(t, slot) glds16(ksrc + (long)(t) * KVBLK * PITCH, (unsigned)__builtin_amdgcn_readfirstlane(kdst + (slot)))
#define DMA_V(t, slot) do { glds16(vsrc + (long)(t) * KVBLK * PITCH, (unsigned)__builtin_amdgcn_readfirstlane(vdst + 2 * (slot))); \
                            glds16(vsrc + (long)(t) * KVBLK * PITCH + 64, (unsigned)__builtin_amdgcn_readfirstlane(vdst + 2 * (slot) + 8192)); } while (0)
    const int vb0 = (int)(lds0 + V2_LDS_V) + ((lane >> 4) & 1) * 32 + (lane & 3) * 8 + (4 * hi + ((lane & 15) >> 2)) * 64;
    const char* Kbase = shm + LDS_K; bf16x8 kf[8];
    const lds_cptr shm3 = (lds_cptr)shm; const lds_cptr kp0 = shm3 + LDS_K + hi * 1024 + r32 * 16; const lds_cptr vp0 = shm3 + V2_LDS_V + ((lane >> 4) & 1) * 32 + (lane & 3) * 8 + (4 * hi + ((lane & 15) >> 2)) * 64;
    const int q0w = q0 + wid * QBLK;
    const LAS float* tabl = (const LAS float*)(shm3 + tabofs) + (256 - r32 + 4 * hi);
#define BCONST_T(t) ((64 * (t) - q0w <= -160) ? cL : ((64 * (t) - q0w >= 128) ? cR : 0.f))
#define BIASADD(C0, C1, t) do { const int dk_ = 64 * (t) - q0w; if (dk_ >= -128 && dk_ <= 96) { const LAS float* tb_ = tabl + dk_; \
      _Pragma("unroll") for (int r = 0; r < 16; ++r) { C0[r] += tb_[(r & 3) + 8 * (r >> 2)]; C1[r] += tb_[(r & 3) + 8 * (r >> 2) + 32]; } } } while (0)
    DMA_K(0, 0); DMA_V(0, 0); DMA_K(1, SLOTB);
    bf16x8 qr[4];
#pragma unroll
    for (int d0 = 0; d0 < 4; ++d0) qr[d0] = *reinterpret_cast<const bf16x8*>(&Qw[(long)r32 * PITCH + d0 * 16 + hi * 8]);
    float l_reg = 0.f; f32x16 o[4]; o[0] = f32x16{}; o[1] = f32x16{}; o[2] = f32x16{}; o[3] = f32x16{};
    int bmode = (64 * 0 - q0w <= -160) ? 1 : ((64 * 0 - q0w >= 128) ? 2 : 0); f32x16 cbt;
    { const float c0_ = BCONST_T(0); _Pragma("unroll") for (int r = 0; r < 16; ++r) cbt[r] = c0_; } asm volatile("" : "+v"(cbt));
#define CB_UPD(tn) do { const int nm_ = (64 * (tn) - q0w <= -160) ? 1 : ((64 * (tn) - q0w >= 128) ? 2 : 0); if (nm_ != bmode) { bmode = nm_; const float c_ = BCONST_T(tn); \
      _Pragma("unroll") for (int r = 0; r < 16; ++r) cbt[r] = c_; asm volatile("" : "+v"(cbt)); } } while (0)
    f32x16 pA0, pA1, pB0, pB1;
    int sl_prev = 0, sl_cur = 0, sl_next = SLOTB;
#define ROT() do { sl_prev = sl_cur; sl_cur = sl_next; sl_next = (sl_next == (NSLOT - 1) * SLOTB) ? 0 : sl_next + SLOTB; } while (0)
    DMA_K(2, 2 * SLOTB);
    WAIT_BAR(4);
    qkt(pA0, pA1, Kbase, qr, cbt, r32, hi); asm volatile("s_nop 15\n\ts_nop 7" : "+v"(pA0), "+v"(pA1)); BIASADD(pA0, pA1, 0);
    _Pragma("unroll") for (int r = 0; r < 16; ++r) { pA0[r] = __builtin_amdgcn_exp2f(pA0[r]); pA1[r] = __builtin_amdgcn_exp2f(pA1[r]); }
    _Pragma("unroll") for (int r = 0; r < 16; ++r) { l_reg += pA0[r]; l_reg += pA1[r]; }
    WAIT_BAR(0);
    DMA_K(3, 0); DMA_V(1, SLOTB);
    ROT();
    kload8(kf, kp0 + sl_cur);
    CB_UPD(1);
    WAIT_BAR(3);
    s16x4 vlo[16], vhi[16]; u32x4 pw0, pw1, pw2, pw3;
#define PKW(P, B) cvtpk(P[B], P[B + 1])
#define PAF(k) __builtin_bit_cast(bf16x8, pw##k)
#define VFR(i) (bf16x8){vlo[i][0], vlo[i][1], vlo[i][2], vlo[i][3], vhi[i][0], vhi[i][1], vhi[i][2], vhi[i][3]}
#define PIN(x) asm volatile("" : "+v"(x))
#define MX3(a, b, c) __builtin_fmaxf(__builtin_fmaxf((a), (b)), (c))
#define GAPA(MF, W0, W1, PW) do { MF; W0; W1; PIN(PW); SBAR(); } while (0)
#define EX(v) __builtin_amdgcn_exp2f(v)
#define GAPB(MF, X, B, Y, BB) do { MF; X[B] = EX(X[B]); X[B + 1] = EX(X[B + 1]); sacc += Y[BB]; sacc += Y[BB + 1]; PIN(sacc); PIN(X); SBAR(); } while (0)
#define GAPB0(MF, X, B) do { MF; X[B] = EX(X[B]); X[B + 1] = EX(X[B + 1]); PIN(X); SBAR(); } while (0)
#define VRD(i) do { vlo[i] = vtr(vp_ + (((i) >> 2) * 4096 + ((i) & 3) * 1024)); vhi[i] = vtr(vp_ + (((i) >> 2) * 4096 + ((i) & 3) * 1024 + 512)); } while (0)
#define KRD(G, j) do { if (G) { kload2(kf, kp0 + sl_next, j); SBAR(); } } while (0)
#define PVM(d, k, i) o[d] = __builtin_amdgcn_mfma_f32_32x32x16_bf16(PAF(k), VFR(i), o[d], 0, 0, 0)
#define STEP(C0, C1, P0, P1, t, GK, GV, GL) do { SBAR(); \
    const lds_cptr vp_ = vp0 + 2 * sl_prev; \
    VRD(0); SBAR(); float sacc = 0.f; \
    GAPA(C0 = __builtin_amdgcn_mfma_f32_32x32x16_bf16(kf[0], qr[0], cbt, 0, 0, 0), pw0[0] = PKW(P0, 0), pw0[1] = PKW(P0, 2), pw0); \
    VRD(4); SBAR(); GAPA(C1 = __builtin_amdgcn_mfma_f32_32x32x16_bf16(kf[1], qr[0], cbt, 0, 0, 0), pw0[2] = PKW(P0, 4), pw0[3] = PKW(P0, 6), pw0); \
    VRD(1); SBAR(); GAPA(C0 = __builtin_amdgcn_mfma_f32_32x32x16_bf16(kf[2], qr[1], C0, 0, 0, 0),   pw1[0] = PKW(P0, 8), pw1[1] = PKW(P0, 10), pw1); \
    VRD(5); SBAR(); GAPA(C1 = __builtin_amdgcn_mfma_f32_32x32x16_bf16(kf[3], qr[1], C1, 0, 0, 0),   pw1[2] = PKW(P0, 12), pw1[3] = PKW(P0, 14), pw1); \
    VRD(2); SBAR(); GAPA(C0 = __builtin_amdgcn_mfma_f32_32x32x16_bf16(kf[4], qr[2], C0, 0, 0, 0),   pw2[0] = PKW(P1, 0), pw2[1] = PKW(P1, 2), pw2); \
    VRD(6); SBAR(); GAPA(C1 = __builtin_amdgcn_mfma_f32_32x32x16_bf16(kf[5], qr[2], C1, 0, 0, 0),   pw2[2] = PKW(P1, 4), pw2[3] = PKW(P1, 6), pw2); \
    VRD(3); SBAR(); GAPA(C0 = __builtin_amdgcn_mfma_f32_32x32x16_bf16(kf[6], qr[3], C0, 0, 0, 0),   pw3[0] = PKW(P1, 8), pw3[1] = PKW(P1, 10), pw3); \
    VRD(7); SBAR(); GAPA(C1 = __builtin_amdgcn_mfma_f32_32x32x16_bf16(kf[7], qr[3], C1, 0, 0, 0),   pw3[2] = PKW(P1, 12), pw3[3] = PKW(P1, 14), pw3); \
    if (GK) { DMA_K((t) + 3, sl_cur); } if (GV) { DMA_V((t) + 1, sl_next); } \
    BIASADD(C0, C1, t); \
    SBAR(); \
    GAPB0(PVM(0, 0, 0), C0, 0);  VRD(8);  SBAR(); \
    GAPB(PVM(1, 0, 4), C0, 2, C0, 0);  VRD(12); SBAR(); \
    GAPB(PVM(0, 1, 1), C0, 4, C0, 2);  VRD(9);  SBAR(); \
    GAPB(PVM(1, 1, 5), C0, 6, C0, 4);  VRD(13); SBAR(); \
    KRD(GL, 0); GAPB(PVM(0, 2, 2), C0, 8, C0, 6);  VRD(10); SBAR(); \
    GAPB(PVM(1, 2, 6), C0, 10, C0, 8); VRD(14); SBAR(); \
    KRD(GL, 1); GAPB(PVM(0, 3, 3), C0, 12, C0, 10); VRD(11); SBAR(); \
    GAPB(PVM(1, 3, 7), C0, 14, C0, 12); VRD(15); SBAR(); \
    KRD(GL, 2); GAPB(PVM(2, 0, 8), C1, 0, C0, 14); \
    GAPB(PVM(3, 0, 12), C1, 2, C1, 0); \
    KRD(GL, 3); GAPB(PVM(2, 1, 9), C1, 4, C1, 2); \
    GAPB(PVM(3, 1, 13), C1, 6, C1, 4); \
    GAPB(PVM(2, 2, 10), C1, 8, C1, 6); \
    GAPB(PVM(3, 2, 14), C1, 10, C1, 8); \
    GAPB(PVM(2, 3, 11), C1, 12, C1, 10); \
    GAPB(PVM(3, 3, 15), C1, 14, C1, 12); \
    sacc += C1[14]; sacc += C1[15]; l_reg += sacc; \
    } while (0)
    int t = 1;
    for (; t + 5 < NT; t += 2) {
        STEP(pB0, pB1, pA0, pA1, t, true, true, true);     WAIT_BAR(3); ROT(); CB_UPD(t + 1);
        STEP(pA0, pA1, pB0, pB1, t + 1, true, true, true); WAIT_BAR(3); ROT(); CB_UPD(t + 2);
    }
#define ENDW(tt) do { if ((tt) + 3 < NT) { WAIT_BAR(3); } else if ((tt) + 2 < NT) { WAIT_BAR(2); } else { WAIT_BAR(0); } } while (0)
    for (; t + 1 < NT; t += 2) {
        STEP(pB0, pB1, pA0, pA1, t, (t + 3 < NT), (t + 1 < NT), (t + 1 < NT));       ENDW(t);     ROT(); CB_UPD(t + 1);
        STEP(pA0, pA1, pB0, pB1, t + 1, (t + 4 < NT), (t + 2 < NT), (t + 2 < NT));   ENDW(t + 1); ROT(); CB_UPD(t + 2);
    }
    STEP(pB0, pB1, pA0, pA1, NT - 1, false, false, false);
    { pw0 = (u32x4){PKW(pB0, 0), PKW(pB0, 2), PKW(pB0, 4), PKW(pB0, 6)}; pw1 = (u32x4){PKW(pB0, 8), PKW(pB0, 10), PKW(pB0, 12), PKW(pB0, 14)}; pw2 = (u32x4){PKW(pB1, 0), PKW(pB1, 2), PKW(pB1, 4), PKW(pB1, 6)}; pw3 = (u32x4){PKW(pB1, 8), PKW(pB1, 10), PKW(pB1, 12), PKW(pB1, 14)};
      SBAR(); pv(o, vb0 + 2 * sl_cur, PAF(0), PAF(1), PAF(2), PAF(3)); pv(o + 2, vb0 + 2 * sl_cur + 8192, PAF(0), PAF(1), PAF(2), PAF(3)); }
#undef PKW
#undef PAF
#undef VFR
#undef PIN
#undef MX3
#undef GAPA
#undef GAPB
#undef GAPB0
#undef EX
#undef VRD
#undef KRD
#undef PVM
#undef STEP
#undef ENDW
    { auto rr = __builtin_amdgcn_permlane32_swap(__float_as_uint(l_reg), __float_as_uint(l_reg), false, false); l_reg = __uint_as_float(rr[0]) + __uint_as_float(rr[1]); }
    if (hi == 0) wsf[32 + r32] = l_reg;
    asm volatile("s_waitcnt lgkmcnt(0)\n\ts_barrier" ::: "memory");
    float rli[16];
#pragma unroll
    for (int r = 0; r < 16; ++r) rli[r] = __builtin_amdgcn_rcpf(wsf[32 + crow(r, hi)]);
    b_pair_epilogue(o, rli, m, lam, subln, Op + (long)(q0 + wid * QBLK) * OPITCH, shm, wid, lane, r32, hi);
#undef DMA_K
#undef DMA_V
#undef BCONST_T
#undef BIASADD
#undef CB_UPD
#undef ROT
}
#undef SBAR
#undef WAIT_BAR
}

__device__ __forceinline__ void p0_transpose_item(const float* W, int K, int N, bf16_t* WT, int k0, int n0, int rowbase, LAS float* scr, int lane) {
#pragma unroll 8
    for (int i = 0; i < 32; ++i) { const int kk = 2 * i + (lane >> 5); scr[kk * 33 + (lane & 31)] = __builtin_nontemporal_load(W + (size_t)(k0 + kk) * N + n0 + (lane & 31)); }
    LDS_WAIT(); asm volatile("" ::: "memory");
    const int c = lane & 7;
#pragma unroll
    for (int j = 0; j < 4; ++j) { const int n = (lane >> 3) + 8 * j; const LAS float* s = scr + (8 * c) * 33 + n;
        u32x4 o; o.x = cvtpk(s[0 * 33], s[1 * 33]); o.y = cvtpk(s[2 * 33], s[3 * 33]); o.z = cvtpk(s[4 * 33], s[5 * 33]); o.w = cvtpk(s[6 * 33], s[7 * 33]);
        *(u32x4*)(WT + (size_t)(rowbase + n) * K + k0 + 8 * c) = o; }
    LDS_WAIT(); asm volatile("" ::: "memory");
}
__device__ __forceinline__ void p0_transpose_item_q(const float* W, int K, int N, unsigned char* WT, int k0, int n0, int rowbase, LAS float* scr, int lane, float sc) {
#pragma unroll 8
    for (int i = 0; i < 32; ++i) { const int kk = 2 * i + (lane >> 5); scr[kk * 33 + (lane & 31)] = __builtin_nontemporal_load(W + (size_t)(k0 + kk) * N + n0 + (lane & 31)); }
    LDS_WAIT(); asm volatile("" ::: "memory");
    const int c = lane & 7;
#pragma unroll
    for (int j = 0; j < 4; ++j) { const int n = (lane >> 3) + 8 * j; const LAS float* s = scr + (8 * c) * 33 + n;
        u32x2 o; o.x = pk_fp8x4(s[0 * 33] * sc, s[1 * 33] * sc, s[2 * 33] * sc, s[3 * 33] * sc); o.y = pk_fp8x4(s[4 * 33] * sc, s[5 * 33] * sc, s[6 * 33] * sc, s[7 * 33] * sc);
        *(u32x2*)(WT + (size_t)(rowbase + n) * K + k0 + 8 * c) = o; }
    LDS_WAIT(); asm volatile("" ::: "memory");
}
constexpr int I_GU = 16 * 64, I_DN = 32 * 32, N_EXPERT_ITEMS = 16 * (2 * I_GU + I_DN);
struct XItem { const float* src; unsigned char* dst; int N, K; float sc; };
__device__ __forceinline__ XItem xitem(const Params& P, int r) {
    unsigned char* ws = P.ws; XItem x;
    if (r < 16 * I_GU) { const int e = r / I_GU, q = r % I_GU, kb = q / 64, n0 = (q % 64) * 32;
        x.src = P.w_gate + (size_t)e * 1024 * 2048 + (size_t)kb * 64 * 2048 + n0; x.dst = ws + WS_WGU + (size_t)e * 4096 * 1024 + (size_t)((n0 >> 7) * 256 + (n0 & 127)) * 1024 + kb * 64; x.N = 2048; x.K = 1024; x.sc = 32.f; return x; }
    r -= 16 * I_GU;
    if (r < 16 * I_GU) { const int e = r / I_GU, q = r % I_GU, kb = q / 64, n0 = (q % 64) * 32;
        x.src = P.w_up + (size_t)e * 1024 * 2048 + (size_t)kb * 64 * 2048 + n0; x.dst = ws + WS_WGU + (size_t)e * 4096 * 1024 + (size_t)((n0 >> 7) * 256 + 128 + (n0 & 127)) * 1024 + kb * 64; x.N = 2048; x.K = 1024; x.sc = 32.f; return x; }
    r -= 16 * I_GU;
    { const int e = r / I_DN, q = r % I_DN, kb = q / 32, n0 = (q % 32) * 32;
        x.src = P.w_down + (size_t)e * 2048 * 1024 + (size_t)kb * 64 * 1024 + n0; x.dst = ws + WS_WD + (size_t)e * 1024 * WDP + (size_t)n0 * WDP + kb * 64; x.N = 1024; x.K = WDP; x.sc = 64.f; return x; }
}
__device__ __forceinline__ void xitem_load(const XItem& x, f32x4 (&v)[8], int lane) {
    const float* p = x.src + (size_t)(lane >> 3) * x.N + (lane & 7) * 4;
#pragma unroll
    for (int i = 0; i < 8; ++i) v[i] = __builtin_nontemporal_load((const f32x4*)(p + (size_t)(8 * i) * x.N));
}
__device__ __forceinline__ void xitem_store(const XItem& x, const f32x4 (&v)[8], LAS float* scr, int lane) {
    LAS float* w = scr + (lane >> 3) * 33 + (lane & 7) * 4;
#pragma unroll
    for (int i = 0; i < 8; ++i) { w[(8 * i) * 33 + 0] = v[i][0]; w[(8 * i) * 33 + 1] = v[i][1]; w[(8 * i) * 33 + 2] = v[i][2]; w[(8 * i) * 33 + 3] = v[i][3]; }
    LDS_WAIT(); asm volatile("" ::: "memory");
    const int c = lane & 7; const float sc = x.sc;
#pragma unroll
    for (int j = 0; j < 4; ++j) { const int n = (lane >> 3) + 8 * j; const LAS float* s = scr + (8 * c) * 33 + n;
        u32x2 o; o.x = pk_fp8x4(s[0 * 33] * sc, s[1 * 33] * sc, s[2 * 33] * sc, s[3 * 33] * sc); o.y = pk_fp8x4(s[4 * 33] * sc, s[5 * 33] * sc, s[6 * 33] * sc, s[7 * 33] * sc);
        *(u32x2*)(x.dst + (size_t)n * x.K + 8 * c) = o; }
    LDS_WAIT(); asm volatile("" ::: "memory");
}
__device__ __forceinline__ void convert_expert_chunk(const Params& P, int first, int stride, int count, LAS float* scr, int lane) {
    f32x4 va[8], vb[8], vc[8];
    XItem xa = xitem(P, first), xb = xitem(P, first + stride), xc = xitem(P, first + 2 * stride);
    xitem_load(xa, va, lane); xitem_load(xb, vb, lane); xitem_load(xc, vc, lane);
#pragma unroll 1
    for (int j = 0; j < count; j += 3) {
        xitem_store(xa, va, scr, lane);
        if (j + 3 < count) { xa = xitem(P, first + (j + 3) * stride); xitem_load(xa, va, lane); }
        xitem_store(xb, vb, scr, lane);
        if (j + 4 < count) { xb = xitem(P, first + (j + 4) * stride); xitem_load(xb, vb, lane); }
        xitem_store(xc, vc, scr, lane);
        if (j + 5 < count) { xc = xitem(P, first + (j + 5) * stride); xitem_load(xc, vc, lane); }
    }
}
__device__ __forceinline__ void phase_prologue(const Params& P, LAS unsigned char* lds, int vcu, int G, int wv) {
    const int tid = ltid(wv), lane = tid & 63, wave = __builtin_amdgcn_readfirstlane(tid >> 6);
    unsigned char* ws = P.ws;
    LAS float* scr = (LAS float*)(lds + wave * 16384);
    const int gw = vcu * NWAVES + wave, NGW = G * NWAVES;
    constexpr int I_IN = 16 * 72, I_SQ = 16 * 32, I_PP = 4 * 32;
    const int NITEMS = I_IN + 2 * I_SQ + I_PP + (G == 256 ? 0 : N_EXPERT_ITEMS);
    for (int it = gw; it < NITEMS; it += NGW) {
        int r = it;
        if (r < I_IN) { const int nb = 72, kb = r / nb, n0 = (r % nb) * 32; p0_transpose_item(P.w_in, 1024, INW, (bf16_t*)(ws + WS_WIN), kb * 64, n0, n0, scr, lane); continue; } r -= I_IN;
        if (r < I_SQ) { const int kb = r / 32, n0 = (r % 32) * 32; p0_transpose_item(P.w_out, 1024, 1024, (bf16_t*)(ws + WS_WO), kb * 64, n0, n0, scr, lane); continue; } r -= I_SQ;
        if (r < I_SQ) { const int kb = r / 32, n0 = (r % 32) * 32; p0_transpose_item(P.w_pg, 1024, 1024, (bf16_t*)(ws + WS_WPG), kb * 64, n0, n0, scr, lane); continue; } r -= I_SQ;
        if (r < I_PP) { const int kb = r / 32, n0 = (r % 32) * 32; p0_transpose_item(P.w_pp, 256, 1024, (bf16_t*)(ws + WS_WPP), kb * 64, n0, n0, scr, lane); continue; } r -= I_PP;
        if (r < 16 * I_GU) { const int e = r / I_GU, q = r % I_GU, kb = q / 64, n0 = (q % 64) * 32;
            p0_transpose_item_q(P.w_gate + (size_t)e * 1024 * 2048, 1024, 2048, ws + WS_WGU + (size_t)e * 4096 * 1024, kb * 64, n0, (n0 >> 7) * 256 + (n0 & 127), scr, lane, 32.f); continue; } r -= 16 * I_GU;
        if (r < 16 * I_GU) { const int e = r / I_GU, q = r % I_GU, kb = q / 64, n0 = (q % 64) * 32;
            p0_transpose_item_q(P.w_up + (size_t)e * 1024 * 2048, 1024, 2048, ws + WS_WGU + (size_t)e * 4096 * 1024, kb * 64, n0, (n0 >> 7) * 256 + 128 + (n0 & 127), scr, lane, 32.f); continue; } r -= 16 * I_GU;
        { const int e = r / I_DN, q = r % I_DN, kb = q / 32, n0 = (q % 32) * 32;
            p0_transpose_item_q(P.w_down + (size_t)e * 2048 * 1024, WDP, 1024, ws + WS_WD + (size_t)e * 1024 * WDP, kb * 64, n0, n0, scr, lane, 64.f); }
    }
    const long gt = (long)vcu * 512 + tid, NTH = (long)G * 512;
    { const f32x4* src = (const f32x4*)P.x; u32x4* dst = (u32x4*)(ws + WS_RH);
      for (long i = gt; i < (long)MROWS * DMODEL / 8; i += NTH) { const f32x4 a = __builtin_nontemporal_load(src + 2 * i), b = __builtin_nontemporal_load(src + 2 * i + 1); u32x4 o; o.x = cvtpk(a[0], a[1]); o.y = cvtpk(a[2], a[3]); o.z = cvtpk(b[0], b[1]); o.w = cvtpk(b[2], b[3]);
          dst[(i >> 7) * (XBP / 8) + (i & 127)] = o; } }
    if (G != 256) { const f32x4* src = (const f32x4*)P.p; u32x4* dst = (u32x4*)(ws + WS_PB);
      for (long i = gt; i < (long)MROWS * PLE / 8; i += NTH) { const f32x4 a = __builtin_nontemporal_load(src + 2 * i), b = __builtin_nontemporal_load(src + 2 * i + 1); u32x4 o; o.x = cvtpk(a[0], a[1]); o.y = cvtpk(a[2], a[3]); o.z = cvtpk(b[0], b[1]); o.w = cvtpk(b[2], b[3]); dst[i] = o; } }
}

__device__ __forceinline__ void phase_qknorm_rope(const Params& P, LAS unsigned char* lds, int vcu, int G, int wv) {
    const int tid = ltid(wv);
    LAS f32x2* cs = (LAS f32x2*)lds;
    LAS float* gq = (LAS float*)(lds + 16384); LAS float* gk = gq + 64;
    for (int idx = tid; idx < 2048; idx += 512) { const int pos = idx >> 4, i = idx & 15; const float inv = powf(10000.f, -(float)(2 * i) / 32.f); const float ang = (float)pos * inv; cs[idx] = (f32x2){cosf(ang), sinf(ang)}; }
    if (tid < 64) { gq[tid] = P.a_q_norm[tid]; gk[tid] = P.a_k_norm[tid]; }
    __syncthreads();
    bf16_t* cols = (bf16_t*)(P.ws + WS_RH + COLS_OFF);
    const long NTH = (long)G * 512;
    for (long item = (long)vcu * 512 + tid; item < (long)MROWS * 10; item += NTH) {
        const int row = (int)(item / 10), head = (int)(item % 10);
        u32x4* ptr = (u32x4*)(cols + (size_t)row * INW + head * 64);
        float x[64]; float ss = 0.f;
#pragma unroll
        for (int c = 0; c < 8; ++c) { const u32x4 w = ptr[c];
            x[8 * c + 0] = bf_lo(w.x); x[8 * c + 1] = bf_hi(w.x); x[8 * c + 2] = bf_lo(w.y); x[8 * c + 3] = bf_hi(w.y);
            x[8 * c + 4] = bf_lo(w.z); x[8 * c + 5] = bf_hi(w.z); x[8 * c + 6] = bf_lo(w.w); x[8 * c + 7] = bf_hi(w.w); }
#pragma unroll
        for (int d = 0; d < 64; ++d) ss += x[d] * x[d];
        const float rinv = 1.0f / sqrtf(ss * (1.f / 64.f) + QK_EPS);
        const LAS float* g = head < 8 ? gq : gk;
#pragma unroll
        for (int d = 0; d < 64; ++d) x[d] = x[d] * rinv * g[d];
        const int t = row & (SEQ - 1), rp = t >> 6, cp = t & 63;
        const float sc = head < 8 ? C2 : 1.f;
#pragma unroll
        for (int i = 0; i < 16; ++i) {
            const f32x2 a = cs[rp * 16 + i], b = cs[cp * 16 + i];
            const float x1 = x[i], x2 = x[i + 16], y1 = x[32 + i], y2 = x[48 + i];
            x[i] = (x1 * a.x - x2 * a.y) * sc; x[i + 16] = (x2 * a.x + x1 * a.y) * sc;
            x[32 + i] = (y1 * b.x - y2 * b.y) * sc; x[48 + i] = (y2 * b.x + y1 * b.y) * sc;
        }
        const float s8 = head < 8 ? 16.f : 1.f;
        u32x2* q8 = head < 8 ? (u32x2*)((unsigned char*)P.out + OUT_Q8 + (size_t)row * 512 + head * 64) : (u32x2*)((unsigned char*)P.out + OUT_K8 + (size_t)row * 128 + (head - 8) * 64);
#pragma unroll
        for (int c = 0; c < 8; ++c) { u32x4 w; w.x = cvtpk(x[8 * c], x[8 * c + 1]); w.y = cvtpk(x[8 * c + 2], x[8 * c + 3]); w.z = cvtpk(x[8 * c + 4], x[8 * c + 5]); w.w = cvtpk(x[8 * c + 6], x[8 * c + 7]); ptr[c] = w;
            u32x2 e; e.x = pk_fp8x4(x[8 * c] * s8, x[8 * c + 1] * s8, x[8 * c + 2] * s8, x[8 * c + 3] * s8); e.y = pk_fp8x4(x[8 * c + 4] * s8, x[8 * c + 5] * s8, x[8 * c + 6] * s8, x[8 * c + 7] * s8); q8[c] = e;
            asm volatile("" ::: "memory"); }
    }
    __syncthreads();
    {
        const int tid2 = ltid(wv), lane = tid2 & 63, wave = wv;
        LAS unsigned char* tl = lds + wave * 4096;
        const int k5 = lane & 31, pk = 32 * ((k5 >> 2) & 1) + 16 * (lane >> 5) + (k5 & 3) + 4 * (k5 >> 3);
        for (int tile = vcu * NWAVES + wave; tile < BATCH * 2 * (SEQ / 64); tile += G * NWAVES) {
            const int b = tile >> 8, g = (tile >> 7) & 1, tt = tile & 127;
            const u32x4* vr = (const u32x4*)(cols + (size_t)(b * SEQ + tt * 64 + lane) * INW + COL_VA + g * 64);
#pragma unroll
            for (int c = 0; c < 8; ++c) { const u32x4 w = vr[c];
                const unsigned q0 = pk_fp8x4(bf_lo(w.x) * 4.f, bf_hi(w.x) * 4.f, bf_lo(w.y) * 4.f, bf_hi(w.y) * 4.f), q1 = pk_fp8x4(bf_lo(w.z) * 4.f, bf_hi(w.z) * 4.f, bf_lo(w.w) * 4.f, bf_hi(w.w) * 4.f);
#pragma unroll
                for (int j = 0; j < 4; ++j) { tl[(8 * c + j) * 64 + pk] = (unsigned char)(q0 >> (8 * j)); tl[(8 * c + 4 + j) * 64 + pk] = (unsigned char)(q1 >> (8 * j)); } }
            LDS_WAIT(); asm volatile("" ::: "memory");
            u32x4* dst = (u32x4*)((unsigned char*)P.out + OUT_VT8 + ((size_t)((b * 2 + g) * 64 + lane)) * SEQ + tt * 64);
#pragma unroll
            for (int c = 0; c < 4; ++c) dst[c] = *(const LAS u32x4*)(tl + lane * 64 + c * 16);
            LDS_WAIT(); asm volatile("" ::: "memory");
        }
    }
}

__device__ __forceinline__ void phase_attention(const Params& P, unsigned char* ldsg, int vcu, int G, int wv) {
    const int tid = ltid(wv);
    char* shm = (char*)ldsg;
    const attn_body::bf16* cols = (const attn_body::bf16*)(P.ws + WS_RH + COLS_OFF);
    attn_body::bf16* mix = (attn_body::bf16*)(P.ws + WS_R3);
    const float a_bound = 8.f * LOG2E * wave_max(fabsf(P.a_q_norm[tid & 63])) * wave_max(fabsf(P.a_k_norm[tid & 63])) * 1.02f;
    const bool a_bounded = a_bound < 64.f;
    const float a_negR = -fmaxf(a_bound - 8.f, 0.f);
    bool b_bounded;
    { const unsigned* bnd = (const unsigned*)P.ws + 3520;
      const float mq = __uint_as_float(__hip_atomic_load(bnd, __ATOMIC_RELAXED, __HIP_MEMORY_SCOPE_AGENT)), mk = __uint_as_float(__hip_atomic_load(bnd + 64, __ATOMIC_RELAXED, __HIP_MEMORY_SCOPE_AGENT));
      const float bmax = wave_max(fabsf(P.rel_bias[(tid & 63) * 2]) > fabsf(P.rel_bias[(tid & 63) * 2 + 1]) ? fabsf(P.rel_bias[(tid & 63) * 2]) : fabsf(P.rel_bias[(tid & 63) * 2 + 1])) * LOG2E;
      b_bounded = (2.f * sqrtf(mq * mk) + bmax) < 90.f; }
    const float lam = expf(wave_sum(P.lq1[tid & 63] * P.lk1[tid & 63])) - expf(wave_sum(P.lq2[tid & 63] * P.lk2[tid & 63])) + LAM_INIT;
    int ri = 0;
    for (int u = vcu; u < 1536; u += G, ++ri) {
        if (G == 256 && ri == (vcu & 3)) {
            const int lane_ = ltid(wv) & 63;
            LAS float* scr = (LAS float*)((LAS unsigned char*)(uintptr_t)(unsigned)(uintptr_t)shm + 65536 + wv * 8448);
            convert_expert_chunk(P, (vcu & 3) * (N_EXPERT_ITEMS / 4) + (vcu >> 2) * NWAVES + wv, 512, N_EXPERT_ITEMS / 4 / 512, scr, lane_);
            {
                const f32x4* src = (const f32x4*)P.p + 2 * ((long)vcu * 4096); u32x4* dst = (u32x4*)(P.ws + WS_PB) + (long)vcu * 4096; const int t_ = ltid(wv);
                f32x4 a[8], b2[8];
#pragma unroll
                for (int j = 0; j < 8; ++j) { a[j] = __builtin_nontemporal_load(src + 2 * (t_ + 512 * j)); b2[j] = __builtin_nontemporal_load(src + 2 * (t_ + 512 * j) + 1); }
#pragma unroll
                for (int j = 0; j < 8; ++j) { u32x4 o; o.x = cvtpk(a[j][0], a[j][1]); o.y = cvtpk(a[j][2], a[j][3]); o.z = cvtpk(b2[j][0], b2[j][1]); o.w = cvtpk(b2[j][2], b2[j][3]); dst[t_ + 512 * j] = o; }
            }
            __syncthreads();
        }
        const int i = u >> 8, v = u & 255, x = v >> 5, qb = v & 31, b = x >> 1;
        const attn_body::bf16* base = cols + (size_t)b * SEQ * INW;
        if (i < 4) { const int g = x & 1, h = g * 4 + i;
            if (a_bounded) attn_body::attn_unit_a8((const unsigned char*)P.out + OUT_Q8 + (size_t)b * SEQ * 512 + h * 64, (const unsigned char*)P.out + OUT_K8 + (size_t)b * SEQ * 128 + g * 64,
                                                   (const unsigned char*)P.out + OUT_VT8 + (size_t)((b * 2 + g) * 64) * SEQ, mix + (size_t)b * SEQ * DMODEL + h * 64, qb * 256, a_negR, shm, wv);
            else attn_body::attn_unit<8>(base + COL_QA + h * 64, base + COL_KA + g * 64, base + COL_VA + g * 64, mix + (size_t)b * SEQ * DMODEL + h * 64, qb * 256, shm, wv); }
        else { const int h = (x & 1) * 2 + (i - 4);
            {
                float* tab = (float*)(shm + attn_body::LDS_TAB);
                const int idx = tid, rel = idx - 256, n = rel < 0 ? -rel : rel;
                int bk = (n < 8) ? n : (2 + (31 - __builtin_clz((unsigned)(n * n)))); if (bk > 15) bk = 15;
                bk += (rel > 0) ? 16 : 0;
                tab[idx] = P.rel_bias[bk * 4 + h] * LOG2E;
                __syncthreads();
            }
            const float cL = P.rel_bias[15 * 4 + h] * LOG2E, cR = P.rel_bias[31 * 4 + h] * LOG2E;
            attn_body::bf16* Ob = mix + (size_t)b * SEQ * DMODEL + 512 + h * 128;
#pragma unroll 1
            for (int m = 0; m < 2; ++m) {
                if (b_bounded) attn_body::attn_unit_v128nm(base + COL_QB + (h * 2 + m) * 64, base + COL_KB + (h * 2 + m) * 64, base + COL_VB + h * 128, Ob, qb * 256, cL, cR, attn_body::LDS_TAB, m, lam, P.subln, shm, wv);
                else attn_body::attn_unit_v128<8>(base + COL_QB + (h * 2 + m) * 64, base + COL_KB + (h * 2 + m) * 64, base + COL_VB + h * 128, Ob, qb * 256, cL, cR, attn_body::LDS_TAB, m, lam, P.subln, shm, wv);
            }
        }
    }
}

__device__ __forceinline__ void ln_row(f32x4 (&v)[4], const float* g, const float* bta, int lane) {
    float s = 0.f;
#pragma unroll
    for (int j = 0; j < 4; ++j) s += (v[j][0] + v[j][1]) + (v[j][2] + v[j][3]);
    const float mean = wave_sum(s) * (1.f / DMODEL); float s2 = 0.f;
#pragma unroll
    for (int j = 0; j < 4; ++j) { v[j] = v[j] - mean; s2 += (v[j][0] * v[j][0] + v[j][1] * v[j][1]) + (v[j][2] * v[j][2] + v[j][3] * v[j][3]); }
    const float rstd = 1.0f / sqrtf(wave_sum(s2) * (1.f / DMODEL) + LN_EPS);
#pragma unroll
    for (int j = 0; j < 4; ++j) { const f32x4 gg = *(const f32x4*)(g + 256 * j + 4 * lane), bb = *(const f32x4*)(bta + 256 * j + 4 * lane); v[j] = v[j] * rstd * gg + bb; }
}
__device__ __forceinline__ void load_row_raw(const bf16_t* irow, u32x2 (&w)[4], int lane) {
#pragma unroll
    for (int j = 0; j < 4; ++j) w[j] = *(const u32x2*)(irow + 256 * j + 4 * lane);
}
__device__ __forceinline__ void cvt_row_raw(const u32x2 (&w)[4], f32x4 (&v)[4]) {
#pragma unroll
    for (int j = 0; j < 4; ++j) v[j] = (f32x4){bf_lo(w[j].x), bf_hi(w[j].x), bf_lo(w[j].y), bf_hi(w[j].y)};
}
__device__ __forceinline__ void load_row_bf16(const bf16_t* irow, f32x4 (&v)[4], int lane) {
#pragma unroll
    for (int j = 0; j < 4; ++j) { const u32x2 w = *(const u32x2*)(irow + 256 * j + 4 * lane); v[j] = (f32x4){bf_lo(w.x), bf_hi(w.x), bf_lo(w.y), bf_hi(w.y)}; }
}
__device__ __forceinline__ void store_row_bf16(bf16_t* orow, const f32x4 (&v)[4], int lane) {
#pragma unroll
    for (int j = 0; j < 4; ++j) { u32x2 w; w.x = cvtpk(v[j][0], v[j][1]); w.y = cvtpk(v[j][2], v[j][3]); *(u32x2*)(orow + 256 * j + 4 * lane) = w; }
}

__device__ __forceinline__ float router_reduce16(const f32x4 (&lgv)[4], int lane) {
    float b[8], c[4], d[2];
#pragma unroll
    for (int e = 0; e < 8; ++e) { auto rr = __builtin_amdgcn_permlane32_swap(__float_as_uint(lgv[e >> 2][e & 3]), __float_as_uint(lgv[2 + (e >> 2)][e & 3]), false, false); b[e] = __uint_as_float(rr[0]) + __uint_as_float(rr[1]); }
    const bool b4 = (lane & 16) != 0, b3 = (lane & 8) != 0, b2 = (lane & 4) != 0;
#pragma unroll
    for (int e = 0; e < 4; ++e) { const float keep = b4 ? b[e + 4] : b[e], send = b4 ? b[e] : b[e + 4]; c[e] = keep + swz_xor<16>(send); }
#pragma unroll
    for (int e = 0; e < 2; ++e) { const float keep = b3 ? c[e + 2] : c[e], send = b3 ? c[e] : c[e + 2]; d[e] = keep + swz_xor<8>(send); }
    float f; { const float keep = b2 ? d[1] : d[0], send = b2 ? d[0] : d[1]; f = keep + swz_xor<4>(send); }
    f += swz_xor<2>(f); f += swz_xor<1>(f);
    return f;
}
__device__ __forceinline__ void phase_ln1_router(const Params& P, LAS unsigned char* lds, int vcu, int G, int wv) {
    const int tid = ltid(wv), lane = tid & 63, wave = tid >> 6, r = lane & 15, g = lane >> 4;
    LAS u32x4* whi = (LAS u32x4*)lds; LAS u32x4* wlo = (LAS u32x4*)(lds + 32768);
    for (int i = tid; i < 2048; i += 512) { const int ks = i >> 6, ln = i & 63, e = ln & 15, gg = ln >> 4; float w[8]; unsigned hb[8], lb[8];
#pragma unroll
        for (int j = 0; j < 8; ++j) { w[j] = P.w_router[(size_t)(32 * ks + 8 * gg + j) * 16 + e]; }
#pragma unroll
        for (int j = 0; j < 8; j += 2) { const unsigned h2 = cvtpk(w[j], w[j + 1]); hb[j / 2] = h2; lb[j / 2] = cvtpk(w[j] - bf_lo(h2), w[j + 1] - bf_hi(h2)); }
        whi[i] = (u32x4){hb[0], hb[1], hb[2], hb[3]}; wlo[i] = (u32x4){lb[0], lb[1], lb[2], lb[3]}; }
    __syncthreads();
    float* aff = (float*)(P.ws + WS_AFF); bf16_t* x1b = (bf16_t*)(P.ws + WS_R3); unsigned char* x1q = (unsigned char*)P.out + 64 * MiB;
    const bf16_t* xb = (const bf16_t*)(P.ws + WS_RH); const bf16_t* mixo = (const bf16_t*)P.out;
    const int gw = vcu * NWAVES + wave, NGW = G * NWAVES;
    for (int tile = gw; tile < MROWS / 16; tile += NGW) {
        const size_t rowoff = (size_t)(tile * 16 + r) * DMODEL + 8 * g, xrowoff = (size_t)(tile * 16 + r) * XBP + 8 * g;
        float s1 = 0.f, s2 = 0.f;
#pragma unroll 8
        for (int ks = 0; ks < 32; ++ks) { const u32x4 a = *(const u32x4*)(xb + xrowoff + 32 * ks), m = *(const u32x4*)(mixo + rowoff + 32 * ks);
            float y[8] = {bf_lo(a.x) * ALPHA + bf_lo(m.x), bf_hi(a.x) * ALPHA + bf_hi(m.x), bf_lo(a.y) * ALPHA + bf_lo(m.y), bf_hi(a.y) * ALPHA + bf_hi(m.y),
                          bf_lo(a.z) * ALPHA + bf_lo(m.z), bf_hi(a.z) * ALPHA + bf_hi(m.z), bf_lo(a.w) * ALPHA + bf_lo(m.w), bf_hi(a.w) * ALPHA + bf_hi(m.w)};
#pragma unroll
            for (int j = 0; j < 8; ++j) { s1 += y[j]; s2 += y[j] * y[j]; } }
        s1 += swz_xor<16>(s1); s2 += swz_xor<16>(s2);
        { auto rr = __builtin_amdgcn_permlane32_swap(__float_as_uint(s1), __float_as_uint(s1), false, false); s1 = __uint_as_float(rr[0]) + __uint_as_float(rr[1]); }
        { auto rr = __builtin_amdgcn_permlane32_swap(__float_as_uint(s2), __float_as_uint(s2), false, false); s2 = __uint_as_float(rr[0]) + __uint_as_float(rr[1]); }
        const float mean = s1 * (1.f / DMODEL); const float var = fmaxf(s2 * (1.f / DMODEL) - mean * mean, 0.f); const float rstd = 1.0f / sqrtf(var + LN_EPS);
        f32x4 acc = {0.f, 0.f, 0.f, 0.f};
#pragma unroll 4
        for (int ks = 0; ks < 32; ++ks) { const u32x4 a = *(const u32x4*)(xb + xrowoff + 32 * ks), m = *(const u32x4*)(mixo + rowoff + 32 * ks);
            const f32x4 g0 = *(const f32x4*)(P.ln1_g + 32 * ks + 8 * g), g1 = *(const f32x4*)(P.ln1_g + 32 * ks + 8 * g + 4), b0 = *(const f32x4*)(P.ln1_b + 32 * ks + 8 * g), b1 = *(const f32x4*)(P.ln1_b + 32 * ks + 8 * g + 4);
            float x[8] = {bf_lo(a.x) * ALPHA + bf_lo(m.x), bf_hi(a.x) * ALPHA + bf_hi(m.x), bf_lo(a.y) * ALPHA + bf_lo(m.y), bf_hi(a.y) * ALPHA + bf_hi(m.y),
                          bf_lo(a.z) * ALPHA + bf_lo(m.z), bf_hi(a.z) * ALPHA + bf_hi(m.z), bf_lo(a.w) * ALPHA + bf_lo(m.w), bf_hi(a.w) * ALPHA + bf_hi(m.w)};
#pragma unroll
            for (int j = 0; j < 4; ++j) { x[j] = (x[j] - mean) * rstd * g0[j] + b0[j]; x[4 + j] = (x[4 + j] - mean) * rstd * g1[j] + b1[j]; }
            u32x4 hi, lo;
            hi.x = cvtpk(x[0], x[1]); hi.y = cvtpk(x[2], x[3]); hi.z = cvtpk(x[4], x[5]); hi.w = cvtpk(x[6], x[7]);
            lo.x = cvtpk(x[0] - bf_lo(hi.x), x[1] - bf_hi(hi.x)); lo.y = cvtpk(x[2] - bf_lo(hi.y), x[3] - bf_hi(hi.y)); lo.z = cvtpk(x[4] - bf_lo(hi.z), x[5] - bf_hi(hi.z)); lo.w = cvtpk(x[6] - bf_lo(hi.w), x[7] - bf_hi(hi.w));
            *(u32x4*)(x1b + rowoff + 32 * ks) = hi;
            { u32x2 qv; qv.x = pk_fp8x4(x[0], x[1], x[2], x[3]); qv.y = pk_fp8x4(x[4], x[5], x[6], x[7]); *(u32x2*)(x1q + rowoff + 32 * ks) = qv; }
            const bf16x8 ah = __builtin_bit_cast(bf16x8, hi), al = __builtin_bit_cast(bf16x8, lo);
            const bf16x8 wh = __builtin_bit_cast(bf16x8, whi[ks * 64 + lane]), wl = __builtin_bit_cast(bf16x8, wlo[ks * 64 + lane]);
            acc = __builtin_amdgcn_mfma_f32_16x16x32_bf16(ah, wh, acc, 0, 0, 0);
            acc = __builtin_amdgcn_mfma_f32_16x16x32_bf16(al, wh, acc, 0, 0, 0);
            acc = __builtin_amdgcn_mfma_f32_16x16x32_bf16(ah, wl, acc, 0, 0, 0); }
#pragma unroll
        for (int q = 0; q < 4; ++q) { float f = acc[q], mx = f;
            mx = fmaxf(mx, swz_xor<1>(mx)); mx = fmaxf(mx, swz_xor<2>(mx)); mx = fmaxf(mx, swz_xor<4>(mx)); mx = fmaxf(mx, swz_xor<8>(mx));
            const float pe = expf(f - mx); float sm = pe; sm += swz_xor<1>(sm); sm += swz_xor<2>(sm); sm += swz_xor<4>(sm); sm += swz_xor<8>(sm);
            aff[(size_t)(tile * 16 + 4 * g + q) * 16 + r] = pe / sm; }
    }
}

__device__ __forceinline__ void phase_topk(const Params& P, LAS unsigned char* lds, int blk, int G, int wv) {
    const int tid = ltid(wv), lane = tid & 63, wid = tid >> 6;
    LAS unsigned* cntb = (LAS unsigned*)lds;
    LAS unsigned* wtot = (LAS unsigned*)(lds + 256);
    const float* affp = (const float*)(P.ws + WS_AFF); int* slotmap = (int*)(P.ws + WS_SLOT); int* tok = (int*)(P.ws + WS_TOK); float* gate = (float*)(P.ws + WS_GATE);
    for (int item = blk; item < BATCH * NEXP; item += G) {
        const int b = item >> 4, e = item & 15;
        unsigned ku[16];
#pragma unroll
        for (int j = 0; j < 16; ++j) ku[j] = __float_as_uint(affp[((size_t)b * SEQ + tid + 512 * j) * 16 + e]);
        unsigned T = 0;
        {
            const unsigned cand = 1u << 30; unsigned c = 0;
#pragma unroll
            for (int j = 0; j < 16; ++j) c += (ku[j] >= cand) ? 1u : 0u;
            c = wave_sum_u(c);
            if (lane == 0) cntb[wid] = c;
            __syncthreads();
            unsigned tot = 0;
#pragma unroll
            for (int w = 0; w < 8; ++w) tot += cntb[w];
            if (tot >= (unsigned)CAP) T = cand;
        }
        for (int b0 = 28, it = 1; b0 >= 0; b0 -= 2, ++it) {
            const unsigned c1 = T | (1u << b0), c2 = T | (2u << b0), c3 = T | (3u << b0);
            unsigned n32 = 0, n1 = 0;
#pragma unroll
            for (int j = 0; j < 16; ++j) { n32 += ((ku[j] >= c3) ? 1u : 0u) + ((ku[j] >= c2) ? 0x10000u : 0u); n1 += (ku[j] >= c1) ? 1u : 0u; }
            n32 = wave_sum_u(n32); n1 = wave_sum_u(n1);
            const int par = it & 1;
            if (lane == 0) { cntb[par * 16 + wid] = n32; cntb[par * 16 + 8 + wid] = n1; }
            __syncthreads();
            unsigned t32 = 0, t1 = 0;
#pragma unroll
            for (int w = 0; w < 8; ++w) { t32 += cntb[par * 16 + w]; t1 += cntb[par * 16 + 8 + w]; }
            const unsigned t3 = t32 & 0xffffu, t2 = t32 >> 16;
            if (t3 >= (unsigned)CAP) T = c3; else if (t2 >= (unsigned)CAP) T = c2; else if (t1 >= (unsigned)CAP) T = c1;
        }
        __syncthreads();
        unsigned cg_ = 0;
#pragma unroll
        for (int j = 0; j < 16; ++j) cg_ += (ku[j] > T) ? 1u : 0u;
        cg_ = wave_sum_u(cg_);
        if (lane == 0) cntb[wid] = cg_;
        __syncthreads();
        unsigned ngt = 0;
#pragma unroll
        for (int w = 0; w < 8; ++w) ngt += cntb[w];
        const unsigned need_eq = (unsigned)CAP - ngt;
        unsigned selmask = 0;
        {
            unsigned below[16];
#pragma unroll
            for (int j = 0; j < 16; ++j) { const unsigned long long bal = __ballot(ku[j] == T); below[j] = __builtin_amdgcn_mbcnt_hi((unsigned)(bal >> 32), __builtin_amdgcn_mbcnt_lo((unsigned)bal, 0u)); if (lane == 0) wtot[j * 8 + wid] = (unsigned)__popcll(bal); }
            __syncthreads();
            unsigned run = 0;
#pragma unroll
            for (int j = 0; j < 16; ++j) { unsigned before = run;
#pragma unroll
                for (int w = 0; w < 8; ++w) { const unsigned c = wtot[j * 8 + w]; before += (w < wid) ? c : 0u; run += c; }
                const bool sel = (ku[j] > T) || ((ku[j] == T) && (before + below[j] < need_eq));
                selmask |= sel ? (1u << j) : 0u; }
            __syncthreads();
        }
        {
            unsigned below[16];
#pragma unroll
            for (int j = 0; j < 16; ++j) { const unsigned long long bal = __ballot((selmask >> j) & 1u); below[j] = __builtin_amdgcn_mbcnt_hi((unsigned)(bal >> 32), __builtin_amdgcn_mbcnt_lo((unsigned)bal, 0u)); if (lane == 0) wtot[j * 8 + wid] = (unsigned)__popcll(bal); }
            __syncthreads();
            unsigned run = 0;
#pragma unroll
            for (int j = 0; j < 16; ++j) { unsigned before = run;
#pragma unroll
                for (int w = 0; w < 8; ++w) { const unsigned c = wtot[j * 8 + w]; before += (w < wid) ? c : 0u; run += c; }
                const int t = tid + 512 * j; const bool sel = (selmask >> j) & 1u; const int slot = (int)(before + below[j]);
                slotmap[((size_t)b * SEQ + t) * 16 + e] = sel ? slot : -1;
                if (sel) { const int vr = (e * 4 + b) * CAP + slot; tok[vr] = b * SEQ + t; gate[vr] = __uint_as_float(ku[j]); } }
            __syncthreads();
        }
    }
}

__device__ __forceinline__ void phase_combine_ln2(const Params& P, int vcu, int G, int wv) {
    const int tid = ltid(wv), lane = tid & 63, wave = tid >> 6;
    const int* slotmap = (const int*)(P.ws + WS_SLOT); const bf16_t* ye = (const bf16_t*)(P.ws + WS_WGU); bf16_t* x2b = (bf16_t*)(P.ws + WS_R3);
    const int gw = vcu * NWAVES + wave, NGW = G * NWAVES;
    for (int row = gw; row < MROWS; row += NGW) {
        bf16_t* xr = x2b + (size_t)row * DMODEL; const int b = row >> 13;
        f32x4 v[4];
        load_row_bf16(xr, v, lane);
#pragma unroll
        for (int j = 0; j < 4; ++j) v[j] = v[j] * ALPHA;
        const int sl = slotmap[(size_t)row * 16 + (lane & 15)];
        unsigned long long m = __ballot(sl >= 0) & 0xffffull;
        while (m) { const int e = __builtin_ctzll(m); m &= m - 1; const int s = __builtin_amdgcn_readlane(sl, e);
            const bf16_t* yr = ye + (size_t)((e * 4 + b) * CAP + s) * DMODEL;
#pragma unroll
            for (int j = 0; j < 4; ++j) { const u32x2 w = *(const u32x2*)(yr + 256 * j + 4 * lane); v[j][0] += bf_lo(w.x); v[j][1] += bf_hi(w.x); v[j][2] += bf_lo(w.y); v[j][3] += bf_hi(w.y); } }
        ln_row(v, P.ln2_g, P.ln2_b, lane);
        store_row_bf16(xr, v, lane);
    }
}
__device__ __forceinline__ void phase_ln3(const Params& P, int vcu, int G, int wv) {
    const int tid = ltid(wv), lane = tid & 63, wave = tid >> 6;
    const bf16_t* y3 = (const bf16_t*)(P.ws + WS_RH + 64 * MiB);
    const int gw = vcu * NWAVES + wave, NGW = G * NWAVES;
    for (int row = gw; row < MROWS; row += NGW) {
        float* xr = P.out + (size_t)row * DMODEL; f32x4 v[4];
        load_row_bf16(y3 + (size_t)row * DMODEL, v, lane);
        ln_row(v, P.ln3_g, P.ln3_b, lane);
#pragma unroll
        for (int j = 0; j < 4; ++j) __builtin_nontemporal_store(v[j], (f32x4*)(xr + 256 * j + 4 * lane));
    }
}

#define XB_TMO      128
#define XB_XCNT(j)  (256  + 64 * (j))
#define XB_XSUB(j)  (1280 + 64 * (j))
#define XB_XGEN(j)  (2304 + 64 * (j))
#define XB_TOP      3328
#define XB_TOPGEN   3392
#define XCD_BAR_WORDS 3456
#define XB_SPIN_CAP (1u << 22)
__device__ __forceinline__ unsigned xb_ld(unsigned* p)              { return __hip_atomic_load(p, __ATOMIC_RELAXED, __HIP_MEMORY_SCOPE_AGENT); }
__device__ __forceinline__ unsigned xb_add(unsigned* p, unsigned v) { return __hip_atomic_fetch_add(p, v, __ATOMIC_RELAXED, __HIP_MEMORY_SCOPE_AGENT); }
__device__ __forceinline__ unsigned xb_xcc_id() { return (unsigned)__builtin_amdgcn_s_getreg((3 << 11) | 20) & 0xFu; }
#define XB_SPIN(cond, bar) do { unsigned _sp = 0; while (cond) { __builtin_amdgcn_s_sleep(1); \
    if ((++_sp & 255u) == 0u) { if (xb_ld(&(bar)[XB_TMO])) break; if (_sp > XB_SPIN_CAP) { atomicAdd(&(bar)[XB_TMO], 1u); break; } } } } while (0)
struct XcdBarrier { unsigned* bar; unsigned x; volatile LAS unsigned* st; };
__device__ __forceinline__ XcdBarrier xcd_barrier_post(unsigned* bar, volatile LAS unsigned* st, int wv) {
    XcdBarrier b; b.bar = bar; b.x = xb_xcc_id(); b.st = st;
    if (ltid(wv) == 0) (void)xb_add(&bar[XB_XCNT(b.x)], 1u);
    return b;
}
__device__ __forceinline__ void xcd_barrier_complete(unsigned* bar, unsigned x, unsigned& nloc, unsigned& nx) {
    const unsigned G = gridDim.x * gridDim.y * gridDim.z;
    unsigned sum, cnt, mine, sp = 0u;
    for (;;) {
        sum = 0u; cnt = 0u; mine = 0u;
#pragma unroll
        for (unsigned j = 0; j < 16; ++j) { const unsigned c = xb_ld(&bar[XB_XCNT(j)]); sum += c; cnt += (c > 0u) ? 1u : 0u; mine = (j == x) ? c : mine; }
        if (sum == G) break;
        __builtin_amdgcn_s_sleep(1);
        if ((++sp & 255u) == 0u) { if (xb_ld(&bar[XB_TMO])) break; if (sp > XB_SPIN_CAP) { atomicAdd(&bar[XB_TMO], 1u); break; } }
    }
    nloc = mine > 0u ? mine : 1u; nx = cnt > 0u ? cnt : 1u;
}
__device__ __forceinline__ void xcd_barrier(const XcdBarrier& b, int wv) {
    asm volatile("s_waitcnt vmcnt(0)" ::: "memory");
    __syncthreads();
    if (ltid(wv) == 0) {
        unsigned* bar = b.bar;
        __builtin_amdgcn_s_waitcnt(0);
        unsigned nloc = b.st[0], nx = b.st[1];
        if (nloc == 0u) { xcd_barrier_complete(bar, b.x, nloc, nx); b.st[0] = nloc; b.st[1] = nx; }
        const unsigned old = xb_add(&bar[XB_XSUB(b.x)], 1u);
        const unsigned gen = old / nloc;
        if (old + 1u == (gen + 1u) * nloc) {
            __builtin_amdgcn_fence(__ATOMIC_RELEASE, "agent");
            asm volatile("s_waitcnt vmcnt(0)" ::: "memory");
            const unsigned og = xb_add(&bar[XB_TOP], 1u);
            const unsigned tg = og / nx;
            if (og + 1u == (tg + 1u) * nx) xb_add(&bar[XB_TOPGEN], 1u);
            else XB_SPIN(xb_ld(&bar[XB_TOPGEN]) == tg, bar);
            __builtin_amdgcn_fence(__ATOMIC_ACQUIRE, "agent");
            xb_add(&bar[XB_XGEN(b.x)], 1u);
            asm volatile("s_waitcnt vmcnt(0)" ::: "memory");
        } else {
            XB_SPIN(xb_ld(&bar[XB_XGEN(b.x)]) == gen, bar);
            __builtin_amdgcn_fence(__ATOMIC_ACQUIRE, "agent");
            asm volatile("s_waitcnt vmcnt(0)" ::: "memory");
        }
    }
    __syncthreads();
}

#ifndef MK_PH_LO
#define MK_PH_LO 0
#endif
#ifndef MK_PH_HI
#define MK_PH_HI 13
#endif
__global__ void __launch_bounds__(NWAVES * 64, 2) fwd_megakernel(Params P) {
    extern __shared__ __attribute__((aligned(16))) unsigned char lds[];
    LAS unsigned char* ldsl = (LAS unsigned char*)lds;
    const int G = gridDim.x, bx = blockIdx.x;
    const int wv = __builtin_amdgcn_readfirstlane((int)(threadIdx.x >> 6));
    const int vcu = (G % 8 == 0) ? (bx % 8) * (G / 8) + bx / 8 : bx;
    unsigned char* ws = P.ws;
    bf16_t* XB = (bf16_t*)(ws + WS_RH); bf16_t* COLS = (bf16_t*)(ws + WS_RH + COLS_OFF); bf16_t* HB = (bf16_t*)(ws + WS_RH); bf16_t* PJ = (bf16_t*)P.out;
    bf16_t* R3 = (bf16_t*)(ws + WS_R3); bf16_t* YE = (bf16_t*)(ws + WS_WGU);
#define PH(k) ((k) >= MK_PH_LO && (k) < MK_PH_HI)
    unsigned* barw = (unsigned*)ws;
    volatile LAS unsigned* bst = (volatile LAS unsigned*)(ldsl + 143360);
    if (ltid(wv) < 2) bst[ltid(wv)] = 0u;
    __syncthreads();
    const XcdBarrier xbar = xcd_barrier_post(barw, bst, wv);
    if (PH(0)) { phase_prologue(P, ldsl, vcu, G, wv); }
    xcd_barrier(xbar, wv);
#define GRID_BAR() xcd_barrier(xbar, wv)
    const bool split_qkv = (G >= 256);
    if (PH(1)) { pg8::ProbPlain S; S.K = 1024; S.KA = XBP; S.ord.init(MROWS / 256, split_qkv ? 8 : INW / 256, G, bx); S.A = (const char*)XB; S.Bt = (const char*)(ws + WS_WIN);
        pg8::EpiQKV E{COLS, (unsigned*)ws + 3520}; pg8::gemm_phase<pg8::ProbPlain, pg8::EpiQKV, true>(ldsl, S, E, wv); }
    GRID_BAR();
    if (PH(2)) {
        if (split_qkv) {
            if (bx < 128) { pg8::ProbPlain S; S.K = 1024; S.KA = XBP; S.ord.init(MROWS / 256, 1, 128, bx, 8); S.A = (const char*)XB; S.Bt = (const char*)(ws + WS_WIN);
                pg8::EpiQKV E{COLS, (unsigned*)ws + 3520}; pg8::gemm_phase<pg8::ProbPlain, pg8::EpiQKV, true>(ldsl, S, E, wv); }
            else phase_qknorm_rope(P, ldsl, bx - 128, G - 128, wv);
        } else phase_qknorm_rope(P, ldsl, vcu, G, wv);
    }
    GRID_BAR();
    if (PH(3)) { phase_attention(P, lds, vcu, G, wv); }
    GRID_BAR();
    if (PH(5)) { pg8::ProbPlain S; S.K = 1024; S.KA = DMODEL; S.ord.init(MROWS / 256, DMODEL / 256, G, bx); S.A = (const char*)R3; S.Bt = (const char*)(ws + WS_WO);
        pg8::EpiBf16Plain E{(bf16_t*)P.out, DMODEL}; pg8::gemm_phase<pg8::ProbPlain, pg8::EpiBf16Plain, true>(ldsl, S, E, wv); }
    GRID_BAR();
    if (PH(6)) { phase_ln1_router(P, ldsl, vcu, G, wv); }
    GRID_BAR();
    if (PH(7)) {
        if (G >= 128) {
            if (bx < 64) phase_topk(P, ldsl, bx, 64, wv);
            else { pg8::ProbPlain S; S.K = PLE; S.KA = PLE; S.ord.init(MROWS / 256, DMODEL / 256, G - 64, bx - 64); S.A = (const char*)(ws + WS_PB); S.Bt = (const char*)(ws + WS_WPP);
                pg8::EpiBf16Plain E{PJ, DMODEL}; pg8::gemm_phase<pg8::ProbPlain, pg8::EpiBf16Plain, true>(ldsl, S, E, wv); }
        } else {
            phase_topk(P, ldsl, bx, G, wv); __syncthreads();
            pg8::ProbPlain S; S.K = PLE; S.KA = PLE; S.ord.init(MROWS / 256, DMODEL / 256, G, bx); S.A = (const char*)(ws + WS_PB); S.Bt = (const char*)(ws + WS_WPP);
            pg8::EpiBf16Plain E{PJ, DMODEL}; pg8::gemm_phase<pg8::ProbPlain, pg8::EpiBf16Plain, true>(ldsl, S, E, wv);
        }
    }
    GRID_BAR();
    if (PH(8)) { pg8::ProbExpertGatherQ S; S.K = 512; S.scale_a = 0x7F7F7F7F; S.scale_b = 0x7A7A7A7A; S.ord.init(VROWS / 256, 16, G, bx); S.A = (const char*)((unsigned char*)P.out + 64 * MiB); S.Bt = (const char*)(ws + WS_WGU); S.tok = (const int*)(ws + WS_TOK);
        pg8::EpiSwiGLU E{(unsigned char*)HB}; pg8::gemm_phase_q<pg8::ProbExpertGatherQ, pg8::EpiSwiGLU, true>(ldsl, S, E, wv); }
    GRID_BAR();
    if (PH(9)) { pg8::ProbExpertDownQ S; S.K = 1024; S.scale_a = 0x7B7B7B7B; S.scale_b = 0x79797979; S.ord.init(VROWS / 256, 4, G, bx); S.A = (const char*)HB; S.Bt = (const char*)(ws + WS_WD);
        pg8::EpiDown E{YE, (const float*)(ws + WS_GATE)}; pg8::gemm_phase_q<pg8::ProbExpertDownQ, pg8::EpiDown, true>(ldsl, S, E, wv); }
    GRID_BAR();
    if (PH(10)) { phase_combine_ln2(P, vcu, G, wv); }
    GRID_BAR();
    if (PH(11)) { pg8::ProbPlain S; S.K = 1024; S.KA = DMODEL; S.ord.init(MROWS / 256, DMODEL / 256, G, bx); S.A = (const char*)R3; S.Bt = (const char*)(ws + WS_WPG);
        pg8::EpiPLE E{R3, PJ, (bf16_t*)(ws + WS_RH + 64 * MiB)}; pg8::gemm_phase<pg8::ProbPlain, pg8::EpiPLE, true>(ldsl, S, E, wv); }
    GRID_BAR();
    if (PH(12)) { phase_ln3(P, vcu, G, wv); }
#undef PH
}

extern "C" void kernel_launch(void* const* d_in, const int* in_sizes, int n_in, void* d_out, int out_size, void* d_ws, size_t ws_size, hipStream_t stream) {
    static int grid = 0;
    if (grid == 0) {
        if (n_in != 24 || out_size != MROWS * DMODEL || ws_size < WS_END) { fprintf(stderr, "kernel_launch: unexpected shapes (n_in %d, out %d, ws %zu < %zu); nothing launched\n", n_in, out_size, ws_size, (size_t)WS_END); grid = -1; return; }
        int dev = 0, cus = 0, per_cu = 0;
        hipGetDevice(&dev); hipDeviceGetAttribute(&cus, hipDeviceAttributeMultiprocessorCount, dev);
        hipFuncSetAttribute((const void*)fwd_megakernel, hipFuncAttributeMaxDynamicSharedMemorySize, LDS_BYTES);
        hipOccupancyMaxActiveBlocksPerMultiprocessor(&per_cu, (const void*)fwd_megakernel, NWAVES * 64, LDS_BYTES);
        (void)hipGetLastError();
        if (per_cu < 1) { fprintf(stderr, "kernel_launch: occupancy query reports %d blocks per CU\n", per_cu); grid = -1; return; }
        grid = cus;
    }
    if (grid < 0) return;
    if (hipMemsetAsync(d_ws, 0, 16384, stream) != hipSuccess) { fprintf(stderr, "kernel_launch: memset of the barrier words failed\n"); return; }
    Params p{};
    const float** f = (const float**)&p;
    for (int i = 0; i < 24; ++i) f[i] = (const float*)d_in[i];
    p.out = (float*)d_out; p.ws = (unsigned char*)d_ws;
    void* args[] = {&p};
    hipError_t e = hipLaunchCooperativeKernel((const void*)fwd_megakernel, dim3(grid), dim3(NWAVES * 64), args, LDS_BYTES, stream);
    if (e != hipSuccess) fprintf(stderr, "kernel_launch: cooperative launch failed: %s (grid %d)\n", hipGetErrorString(e), grid);
}
```
